# Optimizing an MI355X kernel written in HIP

```python
import math
import jax, jax.numpy as jnp
from jax import lax
import numpy as np

D_MODEL = 1024
BATCH = 16
SEQ = 2048
DEPTH = 1

M_HEADS = 4
M_HEAD_DIM = 128
M_WIDTH = M_HEADS * M_HEAD_DIM
M_CHUNK = 128
CONV_WIDTH = 4
N_HEADS = 8
N_KV_GROUPS = 2
N_REP = N_HEADS // N_KV_GROUPS
N_HEAD_DIM = 64
N_WIDTH = N_HEADS * N_HEAD_DIM
N_KV_WIDTH = N_KV_GROUPS * N_HEAD_DIM
CMP_BLOCK = 32
CMP_STRIDE = 16
CMP_HIDDEN = 2 * N_HEAD_DIM
SEL_BLOCK = 64
SEL_TOPK = 16
WINDOW = 512
NSA_Q_BLOCK = 64
REL_BUCKETS = 32
REL_MAX_DIST = 1024
N_BRANCH = 2
BRANCH_WIDTH = 512
D_FF = -(-8 * D_MODEL // (3 * 256)) * 256
RMS_EPS = 1e-6
BIG = 1e9

IN_SIZES = (M_WIDTH, M_WIDTH, M_WIDTH, M_WIDTH, M_HEADS, M_HEADS,
            N_WIDTH, 6 * N_KV_WIDTH, 3 * N_HEADS, N_BRANCH * D_MODEL)
D_IN_TOTAL = sum(IN_SIZES)

kernel_name = 'hybrid_mlstm_nsa_block'


def rms_norm(x, g):
    x32 = x.astype(jnp.float32)
    y = x32 * lax.rsqrt(jnp.mean(x32 * x32, axis=-1, keepdims=True) + RMS_EPS)
    return (y * g.astype(jnp.float32)).astype(x.dtype)


def split_columns(p, sizes):
    out = []
    start = 0
    for s in sizes:
        out.append(p[..., start:start + s])
        start += s
    return out


def causal_depthwise_conv(x, w):
    T = x.shape[1]
    xp = jnp.pad(x, ((0, 0), (CONV_WIDTH - 1, 0), (0, 0)))
    return sum(w[j] * xp[:, j:j + T] for j in range(CONV_WIDTH))


def rel_bucket(dist):
    n = jnp.maximum(dist, 0)
    max_exact = REL_BUCKETS // 2
    nf = jnp.maximum(n, 1).astype(jnp.float32)
    large = max_exact + (jnp.log(nf / max_exact) / math.log(REL_MAX_DIST / max_exact)
                         * (REL_BUCKETS - max_exact)).astype(jnp.int32)
    large = jnp.minimum(large, REL_BUCKETS - 1)
    return jnp.where(n < max_exact, n, large)


def masked_softmax(logits, mask):
    logits = logits.astype(jnp.float32)
    z = jnp.where(mask, logits, -1e30)
    z = z - jnp.max(z, axis=-1, keepdims=True)
    e = jnp.where(mask, jnp.exp(z), 0.0)
    return e / jnp.maximum(jnp.sum(e, axis=-1, keepdims=True), 1e-30)


def mlstm_chunkwise(q, k, v, i_pre, f_pre):
    B, H, T, dk = q.shape
    dv = v.shape[-1]
    L = M_CHUNK
    nc = T // L
    qc = q.reshape(B, H, nc, L, dk)
    kc = k.reshape(B, H, nc, L, dk)
    vc = v.reshape(B, H, nc, L, dv)
    ic = i_pre.reshape(B, H, nc, L)
    bc = jnp.cumsum(jax.nn.log_sigmoid(f_pre).reshape(B, H, nc, L), axis=-1)
    b_last = bc[..., -1]
    a = b_last[..., None] - bc + ic

    def step(carry, inp):
        C, n, m = carry
        k_j, v_j, a_j, bl = inp
        m_new = jnp.maximum(bl + m, jnp.max(a_j, axis=-1))
        decay = jnp.exp(bl + m - m_new)
        w = jnp.exp(a_j - m_new[..., None])
        C_new = decay[..., None, None] * C + jnp.einsum('bhl,bhlk,bhlv->bhkv', w, k_j, v_j)
        n_new = decay[..., None] * n + jnp.einsum('bhl,bhlk->bhk', w, k_j)
        return (C_new, n_new, m_new), (C, n, m)

    init = (jnp.zeros((B, H, dk, dv), jnp.float32), jnp.zeros((B, H, dk), jnp.float32),
            jnp.zeros((B, H), jnp.float32))
    xs = (jnp.moveaxis(kc, 2, 0), jnp.moveaxis(vc, 2, 0), jnp.moveaxis(a, 2, 0), jnp.moveaxis(b_last, 2, 0))
    _, (C_prev, n_prev, m_prev) = lax.scan(step, init, xs)
    C_prev = jnp.moveaxis(C_prev, 0, 2)
    n_prev = jnp.moveaxis(n_prev, 0, 2)
    m_prev = jnp.moveaxis(m_prev, 0, 2)

    causal = jnp.tril(jnp.ones((L, L), dtype=bool))
    log_d = jnp.where(causal, bc[..., :, None] - bc[..., None, :] + ic[..., None, :], -jnp.inf)
    log_inter = bc + m_prev[..., None]
    m_i = jnp.maximum(jnp.max(log_d, axis=-1), log_inter)
    P = jnp.exp(log_d - m_i[..., None]) * jnp.einsum('bhcid,bhcjd->bhcij', qc, kc)
    s_inter = jnp.exp(log_inter - m_i)
    num = (jnp.einsum('bhcij,bhcjv->bhciv', P, vc)
           + s_inter[..., None] * jnp.einsum('bhcid,bhcdv->bhciv', qc, C_prev))
    den = jnp.sum(P, axis=-1) + s_inter * jnp.einsum('bhcid,bhcd->bhci', qc, n_prev)
    h = num / jnp.maximum(jnp.abs(den), jnp.exp(-m_i))[..., None]
    return h.reshape(B, H, T, dv)


def mlstm_mixer(q_pre, k_pre, v, o_pre, i_pre, f_pre, b_fgate, conv_w, g_head):
    B, T, _ = q_pre.shape
    qk = jax.nn.silu(causal_depthwise_conv(jnp.concatenate([q_pre, k_pre], axis=-1), conv_w))
    to_heads = lambda t: t.reshape(B, T, M_HEADS, M_HEAD_DIM).transpose(0, 2, 1, 3).astype(jnp.float32)
    q = to_heads(qk[..., :M_WIDTH])
    k = to_heads(qk[..., M_WIDTH:]) * (M_HEAD_DIM ** -0.5)
    vh = to_heads(v)
    ig = i_pre.astype(jnp.float32).transpose(0, 2, 1)
    fg = (f_pre.astype(jnp.float32) + b_fgate.astype(jnp.float32)).transpose(0, 2, 1)
    hh = mlstm_chunkwise(q, k, vh, ig, fg)
    hh = (hh * lax.rsqrt(jnp.mean(hh * hh, axis=-1, keepdims=True) + RMS_EPS)
          * g_head.astype(jnp.float32).reshape(M_HEADS, 1, M_HEAD_DIM))
    hh = hh.transpose(0, 2, 1, 3).reshape(B, T, M_WIDTH)
    return (jax.nn.sigmoid(o_pre.astype(jnp.float32)) * hh).astype(q_pre.dtype)


def nsa_mixer(q_in, kv_in, gate_in, pe_cmp, w_cmp1, w_cmp2, rel_bias):
    B, T, _ = q_in.shape
    G, R, dh, Q = N_KV_GROUPS, N_REP, N_HEAD_DIM, NSA_Q_BLOCK
    q = q_in.reshape(B, T, G, R, dh).transpose(0, 2, 3, 1, 4) * (dh ** -0.5)
    kv = kv_in.reshape(B, T, 6, G, dh).transpose(2, 0, 3, 1, 4)
    k_c, v_c, k_s, v_s, k_w, v_w = kv[0], kv[1], kv[2], kv[3], kv[4], kv[5]
    gates = jax.nn.sigmoid(gate_in.astype(jnp.float32).reshape(B, T, G, R, 3).transpose(0, 2, 3, 1, 4))

    n_cmp = (T - CMP_BLOCK) // CMP_STRIDE + 1
    cmp_start = jnp.arange(n_cmp) * CMP_STRIDE
    cmp_idx = cmp_start[:, None] + jnp.arange(CMP_BLOCK)[None, :]
    cmp_end = cmp_start + CMP_BLOCK - 1

    def compress(kx, j):
        blk = kx[:, :, cmp_idx] + pe_cmp[j]
        flat = blk.reshape(B, G, n_cmp, CMP_BLOCK * dh)
        return jax.nn.silu(flat @ w_cmp1[j]) @ w_cmp2[j]

    kc_ = compress(k_c, 0)
    vc_ = compress(v_c, 1)

    n_slc = T // SEL_BLOCK
    n_top = min(SEL_TOPK, n_slc)
    k_sb = k_s.reshape(B, G, n_slc, SEL_BLOCK, dh)
    v_sb = v_s.reshape(B, G, n_slc, SEL_BLOCK, dh)
    slc_start = jnp.arange(n_slc) * SEL_BLOCK
    overlap = (jnp.clip(jnp.minimum(cmp_start[:, None] + CMP_BLOCK, slc_start[None, :] + SEL_BLOCK)
                        - jnp.maximum(cmp_start[:, None], slc_start[None, :]), 0)
               / CMP_STRIDE).astype(jnp.float32)

    k_wp = jnp.pad(k_w, ((0, 0), (0, 0), (WINDOW, 0), (0, 0)))
    v_wp = jnp.pad(v_w, ((0, 0), (0, 0), (WINDOW, 0), (0, 0)))

    table = rel_bias.astype(jnp.float32).T.reshape(G, R, REL_BUCKETS)
    g_ix = jnp.arange(G)[None, :, None, None, None]
    r_ix = jnp.arange(R)[None, None, :, None, None]
    gather_blocks = jax.vmap(jax.vmap(lambda blk, ix: blk[ix]))

    def block(i):
        qs = i * Q
        t = qs + jnp.arange(Q)
        qb = lax.dynamic_slice_in_dim(q, qs, Q, axis=3)
        lc = (jnp.einsum('bgrqd,bgcd->bgrqc', qb, kc_).astype(jnp.float32)
              + table[:, :, rel_bucket(t[:, None] - cmp_end[None, :])])
        p_c = masked_softmax(lc, cmp_end[None, :] <= t[:, None])
        o_c = jnp.einsum('bgrqc,bgcd->bgrqd', p_c, vc_.astype(jnp.float32))
        imp = jnp.einsum('bgrqc,cj->bgqj', p_c, overlap)
        cur = t // SEL_BLOCK
        jb = jnp.arange(n_slc)[None, :]
        forced = (jb == 0) | (jb == cur[:, None]) | (jb == cur[:, None] - 1)
        eligible = jb * SEL_BLOCK <= t[:, None]
        score = jnp.where(eligible, jnp.where(forced, BIG, imp), -BIG)
        top_val, top_idx = lax.top_k(score, n_top)
        N = n_top * SEL_BLOCK
        k_g = gather_blocks(k_sb, top_idx).reshape(B, G, Q, N, dh)
        v_g = gather_blocks(v_sb, top_idx).reshape(B, G, Q, N, dh)
        pos_u = top_idx[..., None] * SEL_BLOCK + jnp.arange(SEL_BLOCK)
        mask_u = (top_val > -BIG / 2)[..., None] & (pos_u <= t[:, None, None])
        pos = pos_u.reshape(B, G, Q, N)
        mask_s = mask_u.reshape(B, G, Q, N)
        bias_s = table[g_ix, r_ix, rel_bucket(t[:, None] - pos)[:, :, None]]
        ls = jnp.einsum('bgrqd,bgqnd->bgrqn', qb, k_g).astype(jnp.float32) + bias_s
        p_s = masked_softmax(ls, mask_s[:, :, None])
        o_s = jnp.einsum('bgrqn,bgqnd->bgrqd', p_s, v_g.astype(jnp.float32))
        span = Q + WINDOW
        k_wb = lax.dynamic_slice_in_dim(k_wp, qs, span, axis=2)
        v_wb = lax.dynamic_slice_in_dim(v_wp, qs, span, axis=2)
        pos_w = qs - WINDOW + jnp.arange(span)
        dist = t[:, None] - pos_w[None, :]
        mask_w = (pos_w[None, :] >= 0) & (dist >= 0) & (dist < WINDOW)
        lw = jnp.einsum('bgrqd,bgkd->bgrqk', qb, k_wb).astype(jnp.float32) + table[:, :, rel_bucket(dist)]
        p_w = masked_softmax(lw, mask_w)
        o_w = jnp.einsum('bgrqk,bgkd->bgrqd', p_w, v_wb.astype(jnp.float32))
        gb = lax.dynamic_slice_in_dim(gates, qs, Q, axis=3)
        return gb[..., 0:1] * o_c + gb[..., 1:2] * o_s + gb[..., 2:3] * o_w

    out = lax.map(block, jnp.arange(T // Q))
    out = out.transpose(1, 0, 4, 2, 3, 5).reshape(B, T, N_WIDTH)
    return out.astype(q_in.dtype)


def setup_inputs(seed: int = 0) -> dict:
    key = jax.random.key(seed)
    ks = jax.random.split(key, 20)
    nrm = lambda k, shape, scale: jax.random.normal(k, shape, jnp.float32) * scale
    x = nrm(ks[0], (BATCH, SEQ, D_MODEL), 1.0)
    g_norm_mix = 1.0 + nrm(ks[1], (DEPTH, D_MODEL), 0.02)
    w_in = nrm(ks[2], (DEPTH, D_MODEL, D_IN_TOTAL), D_MODEL ** -0.5)
    b_in = nrm(ks[3], (DEPTH, D_IN_TOTAL), 0.02)
    b_fgate = jnp.linspace(3.0, 6.0, M_HEADS, dtype=jnp.float32)[None, :] + nrm(ks[4], (DEPTH, M_HEADS), 0.1)
    conv_qk = nrm(ks[5], (DEPTH, CONV_WIDTH, 2 * M_WIDTH), CONV_WIDTH ** -0.5)
    g_mlstm_head = 1.0 + nrm(ks[6], (DEPTH, M_WIDTH), 0.02)
    pe_cmp = nrm(ks[7], (DEPTH, 2, CMP_BLOCK, N_HEAD_DIM), 0.1)
    w_cmp1 = nrm(ks[8], (DEPTH, 2, CMP_BLOCK * N_HEAD_DIM, CMP_HIDDEN), (CMP_BLOCK * N_HEAD_DIM) ** -0.5)
    w_cmp2 = nrm(ks[9], (DEPTH, 2, CMP_HIDDEN, N_HEAD_DIM), CMP_HIDDEN ** -0.5)
    rel_bias = nrm(ks[10], (REL_BUCKETS, N_HEADS), 0.5)
    w_branch = nrm(ks[11], (DEPTH, N_BRANCH, BRANCH_WIDTH, D_MODEL), BRANCH_WIDTH ** -0.5)
    w_out = nrm(ks[12], (DEPTH, D_MODEL, D_MODEL), D_MODEL ** -0.5)
    g_norm_ffn = 1.0 + nrm(ks[13], (DEPTH, D_MODEL), 0.02)
    w_gate = nrm(ks[14], (DEPTH, D_MODEL, D_FF), D_MODEL ** -0.5)
    w_up = nrm(ks[15], (DEPTH, D_MODEL, D_FF), D_MODEL ** -0.5)
    w_down = nrm(ks[16], (DEPTH, D_FF, D_MODEL), D_FF ** -0.5)
    g_final = 1.0 + nrm(ks[17], (D_MODEL,), 0.02)
    return {'x': x, 'g_norm_mix': g_norm_mix, 'w_in': w_in, 'b_in': b_in, 'b_fgate': b_fgate,
            'conv_qk': conv_qk, 'g_mlstm_head': g_mlstm_head, 'pe_cmp': pe_cmp, 'w_cmp1': w_cmp1,
            'w_cmp2': w_cmp2, 'rel_bias': rel_bias, 'w_branch': w_branch, 'w_out': w_out,
            'g_norm_ffn': g_norm_ffn, 'w_gate': w_gate, 'w_up': w_up, 'w_down': w_down, 'g_final': g_final}


def reference(x, g_norm_mix, w_in, b_in, b_fgate, conv_qk, g_mlstm_head, pe_cmp, w_cmp1, w_cmp2,
              rel_bias, w_branch, w_out, g_norm_ffn, w_gate, w_up, w_down, g_final):
    B, T, _ = x.shape
    h = x
    for l in range(DEPTH):
        u = rms_norm(h, g_norm_mix[l])
        proj = jnp.einsum('btd,de->bte', u, w_in[l]) + b_in[l]
        mq, mk, mv, mo, mi, mf, nq, nkv, ngate, merge = split_columns(proj, IN_SIZES)
        y_m = mlstm_mixer(mq, mk, mv, mo, mi, mf, b_fgate[l], conv_qk[l], g_mlstm_head[l])
        y_n = nsa_mixer(nq, nkv, ngate, pe_cmp[l], w_cmp1[l], w_cmp2[l], rel_bias)
        ys = jnp.stack([y_m, y_n], axis=2)
        branch = jnp.einsum('btnw,nwd->btnd', ys, w_branch[l])
        gates = jax.nn.sigmoid(merge.reshape(B, T, N_BRANCH, D_MODEL))
        mixed = jnp.sum(gates * branch, axis=2)
        h = h + mixed @ w_out[l]
        f = rms_norm(h, g_norm_ffn[l])
        h = h + (jax.nn.silu(f @ w_gate[l]) * (f @ w_up[l])) @ w_down[l]
    return rms_norm(h, g_final)
```

```cpp
#include <hip/hip_runtime.h>
#include <hip/hip_cooperative_groups.h>
#include <cstdio>
#include <cstdint>
namespace cg = cooperative_groups;

#define LAS __attribute__((address_space(3)))
typedef unsigned short bf16_t;
typedef short bf16x8 __attribute__((ext_vector_type(8)));
typedef short s16x4 __attribute__((ext_vector_type(4)));
typedef float f32x4 __attribute__((ext_vector_type(4)));
typedef float f32x2 __attribute__((ext_vector_type(2)));
typedef float f32x16 __attribute__((ext_vector_type(16)));
typedef unsigned u32x4 __attribute__((ext_vector_type(4)));
typedef unsigned u32x2 __attribute__((ext_vector_type(2)));
typedef __bf16 bf16x2_t __attribute__((ext_vector_type(2)));

constexpr int D_MODEL = 1024, BATCH = 16, SEQ = 2048, MTOK = BATCH * SEQ;
constexpr int M_HEADS = 4, M_HD = 128, M_WIDTH = 512, M_CHUNK = 128, NCHUNK = SEQ / M_CHUNK;
constexpr int N_HEADS = 8, N_G = 2, N_R = 4, N_HD = 64;
constexpr int N_CMP = 127, N_SLC = 32, SEL_TOPK = 16;
constexpr int D_FF = 2816, D_IN = 5408;
constexpr int N1 = 5632;
constexpr int NGU = 2 * D_FF;
constexpr float RMS_EPS = 1e-6f;
constexpr int BIAS_PAD = 64, BIAS_LEN = SEQ + BIAS_PAD;

constexpr size_t KiB = 1024, MiB = 1u << 20;
constexpr size_t WS_CTL   = 0;
constexpr size_t WS_BIAS1 = 4 * KiB;
constexpr size_t WS_PEB   = 28 * KiB;
constexpr size_t WS_WC2T  = 32 * KiB;
constexpr size_t WS_BTAB  = 64 * KiB;
constexpr size_t WS_RSX   = 256 * KiB;
constexpr size_t WS_W1T   = 1 * MiB;
constexpr size_t WS_WGUT  = 12 * MiB;
constexpr size_t WS_WDNT  = 23 * MiB;
constexpr size_t WS_WOUTT = 29 * MiB;
constexpr size_t WS_WBRT  = 31 * MiB;
constexpr size_t WS_WC1T  = 33 * MiB;
constexpr size_t WS_PART1 = 34 * MiB;
constexpr size_t WS_PART2 = 36 * MiB;
constexpr size_t WS_KC    = 38 * MiB;
constexpr size_t WS_VCT   = 38 * MiB + 512 * KiB;
constexpr size_t WS_HAB   = 39 * MiB;
constexpr size_t WS_XB    = 48 * MiB;
constexpr size_t WS_QK    = 112 * MiB;
constexpr size_t WS_VO    = 176 * MiB;
constexpr size_t WS_NQ    = 240 * MiB;
constexpr size_t WS_NKV   = 272 * MiB;
constexpr size_t WS_HID   = 112 * MiB;
constexpr size_t WS_GT    = 320 * MiB;
constexpr size_t WS_SM    = 448 * MiB;
constexpr size_t WS_VST   = 452 * MiB;
constexpr size_t WS_VWT   = 460 * MiB;
constexpr size_t WS_END   = 468 * MiB;

__device__ __forceinline__ unsigned cvtpk(float lo, float hi) { f32x2 v = {lo, hi}; bf16x2_t b = __builtin_convertvector(v, bf16x2_t); return __builtin_bit_cast(unsigned, b); }
__device__ __forceinline__ float bf2f(unsigned short u) { return __uint_as_float(((unsigned)u) << 16); }
__device__ __forceinline__ float bflo(unsigned u) { return __uint_as_float(u << 16); }
__device__ __forceinline__ float bfhi(unsigned u) { return __uint_as_float(u & 0xffff0000u); }
__device__ __forceinline__ float sigmoidf_(float x) { return __builtin_amdgcn_rcpf(1.0f + __expf(-x)); }
__device__ __forceinline__ float wave_sum(float v) {
#pragma unroll
    for (int o = 1; o < 64; o <<= 1) v += __shfl_xor(v, o);
    return v;
}

namespace pg8 {
constexpr int BM = 256, BK = 64, HALF = 128, HTB = HALF * BK * 2  , STAGE_BYTES = 8 * HTB, NXCD = 8, WGM = 8;
__host__ __device__ __forceinline__ int lds_byte(int r, int c) { const int st = (r >> 4) * 2 + (c >> 5), rr = r & 15, cc = c & 31, ob = rr * 64 + cc * 2; return st * 1024 + (ob ^ (((ob >> 9) & 1) << 5)); }
__host__ __device__ __forceinline__ void stage_rc(int b, int& R, int& C) { const int st = b / 1024, sb = b % 1024, swz = sb ^ (((sb >> 9) & 1) << 5); R = (st >> 1) * 16 + swz / 64; C = (st & 1) * 32 + (swz % 64) / 2; }

struct Unit { int pm, pn, seg; const char* A; const char* B; };
struct Dims { int lda, ldb, nt; };

__device__ __forceinline__ void tile_of(int L, int nM, int nN, int& pm, int& pn) {
    const int nwg = nM * nN; int wgid = L; { const int q = nwg / NXCD, r = nwg % NXCD, xcd = wgid % NXCD, off = wgid / NXCD; wgid = (xcd < r ? xcd * (q + 1) : r * (q + 1) + (xcd - r) * q) + off; }
    const int nig = WGM * nN, gid = wgid / nig, fm = gid * WGM, gsz = (nM - fm) < WGM ? (nM - fm) : WGM;
    pm = fm + ((wgid % nig) % gsz); pn = (wgid % nig) / gsz;
}
struct StaticOrder {
    int nM, nN, nwg, G, c; const char* A; const char* B; size_t tstepA, tstepB;
    __device__ void init(const void* A_, int lda, const void* B_, int ldb, int M, int N, int G_, int c_) { nM = M / BM; nN = N / BM; nwg = nM * nN; G = G_; c = c_; A = (const char*)A_; B = (const char*)B_; tstepA = (size_t)BM * lda * 2; tstepB = (size_t)BM * ldb * 2; }
    __device__ __forceinline__ bool next(int i, Unit& u) const {
        const long L = (long)i * G + c; if (L >= nwg) return false;
        tile_of((int)L, nM, nN, u.pm, u.pn); u.seg = 0; u.A = A + (size_t)u.pm * tstepA; u.B = B + (size_t)u.pn * tstepB; return true;
    }
    __device__ __forceinline__ bool carry(const Unit&) const { return false; }
};
struct DualOrder {
    int nM, nN, nwg, G, c; const char* A; const char* B; size_t tstepA, tstepB, segA, segB;
    __device__ void init(const void* A_, int lda, const void* B_, int ldb, int M, int N, int G_, int c_, size_t segA_, size_t segB_) { nM = M / BM; nN = N / BM; nwg = nM * nN; G = G_; c = c_; A = (const char*)A_; B = (const char*)B_; tstepA = (size_t)BM * lda * 2; tstepB = (size_t)BM * ldb * 2; segA = segA_; segB = segB_; }
    __device__ __forceinline__ bool next(int i, Unit& u) const {
        const long L = (long)(i >> 1) * G + c; if (L >= nwg) return false;
        tile_of((int)L, nM, nN, u.pm, u.pn); u.seg = i & 1; u.A = A + (size_t)u.pm * tstepA + (size_t)u.seg * segA; u.B = B + (size_t)u.pn * tstepB + (size_t)u.seg * segB; return true;
    }
    __device__ __forceinline__ bool carry(const Unit& u) const { return u.seg == 0; }
};

template <class Epi, class Sched, bool ALIGN_EPI>
__device__ __forceinline__ void gemm_phase(LAS unsigned char* lds, const Dims g, const Sched& S, const Epi& E) {
    const int tid = threadIdx.x, wid = __builtin_amdgcn_readfirstlane(tid >> 6), lane = tid & 63, wr = wid >> 2, wc = wid & 3, fr = lane & 15, fq = lane >> 4;
    const int nt = g.nt;
    unsigned voffA[2], voffB[2];
#pragma unroll
    for (int i = 0; i < 2; ++i) { int R, C; stage_rc(tid * 16 + i * 8192, R, C); voffA[i] = (unsigned)(R * g.lda + C) * 2u; voffB[i] = (unsigned)(R * g.ldb + C) * 2u; }
    const size_t kstep = (size_t)(BK * 2);
    const size_t hstepA = (size_t)HALF * g.lda * 2, hstepB = (size_t)HALF * g.ldb * 2;
    const unsigned ldsw = (unsigned)wid * 1024u;
    const int aoff = lds_byte(wr * 64 + fr, fq * 8), boff = lds_byte(wc * 32 + fr, fq * 8);
#define PG8_SA(b, h) (((b) * 2 + (h)) * HTB)
#define PG8_SB(b, h) ((4 + (b) * 2 + (h)) * HTB)
#define PG8_STAGE(bufoff, gbase, voff) do { _Pragma("unroll") for (int _i = 0; _i < 2; ++_i) \
        __builtin_amdgcn_global_load_lds((const unsigned*)((const char*)(gbase) + (voff)[_i]), (LAS unsigned*)(lds + (bufoff) + ldsw + _i * 8192), 16, 0, 0); } while (0)
#define PG8_LDA(dst, b, h) do { _Pragma("unroll") for (int m = 0; m < 4; ++m) _Pragma("unroll") for (int k = 0; k < 2; ++k) dst[m][k] = *(const LAS bf16x8*)(lds + PG8_SA(b, h) + aoff + m * 2048 + k * 1024); } while (0)
#define PG8_LDB(dst, b, h) do { _Pragma("unroll") for (int n = 0; n < 2; ++n) _Pragma("unroll") for (int k = 0; k < 2; ++k) dst[n][k] = *(const LAS bf16x8*)(lds + PG8_SB(b, h) + boff + n * 2048 + k * 1024); } while (0)
#define PG8_MMA(ai, bj, At, Bt) do { __builtin_amdgcn_s_setprio(1); _Pragma("unroll") for (int m = 0; m < 4; ++m) _Pragma("unroll") for (int n = 0; n < 2; ++n) _Pragma("unroll") for (int k = 0; k < 2; ++k) \
        acc[ai][bj][m][n] = __builtin_amdgcn_mfma_f32_16x16x32_bf16(Bt[n][k], At[m][k], acc[ai][bj][m][n], 0, 0, 0); __builtin_amdgcn_s_setprio(0); } while (0)
#define PG8_WAIT_V(n) asm volatile("s_waitcnt vmcnt(" #n ")" ::: "memory")
#define PG8_WAIT_L(n) asm volatile("s_waitcnt lgkmcnt(" #n ")" ::: "memory")
#define PG8_BAR __builtin_amdgcn_s_barrier()
#define PG8_SCHED __builtin_amdgcn_sched_barrier(0)
    Unit cur, nxt; int ui = 0;
    if (!S.next(0, cur)) return;
    f32x4 acc[2][2][4][2];
#pragma unroll
    for (int a = 0; a < 2; ++a)
#pragma unroll
        for (int b = 0; b < 2; ++b)
#pragma unroll
            for (int m = 0; m < 4; ++m)
#pragma unroll
                for (int n = 0; n < 2; ++n) acc[a][b][m][n] = (f32x4){0.f, 0.f, 0.f, 0.f};
    bf16x8 At[4][2], B0[2][2], B1[2][2];
    const char* cA = cur.A; const char* cB = cur.B;
    PG8_STAGE(PG8_SB(0, 0), cB, voffB); PG8_STAGE(PG8_SB(0, 1), cB + hstepB, voffB); PG8_STAGE(PG8_SA(0, 0), cA, voffA); PG8_STAGE(PG8_SA(0, 1), cA + hstepA, voffA);
    if (wr == 1) PG8_BAR;
    PG8_WAIT_V(2); PG8_BAR;
    PG8_STAGE(PG8_SB(1, 0), cB + kstep, voffB); PG8_STAGE(PG8_SA(1, 0), cA + kstep, voffA); PG8_STAGE(PG8_SB(1, 1), cB + hstepB + kstep, voffB);
    PG8_WAIT_V(6); PG8_BAR;
    for (;;) {
        const bool has_next = S.next(ui + 1, nxt);
        const char* nA = has_next ? nxt.A : cA; const char* nB = has_next ? nxt.B : cB;
        for (int t = 0; t < nt; t += 2) {
            const bool last = (t == nt - 2);
            const char* a1 = cA + (size_t)(t + 1) * kstep;
            const char* a2 = last ? nA : cA + (size_t)(t + 2) * kstep; const char* b2 = last ? nB : cB + (size_t)(t + 2) * kstep;
            const char* a3 = a2 + kstep; const char* b3 = b2 + kstep;
            PG8_LDB(B0, 0, 0); PG8_LDB(B1, 0, 1); PG8_SCHED; PG8_LDA(At, 0, 0); PG8_STAGE(PG8_SA(1, 1), a1 + hstepA, voffA);
            PG8_WAIT_V(8); PG8_WAIT_L(0); PG8_BAR; PG8_MMA(0, 0, At, B0); PG8_MMA(0, 1, At, B1); PG8_BAR; PG8_SCHED;
            PG8_LDA(At, 0, 1); PG8_STAGE(PG8_SB(0, 0), b2, voffB); PG8_STAGE(PG8_SB(0, 1), b2 + hstepB, voffB); PG8_STAGE(PG8_SA(0, 0), a2, voffA);
            PG8_WAIT_V(8); PG8_WAIT_L(0); PG8_BAR; PG8_MMA(1, 0, At, B0); PG8_MMA(1, 1, At, B1); PG8_BAR; PG8_SCHED;
            PG8_LDB(B0, 1, 0); PG8_LDB(B1, 1, 1); PG8_SCHED; PG8_LDA(At, 1, 0); PG8_STAGE(PG8_SA(0, 1), a2 + hstepA, voffA);
            PG8_WAIT_V(8); PG8_WAIT_L(0); PG8_BAR; PG8_MMA(0, 0, At, B0); PG8_MMA(0, 1, At, B1); PG8_BAR; PG8_SCHED;
            PG8_LDA(At, 1, 1); PG8_STAGE(PG8_SB(1, 0), b3, voffB); PG8_STAGE(PG8_SB(1, 1), b3 + hstepB, voffB); PG8_STAGE(PG8_SA(1, 0), a3, voffA);
            PG8_WAIT_V(8); PG8_WAIT_L(0); PG8_BAR; PG8_MMA(1, 0, At, B0); PG8_MMA(1, 1, At, B1); PG8_BAR; PG8_SCHED;
        }
        if constexpr (ALIGN_EPI) { if (wr == 0) PG8_BAR; }
        if constexpr (!Epi::AFTER_DRAIN) { E(acc, cur, wr, wc, fr, fq); }
        if (!has_next) break;
        if (!S.carry(cur)) {
#pragma unroll
            for (int a = 0; a < 2; ++a)
#pragma unroll
                for (int b = 0; b < 2; ++b)
#pragma unroll
                    for (int m = 0; m < 4; ++m)
#pragma unroll
                        for (int n = 0; n < 2; ++n) acc[a][b][m][n] = (f32x4){0.f, 0.f, 0.f, 0.f};
        }
        cur = nxt; cA = nA; cB = nB; ++ui;
        if constexpr (ALIGN_EPI) { if (wr == 1) PG8_BAR; }
    }
    PG8_WAIT_V(0);
    if constexpr (!ALIGN_EPI) { if (wr == 0) PG8_BAR; }
    PG8_BAR;
    if constexpr (Epi::AFTER_DRAIN) { E.fused(acc, cur, wr, wc, fr, fq, lds, wid, lane); }
#undef PG8_SA
#undef PG8_SB
#undef PG8_STAGE
#undef PG8_LDA
#undef PG8_LDB
#undef PG8_MMA
#undef PG8_WAIT_V
#undef PG8_WAIT_L
#undef PG8_BAR
#undef PG8_SCHED
}
}

typedef f32x4 acc_t[2][2][4][2];

struct EpiProj {
    static constexpr bool AFTER_DRAIN = false;
    const float* rstd; const float* bias; unsigned char* ws;
    __device__ __forceinline__ void operator()(acc_t& acc, const pg8::Unit& u, int wr, int wc, int fr, int fq) const {
        const int pn = u.pn, row0 = u.pm * 256 + wr * 64 + fr;
        f32x4 bv[2][2];
#pragma unroll
        for (int bj = 0; bj < 2; ++bj)
#pragma unroll
            for (int n = 0; n < 2; ++n) bv[bj][n] = *(const f32x4*)(bias + pn * 256 + bj * 128 + wc * 32 + n * 16 + 4 * fq);
        if (pn == 21) {
            if (wc == 0) {
                float* sm = (float*)(ws + WS_SM);
#pragma unroll
                for (int ai = 0; ai < 2; ++ai)
#pragma unroll
                    for (int m = 0; m < 4; ++m) { const int row = row0 + ai * 128 + m * 16; const float rs = rstd[row];
#pragma unroll
                        for (int n = 0; n < 2; ++n) *(f32x4*)(sm + (size_t)row * 32 + n * 16 + 4 * fq) = acc[ai][0][m][n] * rs + bv[0][n]; }
            }
            return;
        }
#ifdef DBG_SKIP_VO
        if (pn < 8) return;
#endif
        bf16_t* cb[2]; int ld, mode = 0;
        if (pn < 8) { bf16_t* b = (bf16_t*)(ws + (pn < 4 ? WS_QK : WS_VO)) + (pn & 3) * 256 + wc * 32; cb[0] = b; cb[1] = b + 128; ld = 1024; mode = (pn >= 6) ? 1 : 0; }
        else if (pn < 10) { bf16_t* b = (bf16_t*)(ws + WS_NQ) + (pn - 8) * 256 + wc * 32; cb[0] = b; cb[1] = b + 128; ld = 512; mode = 2; }
        else if (pn < 13) { bf16_t* b = (bf16_t*)(ws + WS_NKV) + (size_t)((pn - 10) * 4 + (wc >> 1)) * MTOK * 64 + 32 * (wc & 1); cb[0] = b; cb[1] = b + (size_t)2 * MTOK * 64; ld = 64; }
        else { bf16_t* b = (bf16_t*)(ws + WS_GT) + (pn - 13) * 256 + wc * 32; cb[0] = b; cb[1] = b + 128; ld = 2048; mode = 1; }
#pragma unroll
        for (int ai = 0; ai < 2; ++ai)
#pragma unroll
            for (int m = 0; m < 4; ++m) { const int row = row0 + ai * 128 + m * 16; const float rs = rstd[row];
#pragma unroll
                for (int bj = 0; bj < 2; ++bj)
#pragma unroll
                    for (int n = 0; n < 2; ++n) { f32x4 v = acc[ai][bj][m][n] * rs + bv[bj][n];
                        if (mode == 1) { v[0] = sigmoidf_(v[0]); v[1] = sigmoidf_(v[1]); v[2] = sigmoidf_(v[2]); v[3] = sigmoidf_(v[3]); }
                        else if (mode == 2) v = v * 0.125f;
                        u32x2 w; w.x = cvtpk(v[0], v[1]); w.y = cvtpk(v[2], v[3]);
                        *(u32x2*)(cb[bj] + (size_t)row * ld + n * 16 + 4 * fq) = w; } }
    }
};

struct EpiBranch {
    static constexpr bool AFTER_DRAIN = false;
    const bf16_t* gt; bf16_t* mixed;
    __device__ __forceinline__ void operator()(acc_t& acc, const pg8::Unit& u, int wr, int wc, int fr, int fq) const {
        const int row0 = u.pm * 256 + wr * 64 + fr, col0 = u.pn * 256 + wc * 32 + 4 * fq;
#pragma unroll
        for (int ai = 0; ai < 2; ++ai)
#pragma unroll
            for (int m = 0; m < 4; ++m) { const int row = row0 + ai * 128 + m * 16;
#pragma unroll
                for (int bj = 0; bj < 2; ++bj)
#pragma unroll
                    for (int n = 0; n < 2; ++n) { const int col = col0 + bj * 128 + n * 16;
                        const u32x2 q1 = *(const u32x2*)(gt + (size_t)row * 2048 + 1024 + col);
                        const f32x4 g1 = {bflo(q1.x), bfhi(q1.x), bflo(q1.y), bfhi(q1.y)};
                        if (u.seg == 0) {
                            const u32x2 q0 = *(const u32x2*)(gt + (size_t)row * 2048 + col);
                            const f32x4 g0 = {bflo(q0.x), bfhi(q0.x), bflo(q0.y), bfhi(q0.y)};
                            f32x4 a = acc[ai][bj][m][n];
#pragma unroll
                            for (int e = 0; e < 4; ++e) a[e] = a[e] * g0[e] * __builtin_amdgcn_rcpf(fmaxf(g1[e], 1e-18f));
                            acc[ai][bj][m][n] = a;
                        } else {
                            const f32x4 v = acc[ai][bj][m][n] * g1; u32x2 w; w.x = cvtpk(v[0], v[1]); w.y = cvtpk(v[2], v[3]);
                            *(u32x2*)(mixed + (size_t)row * 1024 + col) = w;
                        } } }
    }
};

struct EpiResid {
    static constexpr bool AFTER_DRAIN = false;
    const float* base; float* out; bf16_t* outb; float* part;
    __device__ __forceinline__ void operator()(acc_t& acc, const pg8::Unit& u, int wr, int wc, int fr, int fq) const {
        const int row0 = u.pm * 256 + wr * 64 + fr, col0 = u.pn * 256 + wc * 32 + 4 * fq;
#pragma unroll
        for (int ai = 0; ai < 2; ++ai)
#pragma unroll
            for (int m = 0; m < 4; ++m) { const int row = row0 + ai * 128 + m * 16; float ss = 0.f;
#pragma unroll
                for (int bj = 0; bj < 2; ++bj)
#pragma unroll
                    for (int n = 0; n < 2; ++n) { const size_t off = (size_t)row * 1024 + col0 + bj * 128 + n * 16;
                        const f32x4 v = acc[ai][bj][m][n] + *(const f32x4*)(base + off);
                        ss += (v[0] * v[0] + v[1] * v[1]) + (v[2] * v[2] + v[3] * v[3]);
                        *(f32x4*)(out + off) = v;
                        if (outb) { u32x2 w; w.x = cvtpk(v[0], v[1]); w.y = cvtpk(v[2], v[3]); *(u32x2*)(outb + off) = w; } }
                ss += __shfl_xor(ss, 16); ss += __shfl_xor(ss, 32);
                if (fq == 0) part[((size_t)u.pn * MTOK + row) * 4 + wc] = ss; }
    }
};

struct EpiGateUp {
    static constexpr bool AFTER_DRAIN = false;
    const float* part; bf16_t* hid;
    __device__ __forceinline__ void operator()(acc_t& acc, const pg8::Unit& u, int wr, int wc, int fr, int fq) const {
        const int row0 = u.pm * 256 + wr * 64 + fr, col0 = u.pn * 128 + wc * 16 + 4 * fq;
#pragma unroll
        for (int ai = 0; ai < 2; ++ai)
#pragma unroll
            for (int m = 0; m < 4; ++m) { const int row = row0 + ai * 128 + m * 16;
                const f32x4 p0 = *(const f32x4*)(part + (size_t)row * 4), p1 = *(const f32x4*)(part + ((size_t)MTOK + row) * 4), p2 = *(const f32x4*)(part + ((size_t)2 * MTOK + row) * 4), p3 = *(const f32x4*)(part + ((size_t)3 * MTOK + row) * 4);
                const float ss = ((p0[0] + p0[1]) + (p0[2] + p0[3])) + ((p1[0] + p1[1]) + (p1[2] + p1[3])) + ((p2[0] + p2[1]) + (p2[2] + p2[3])) + ((p3[0] + p3[1]) + (p3[2] + p3[3]));
                const float rs = rsqrtf(ss * (1.0f / 1024.0f) + RMS_EPS);
#pragma unroll
                for (int bj = 0; bj < 2; ++bj) { const f32x4 g = acc[ai][bj][m][0] * rs, up = acc[ai][bj][m][1] * rs; f32x4 y;
#pragma unroll
                    for (int e = 0; e < 4; ++e) y[e] = g[e] * sigmoidf_(g[e]) * up[e];
                    u32x2 w; w.x = cvtpk(y[0], y[1]); w.y = cvtpk(y[2], y[3]);
                    *(u32x2*)(hid + (size_t)row * D_FF + col0 + bj * 64) = w; } }
    }
};

struct Args {
    const float* x; const float* g_norm_mix; const float* w_in; const float* b_in; const float* b_fgate; const float* conv_qk; const float* g_mlstm_head; const float* pe_cmp;
    const float* w_cmp1; const float* w_cmp2; const float* rel_bias; const float* w_branch; const float* w_out; const float* g_norm_ffn; const float* w_gate; const float* w_up;
    const float* w_down; const float* g_final;
    float* out; unsigned char* ws; int ph_lo, ph_hi, coop, pad;
};
constexpr int NWAVES = 8, NTHREADS = 512;
constexpr int RING_BYTES = 131072, LDS_BYTES = 147456;

__device__ __forceinline__ int rel_bucket_dev(int n) {
    if (n < 16) return n < 0 ? 0 : n;
    int b = 16;
    b += (n >= 21); b += (n >= 27); b += (n >= 35); b += (n >= 46); b += (n >= 59); b += (n >= 77); b += (n >= 99); b += (n >= 128);
    b += (n >= 166); b += (n >= 216); b += (n >= 280); b += (n >= 363); b += (n >= 470); b += (n >= 609); b += (n >= 790);
    return b;
}

struct ColSrc { const float* p; int ld; };
template <class F>
__device__ __forceinline__ void tr_item(const F& f, const float* kscale, bf16_t* WT, int K, int nblk, int item, LAS float* scr, int lane) {
    const int kb = item / nblk, nb = item % nblk, k0 = 64 * kb, n0 = 32 * nb;
    const ColSrc cs = f(n0 + (lane & 31));
#pragma unroll 8
    for (int i = 0; i < 32; ++i) { const int kk = 2 * i + (lane >> 5); float v = cs.p ? cs.p[(size_t)(k0 + kk) * cs.ld] : 0.f; if (kscale) v *= kscale[k0 + kk]; scr[kk * 33 + (lane & 31)] = v; }
    asm volatile("s_waitcnt lgkmcnt(0)" ::: "memory");
    const int c = lane & 7;
#pragma unroll
    for (int j = 0; j < 4; ++j) { const int n = (lane >> 3) + 8 * j; const LAS float* s = scr + (8 * c) * 33 + n;
        u32x4 o; o.x = cvtpk(s[0 * 33], s[1 * 33]); o.y = cvtpk(s[2 * 33], s[3 * 33]); o.z = cvtpk(s[4 * 33], s[5 * 33]); o.w = cvtpk(s[6 * 33], s[7 * 33]);
        *(u32x4*)(WT + (size_t)(n0 + n) * K + k0 + 8 * c) = o; }
    asm volatile("s_waitcnt lgkmcnt(0)" ::: "memory");
}
__device__ __forceinline__ int proj_src_col(int n) {
    if (n < 2048) return n;
    if (n < 2560) return 2056 + (n - 2048);
    if (n < 3328) return 2568 + (n - 2560);
    if (n < 5376) return 3360 + (n - 3328);
    const int x = n - 5376;
    if (x < 8) return 2048 + x;
    if (x < 32) return 3336 + (x - 8);
    return -1;
}
struct SrcW1 { const float* w; __device__ ColSrc operator()(int n) const { const int c = proj_src_col(n); return ColSrc{c >= 0 ? w + c : nullptr, D_IN}; } };
struct SrcGU { const float* wg; const float* wu; __device__ ColSrc operator()(int n) const { const int G = n >> 4; const uintptr_t pg = (uintptr_t)wg, pu = (uintptr_t)wu; const uintptr_t sel = pg ^ ((pg ^ pu) & (uintptr_t)(0 - (long long)(G & 1)));
    return ColSrc{(const float*)sel + 16 * (G >> 1) + (n & 15), D_FF}; } };
struct SrcPlain { const float* w; int ld; __device__ ColSrc operator()(int n) const { return ColSrc{w + n, ld}; } };
struct SrcBr { const float* w; __device__ ColSrc operator()(int n) const { return ColSrc{w + (size_t)(n >> 10) * 512 * 1024 + (n & 1023), 1024}; } };
struct SrcC1 { const float* w; __device__ ColSrc operator()(int n) const { const int j = n >> 8, q = n & 255; return ColSrc{w + (size_t)j * 2048 * 128 + (q >= 128 ? 1024 * 128 : 0) + (q & 127), 128}; } };
struct SrcC2 { const float* w; __device__ ColSrc operator()(int n) const { return ColSrc{w + (size_t)(n >> 6) * 128 * 64 + (n & 63), 64}; } };

__device__ __forceinline__ void p0_prologue(const Args& a, LAS unsigned char* lds, int vcu, int G, int wave, int lane) {
    unsigned char* ws = a.ws;
    LAS float* scr = (LAS float*)(lds + wave * 16384);
    const int gw = vcu * NWAVES + wave, NGW = G * NWAVES;
    constexpr int I_W1 = (1024 / 64) * (N1 / 32), I_GU = (1024 / 64) * (NGU / 32), I_DN = (D_FF / 64) * (1024 / 32), I_OUT = 16 * 32, I_BR = (512 / 64) * (2048 / 32), I_C1 = 16 * (512 / 32), I_C2 = 2 * (128 / 32);
    constexpr int I_PEB = 256, I_BIAS = N1 / 64, I_BT = 8 * (BIAS_LEN / 64);
    constexpr int NITEMS = I_W1 + I_GU + I_DN + I_OUT + I_BR + I_C1 + I_C2 + I_PEB + I_BIAS + I_BT;
    if (blockIdx.x == 0 && threadIdx.x < 64) ((unsigned*)(ws + WS_CTL))[threadIdx.x] = 0u;
    for (int it = gw; it < NITEMS; it += NGW) {
        int r = it;
        if (r < I_W1) { tr_item(SrcW1{a.w_in}, a.g_norm_mix, (bf16_t*)(ws + WS_W1T), 1024, N1 / 32, r, scr, lane); continue; } r -= I_W1;
        if (r < I_GU) { tr_item(SrcGU{a.w_gate, a.w_up}, a.g_norm_ffn, (bf16_t*)(ws + WS_WGUT), 1024, NGU / 32, r, scr, lane); continue; } r -= I_GU;
        if (r < I_DN) { tr_item(SrcPlain{a.w_down, 1024}, nullptr, (bf16_t*)(ws + WS_WDNT), D_FF, 1024 / 32, r, scr, lane); continue; } r -= I_DN;
        if (r < I_OUT) { tr_item(SrcPlain{a.w_out, 1024}, nullptr, (bf16_t*)(ws + WS_WOUTT), 1024, 1024 / 32, r, scr, lane); continue; } r -= I_OUT;
        if (r < I_BR) { tr_item(SrcBr{a.w_branch}, nullptr, (bf16_t*)(ws + WS_WBRT), 512, 2048 / 32, r, scr, lane); continue; } r -= I_BR;
        if (r < I_C1) { tr_item(SrcC1{a.w_cmp1}, nullptr, (bf16_t*)(ws + WS_WC1T), 1024, 512 / 32, r, scr, lane); continue; } r -= I_C1;
        if (r < I_C2) { tr_item(SrcC2{a.w_cmp2}, nullptr, (bf16_t*)(ws + WS_WC2T), 128, 128 / 32, r, scr, lane); continue; } r -= I_C2;
        if (r < I_PEB) {
            const int j = r >> 7, n = r & 127; const float* pe = a.pe_cmp + j * 2048; const float* w = a.w_cmp1 + (size_t)j * 2048 * 128 + n; float s = 0.f;
#pragma unroll 8
            for (int i = 0; i < 32; ++i) { const int k = i * 64 + lane; s += pe[k] * w[(size_t)k * 128]; }
            s = wave_sum(s); if (lane == 0) __hip_atomic_store((float*)(ws + WS_PEB) + r, s, __ATOMIC_RELAXED, __HIP_MEMORY_SCOPE_AGENT); continue; } r -= I_PEB;
        if (r < I_BIAS) { const int n = r * 64 + lane; const int c = proj_src_col(n); ((float*)(ws + WS_BIAS1))[n] = c >= 0 ? a.b_in[c] : 0.f; continue; } r -= I_BIAS;
        { const int h = r / (BIAS_LEN / 64), idx = (r % (BIAS_LEN / 64)) * 64 + lane;
          ((float*)(ws + WS_BTAB))[h * BIAS_LEN + idx] = a.rel_bias[rel_bucket_dev(idx - BIAS_PAD) * N_HEADS + h] * 1.4426950408889634f; }
    }
    bf16_t* xb = (bf16_t*)(ws + WS_XB); float* rsx = (float*)(ws + WS_RSX);
    for (int blk = gw; blk < MTOK / 32; blk += NGW) {
        float myrs = 0.f;
        for (int k = 0; k < 32; ++k) {
            const int m = blk * 32 + k;
            const f32x4* xr = (const f32x4*)(a.x + (size_t)m * 1024) + lane; f32x4 v[4]; float s = 0.f;
#pragma unroll
            for (int j = 0; j < 4; ++j) { v[j] = xr[64 * j]; s += (v[j][0] * v[j][0] + v[j][1] * v[j][1]) + (v[j][2] * v[j][2] + v[j][3] * v[j][3]); }
            s = wave_sum(s);
            u32x2* o = (u32x2*)(xb + (size_t)m * 1024) + lane;
#pragma unroll
            for (int j = 0; j < 4; ++j) { u32x2 w; w.x = cvtpk(v[j][0], v[j][1]); w.y = cvtpk(v[j][2], v[j][3]); o[64 * j] = w; }
            if (lane == k) myrs = rsqrtf(s * (1.0f / 1024.0f) + RMS_EPS);
        }
        if (lane < 32) rsx[blk * 32 + lane] = myrs;
    }
}

__device__ __forceinline__ void p8_final(const Args& a, int vcu, int G, int wave, int lane) {
    const float* part = (const float*)(a.ws + WS_PART2);
    const int gw = vcu * NWAVES + wave, NGW = G * NWAVES;
    f32x4 gv[4];
#pragma unroll
    for (int j = 0; j < 4; ++j) gv[j] = ((const f32x4*)a.g_final)[lane + 64 * j];
    for (int m = gw; m < MTOK; m += NGW) {
        float p = (lane < 16) ? part[((size_t)(lane >> 2) * MTOK + m) * 4 + (lane & 3)] : 0.f;
        p += __shfl_xor(p, 1); p += __shfl_xor(p, 2); p += __shfl_xor(p, 4); p += __shfl_xor(p, 8);
        const float rs = rsqrtf(__shfl(p, 0) * (1.0f / 1024.0f) + RMS_EPS);
        f32x4* xr = (f32x4*)(a.out + (size_t)m * 1024) + lane;
#pragma unroll
        for (int j = 0; j < 4; ++j) xr[64 * j] = xr[64 * j] * rs * gv[j];
    }
}

__device__ __forceinline__ int kpos16(int key) { return (key & ~12) | ((key & 4) << 1) | ((key & 8) >> 1); }
__device__ __forceinline__ float siluf_(float x) { return x * sigmoidf_(x); }

__device__ __forceinline__ void p2_conv_item(const Args& a, int item, int tid) {
    const bf16_t* qk = (const bf16_t*)(a.ws + WS_QK); bf16_t* qc = (bf16_t*)(a.ws + WS_XB);
    const int cg8 = tid & 127, tg = tid >> 7, ch = cg8 * 8, row0 = item * 32 + tg * 8, tl0 = row0 & (SEQ - 1);
    float w[4][8];
#pragma unroll
    for (int j = 0; j < 4; ++j) { const f32x4 w0 = *(const f32x4*)(a.conv_qk + j * 1024 + ch), w1 = *(const f32x4*)(a.conv_qk + j * 1024 + ch + 4);
        w[j][0] = w0[0]; w[j][1] = w0[1]; w[j][2] = w0[2]; w[j][3] = w0[3]; w[j][4] = w1[0]; w[j][5] = w1[1]; w[j][6] = w1[2]; w[j][7] = w1[3]; }
    const float osc = (ch >= 512) ? 0.08838834764831845f : 1.0f;
    float xw[3][8];
#pragma unroll
    for (int k = 0; k < 3; ++k) { const int tl = tl0 - 3 + k; u32x4 v = (u32x4){0u, 0u, 0u, 0u}; if (tl >= 0) v = *(const u32x4*)(qk + (size_t)(row0 - 3 + k) * 1024 + ch);
        xw[k][0] = bflo(v.x); xw[k][1] = bfhi(v.x); xw[k][2] = bflo(v.y); xw[k][3] = bfhi(v.y); xw[k][4] = bflo(v.z); xw[k][5] = bfhi(v.z); xw[k][6] = bflo(v.w); xw[k][7] = bfhi(v.w); }
#pragma unroll
    for (int t = 0; t < 8; ++t) {
        const u32x4 v = *(const u32x4*)(qk + (size_t)(row0 + t) * 1024 + ch);
        float x[8] = {bflo(v.x), bfhi(v.x), bflo(v.y), bfhi(v.y), bflo(v.z), bfhi(v.z), bflo(v.w), bfhi(v.w)}; float y[8];
#pragma unroll
        for (int e = 0; e < 8; ++e) { const float s = w[0][e] * xw[0][e] + w[1][e] * xw[1][e] + w[2][e] * xw[2][e] + w[3][e] * x[e]; y[e] = siluf_(s) * osc; xw[0][e] = xw[1][e]; xw[1][e] = xw[2][e]; xw[2][e] = x[e]; }
        u32x4 o; o.x = cvtpk(y[0], y[1]); o.y = cvtpk(y[2], y[3]); o.z = cvtpk(y[4], y[5]); o.w = cvtpk(y[6], y[7]);
        *(u32x4*)(qc + (size_t)(row0 + t) * 1024 + ch) = o;
    }
}
__device__ __forceinline__ void p2_vt_item(const Args& a, int it, LAS unsigned char* scr, int lane) {
    const int which = it >> 10, rem = it & 1023, bg = rem >> 5, blk = rem & 31, b = bg >> 1, g = bg & 1;
    const bf16_t* src = (const bf16_t*)(a.ws + WS_NKV) + ((size_t)((which ? 10 : 6) + g) * MTOK + (size_t)b * SEQ + blk * 64) * 64;
    bf16_t* dst = (bf16_t*)(a.ws + (which ? WS_VWT : WS_VST)) + (size_t)(bg * 32 + blk) * 4096;
    LAS unsigned short* s = (LAS unsigned short*)scr;
#pragma unroll
    for (int i = 0; i < 8; ++i) { const int key = i * 8 + (lane >> 3), c = lane & 7; const u32x4 v = *(const u32x4*)(src + key * 64 + c * 8); const int p = (key & ~15) | kpos16(key & 15);
        s[(c * 8 + 0) * 72 + p] = (unsigned short)(v.x & 0xffff); s[(c * 8 + 1) * 72 + p] = (unsigned short)(v.x >> 16); s[(c * 8 + 2) * 72 + p] = (unsigned short)(v.y & 0xffff); s[(c * 8 + 3) * 72 + p] = (unsigned short)(v.y >> 16);
        s[(c * 8 + 4) * 72 + p] = (unsigned short)(v.z & 0xffff); s[(c * 8 + 5) * 72 + p] = (unsigned short)(v.z >> 16); s[(c * 8 + 6) * 72 + p] = (unsigned short)(v.w & 0xffff); s[(c * 8 + 7) * 72 + p] = (unsigned short)(v.w >> 16); }
    asm volatile("s_waitcnt lgkmcnt(0)" ::: "memory");
#pragma unroll
    for (int i = 0; i < 8; ++i) { const int d = i * 8 + (lane >> 3), c = lane & 7; *(u32x4*)(dst + d * 64 + c * 8) = *(const LAS u32x4*)(scr + d * 144 + c * 16); }
    asm volatile("s_waitcnt lgkmcnt(0)" ::: "memory");
}
struct CmpOrder {
    int c; const char* A; const char* B;
    __device__ __forceinline__ bool next(int i, pg8::Unit& u) const { if (i != 0 || c >= 32) return false; u.pm = c & 7; u.pn = c >> 3; u.seg = 0; u.A = A + (size_t)(c >> 3) * MTOK * 64 * 2 + (size_t)(c & 7) * 256 * 1024 * 2; u.B = B + (size_t)(c >> 4) * 256 * 1024 * 2; return true; }
    __device__ __forceinline__ bool carry(const pg8::Unit&) const { return false; }
};
struct EpiCmp {
    static constexpr bool AFTER_DRAIN = true;
    const float* peb; const bf16_t* wc2t; bf16_t* kc; bf16_t* vct;
    __device__ __forceinline__ void operator()(acc_t&, const pg8::Unit&, int, int, int, int) const {}
    __device__ __forceinline__ void fused(acc_t& acc, const pg8::Unit& u, int wr, int wc, int fr, int fq, LAS unsigned char* lds, int wid, int lane) const {
        const int p = u.pn, jj = p >> 1, g = p & 1;
        LAS float* hb = (LAS float*)lds;
#pragma unroll
        for (int ai = 0; ai < 2; ++ai)
#pragma unroll
            for (int m = 0; m < 4; ++m) { const int r = ai * 128 + wr * 64 + m * 16 + fr;
#pragma unroll
                for (int n = 0; n < 2; ++n) { const int cu = (32 * wc + 16 * n + 4 * fq) >> 2; *(LAS f32x4*)(hb + r * 128 + ((cu ^ (r & 15)) << 2)) = acc[ai][1][m][n]; } }
        asm volatile("s_waitcnt lgkmcnt(0)" ::: "memory"); __builtin_amdgcn_s_barrier(); asm volatile("" ::: "memory");
#pragma unroll
        for (int ai = 0; ai < 2; ++ai)
#pragma unroll
            for (int m = 0; m < 4; ++m) { const int r = ai * 128 + wr * 64 + m * 16 + fr, r1 = (r + 1) & 255;
#pragma unroll
                for (int n = 0; n < 2; ++n) { const int col = 32 * wc + 16 * n + 4 * fq, cu = col >> 2;
                    const f32x4 bt = *(const LAS f32x4*)(hb + r1 * 128 + ((cu ^ (r1 & 15)) << 2)); const f32x4 pb = *(const f32x4*)(peb + jj * 128 + col);
                    f32x4 v = acc[ai][0][m][n] + bt + pb; v[0] = siluf_(v[0]); v[1] = siluf_(v[1]); v[2] = siluf_(v[2]); v[3] = siluf_(v[3]); acc[ai][0][m][n] = v; } }
        asm volatile("s_waitcnt lgkmcnt(0)" ::: "memory"); __builtin_amdgcn_s_barrier(); asm volatile("" ::: "memory");
#pragma unroll
        for (int ai = 0; ai < 2; ++ai)
#pragma unroll
            for (int m = 0; m < 4; ++m) { const int r = ai * 128 + wr * 64 + m * 16 + fr;
#pragma unroll
                for (int n = 0; n < 2; ++n) { const int col = 32 * wc + 16 * n + 4 * fq; const f32x4 v = acc[ai][0][m][n]; u32x2 w; w.x = cvtpk(v[0], v[1]); w.y = cvtpk(v[2], v[3]); *(LAS u32x2*)(lds + r * 272 + col * 2) = w; } }
        asm volatile("s_waitcnt lgkmcnt(0)" ::: "memory"); __builtin_amdgcn_s_barrier(); asm volatile("" ::: "memory");
        const bf16_t* w2 = wc2t + jj * 64 * 128;
        bf16x8 wf[4][4];
#pragma unroll
        for (int dt = 0; dt < 4; ++dt)
#pragma unroll
            for (int s = 0; s < 4; ++s) wf[dt][s] = *(const bf16x8*)(w2 + (dt * 16 + fr) * 128 + 32 * s + 8 * fq);
#pragma unroll
        for (int rt = 0; rt < 2; ++rt) {
            const int r = wid * 32 + rt * 16 + fr; bf16x8 hf[4];
#pragma unroll
            for (int s = 0; s < 4; ++s) hf[s] = *(const LAS bf16x8*)(lds + r * 272 + (32 * s + 8 * fq) * 2);
            const int crow = u.pm * 256 + r, b = crow >> 7, c = crow & 127; const bool zero = (c == 127);
#pragma unroll
            for (int dt = 0; dt < 4; ++dt) { f32x4 o = {0.f, 0.f, 0.f, 0.f};
#pragma unroll
                for (int s = 0; s < 4; ++s) o = __builtin_amdgcn_mfma_f32_16x16x32_bf16(wf[dt][s], hf[s], o, 0, 0, 0);
                if (zero) o = (f32x4){0.f, 0.f, 0.f, 0.f};
                const int dd = dt * 16 + 4 * fq;
                if (jj == 0) { u32x2 w; w.x = cvtpk(o[0], o[1]); w.y = cvtpk(o[2], o[3]); *(u32x2*)(kc + ((size_t)(b * 2 + g) * 128 + c) * 64 + dd) = w; }
                else { bf16_t* vb = vct + ((size_t)(b * 2 + g) * 2 + (c >> 6)) * 4096 + ((c & 48) | kpos16(c & 15));
#pragma unroll
                    for (int e = 0; e < 4; ++e) vb[(dd + e) * 64] = (bf16_t)(cvtpk(o[e], 0.f) & 0xffff); } }
        }
    }
};
__device__ __forceinline__ void p2_prep(const Args& a, LAS unsigned char* lds, int bx, int G, int wave, int lane) {
    unsigned char* ws = a.ws;
    {
        CmpOrder S{bx, (const char*)(ws + WS_NKV), (const char*)(ws + WS_WC1T)};
        EpiCmp E{(const float*)(ws + WS_PEB), (const bf16_t*)(ws + WS_WC2T), (bf16_t*)(ws + WS_KC), (bf16_t*)(ws + WS_VCT)};
        pg8::gemm_phase<EpiCmp, CmpOrder, false>(lds, pg8::Dims{1024, 1024, 16}, S, E);
        __syncthreads();
    }
#ifndef DBG_SKIP_VO
    for (int it = bx; it < MTOK / 32; it += G) p2_conv_item(a, it, threadIdx.x);
#endif
#ifndef DBG_NO_VT
    for (int it = bx * NWAVES + wave; it < 2048; it += G * NWAVES) p2_vt_item(a, it, lds + wave * 16384, lane);
#endif
}

__device__ __forceinline__ int jpos32(int jj) { return ((jj & 12) << 1) | ((jj & 16) >> 2) | (jj & 3); }
__device__ __forceinline__ float logsigf_(float x) { return fminf(x, 0.f) - log1pf(__expf(-fabsf(x))); }
constexpr int ML_KS = 0, ML_VTS = 34816, ML_CS = 69632, ML_GV = 108800, ML_MI = 109312, ML_BCS = 109824, ML_WP = 110336, ML_SC = 110848;
__device__ __forceinline__ void mlstm_item(const Args& a, LAS unsigned char* lds, int b, int h, int tid, int wave, int lane) {
    const bf16_t* qc = (const bf16_t*)(a.ws + WS_XB); const bf16_t* vo = (const bf16_t*)(a.ws + WS_VO); const float* sm = (const float*)(a.ws + WS_SM); bf16_t* ys = (bf16_t*)(a.ws + WS_QK);
    asm volatile("" : "+v"(tid), "+v"(lane));
    const int w = wave, fr = lane & 15, g = lane >> 4;
    const float bfg = a.b_fgate[h];
    float m_prev = 0.f;
    f32x4 ct[9];
#pragma unroll
    for (int vt = 0; vt < 9; ++vt) ct[vt] = (f32x4){0.f, 0.f, 0.f, 0.f};
    bf16x8 ones; { const short o = (fr == 0) ? (short)0x3F80 : (short)0; ones = (bf16x8){o, o, o, o, o, o, o, o}; }
    for (int c = 0; c < NCHUNK; ++c) {
        const int r0 = b * SEQ + c * M_CHUNK;
#pragma unroll
        for (int i = 0; i < 4; ++i) { const int idx = tid + i * NTHREADS, j = idx >> 4, ch = idx & 15;
            const u32x4 kv = *(const u32x4*)(qc + (size_t)(r0 + j) * 1024 + 512 + h * 128 + ch * 8); *(LAS u32x4*)(lds + ML_KS + j * 272 + ch * 16) = kv;
            const u32x4 v = *(const u32x4*)(vo + (size_t)(r0 + j) * 1024 + h * 128 + ch * 8); const int p = (j & ~31) | jpos32(j & 31);
            LAS unsigned short* d = (LAS unsigned short*)(lds + ML_VTS + (ch * 8) * 272 + p * 2);
            d[0 * 136] = (unsigned short)(v.x & 0xffff); d[1 * 136] = (unsigned short)(v.x >> 16); d[2 * 136] = (unsigned short)(v.y & 0xffff); d[3 * 136] = (unsigned short)(v.y >> 16);
            d[4 * 136] = (unsigned short)(v.z & 0xffff); d[5 * 136] = (unsigned short)(v.z >> 16); d[6 * 136] = (unsigned short)(v.w & 0xffff); d[7 * 136] = (unsigned short)(v.w >> 16); }
        if (w == 0) {
            const int j0 = 2 * lane, j1 = j0 + 1;
            const float ip0 = sm[(size_t)(r0 + j0) * 32 + h], ip1 = sm[(size_t)(r0 + j1) * 32 + h];
            const float lf0 = logsigf_(sm[(size_t)(r0 + j0) * 32 + 4 + h] + bfg), lf1 = logsigf_(sm[(size_t)(r0 + j1) * 32 + 4 + h] + bfg);
            float s = lf0 + lf1;
#pragma unroll
            for (int o = 1; o < 64; o <<= 1) { const float t = __shfl_up(s, o); if (lane >= o) s += t; }
            const float bc1 = s, bc0 = s - lf1, gv0 = ip0 - bc0, gv1 = ip1 - bc1;
            float pm = fmaxf(gv0, gv1);
#pragma unroll
            for (int o = 1; o < 64; o <<= 1) { const float t = __shfl_up(pm, o); if (lane >= o) pm = fmaxf(pm, t); }
            float ex = __shfl_up(pm, 1); if (lane == 0) ex = -INFINITY;
            const float M0 = fmaxf(fmaxf(ex, gv0), m_prev), M1 = fmaxf(pm, m_prev);
            const float Ml = __shfl(M1, 63), bl = __shfl(bc1, 63);
            LAS float* GV = (LAS float*)(lds + ML_GV); LAS float* MI = (LAS float*)(lds + ML_MI); LAS float* BC = (LAS float*)(lds + ML_BCS); LAS float* WP = (LAS float*)(lds + ML_WP); LAS float* SC = (LAS float*)(lds + ML_SC);
            GV[j0] = gv0; GV[j1] = gv1; MI[j0] = M0; MI[j1] = M1; BC[j0] = bc0; BC[j1] = bc1; WP[j0] = __expf(gv0 - Ml); WP[j1] = __expf(gv1 - Ml);
            if (lane == 0) { SC[0] = bl + Ml; SC[1] = __expf(m_prev - Ml); }
        }
#pragma unroll
        for (int vt = 0; vt < 9; ++vt)
#pragma unroll
            for (int r = 0; r < 4; ++r) *(LAS unsigned short*)(lds + ML_CS + (16 * vt + 4 * g + r) * 272 + (16 * w + fr) * 2) = (unsigned short)(cvtpk(ct[vt][r], 0.f) & 0xffff);
        __syncthreads();
        const int irow = r0 + 16 * w + fr;
        bf16x8 qf[4];
#pragma unroll
        for (int s = 0; s < 4; ++s) qf[s] = *(const bf16x8*)(qc + (size_t)irow * 1024 + h * 128 + 32 * s + 8 * g);
        const float Mi = ((const LAS float*)(lds + ML_MI))[16 * w + fr], bci = ((const LAS float*)(lds + ML_BCS))[16 * w + fr];
        const float sint = __expf(m_prev - Mi);
        unsigned pk[8][2];
#pragma unroll
        for (int jt = 0; jt < 8; ++jt) {
            pk[jt][0] = 0u; pk[jt][1] = 0u;
            if (jt <= w) {
                f32x4 st = {0.f, 0.f, 0.f, 0.f};
#pragma unroll
                for (int s = 0; s < 4; ++s) st = __builtin_amdgcn_mfma_f32_16x16x32_bf16(*(const LAS bf16x8*)(lds + ML_KS + (16 * jt + fr) * 272 + (32 * s + 8 * g) * 2), qf[s], st, 0, 0, 0);
                const f32x4 gvv = *(const LAS f32x4*)(lds + ML_GV + (16 * jt + 4 * g) * 4); float p[4];
#pragma unroll
                for (int r = 0; r < 4; ++r) { const bool ok = (jt < w) || (4 * g + r <= fr); p[r] = ok ? st[r] * __expf(gvv[r] - Mi) : 0.f; }
                pk[jt][0] = cvtpk(p[0], p[1]); pk[jt][1] = cvtpk(p[2], p[3]);
            }
        }
        f32x4 hacc[9];
#pragma unroll
        for (int vt = 0; vt < 9; ++vt) {
            f32x4 hh = {0.f, 0.f, 0.f, 0.f};
#pragma unroll
            for (int s = 0; s < 4; ++s) hh = __builtin_amdgcn_mfma_f32_16x16x32_bf16(*(const LAS bf16x8*)(lds + ML_CS + (16 * vt + fr) * 272 + (32 * s + 8 * g) * 2), qf[s], hh, 0, 0, 0);
            hh = hh * sint;
#pragma unroll
            for (int s = 0; s < 4; ++s) if (2 * s <= w) {
                const bf16x8 av = (vt < 8) ? *(const LAS bf16x8*)(lds + ML_VTS + (16 * vt + fr) * 272 + (32 * s + 8 * g) * 2) : ones;
                const u32x4 pb = {pk[2 * s][0], pk[2 * s][1], pk[2 * s + 1][0], pk[2 * s + 1][1]};
                hh = __builtin_amdgcn_mfma_f32_16x16x32_bf16(av, __builtin_bit_cast(bf16x8, pb), hh, 0, 0, 0); }
            hacc[vt] = hh;
        }
        {
            const float den = __shfl(hacc[8][0], fr);
            const float inv = 1.0f / fmaxf(fabsf(den), __expf(-(bci + Mi)));
            float ss = 0.f;
#pragma unroll
            for (int vt = 0; vt < 8; ++vt) { hacc[vt] = hacc[vt] * inv; ss += (hacc[vt][0] * hacc[vt][0] + hacc[vt][1] * hacc[vt][1]) + (hacc[vt][2] * hacc[vt][2] + hacc[vt][3] * hacc[vt][3]); }
            ss += __shfl_xor(ss, 16); ss += __shfl_xor(ss, 32);
            const float rs = rsqrtf(ss * (1.0f / 128.0f) + RMS_EPS);
#pragma unroll
            for (int vt = 0; vt < 8; ++vt) { const int v0 = 16 * vt + 4 * g;
                const f32x4 gh = *(const f32x4*)(a.g_mlstm_head + h * 128 + v0); const u32x2 so = *(const u32x2*)(vo + (size_t)irow * 1024 + 512 + h * 128 + v0);
                const f32x4 y = {hacc[vt][0] * rs * gh[0] * bflo(so.x), hacc[vt][1] * rs * gh[1] * bfhi(so.x), hacc[vt][2] * rs * gh[2] * bflo(so.y), hacc[vt][3] * rs * gh[3] * bfhi(so.y)};
                u32x2 o; o.x = cvtpk(y[0], y[1]); o.y = cvtpk(y[2], y[3]); *(u32x2*)(ys + (size_t)irow * 1024 + h * 128 + v0) = o; }
        }
        {
            const float decay = ((const LAS float*)(lds + ML_SC))[1];
            bf16x8 kb[4];
#pragma unroll
            for (int s = 0; s < 4; ++s) {
                const f32x4 w0 = *(const LAS f32x4*)(lds + ML_WP + (32 * s + 4 * g) * 4), w1 = *(const LAS f32x4*)(lds + ML_WP + (32 * s + 16 + 4 * g) * 4); float kv[8];
#pragma unroll
                for (int e = 0; e < 4; ++e) { kv[e] = bf2f(*(const LAS unsigned short*)(lds + ML_KS + (32 * s + 4 * g + e) * 272 + (16 * w + fr) * 2)) * w0[e];
                    kv[4 + e] = bf2f(*(const LAS unsigned short*)(lds + ML_KS + (32 * s + 16 + 4 * g + e) * 272 + (16 * w + fr) * 2)) * w1[e]; }
                const u32x4 kk = {cvtpk(kv[0], kv[1]), cvtpk(kv[2], kv[3]), cvtpk(kv[4], kv[5]), cvtpk(kv[6], kv[7])}; kb[s] = __builtin_bit_cast(bf16x8, kk);
            }
#pragma unroll
            for (int vt = 0; vt < 9; ++vt) { f32x4 cc = ct[vt] * decay;
#pragma unroll
                for (int s = 0; s < 4; ++s) { const bf16x8 av = (vt < 8) ? *(const LAS bf16x8*)(lds + ML_VTS + (16 * vt + fr) * 272 + (32 * s + 8 * g) * 2) : ones;
                    cc = __builtin_amdgcn_mfma_f32_16x16x32_bf16(av, kb[s], cc, 0, 0, 0); }
                ct[vt] = cc; }
            m_prev = ((const LAS float*)(lds + ML_SC))[0];
        }
        __syncthreads();
    }
}

constexpr int NS_KB = 0, NS_VB = 18432, NS_BT = 36864, NS_IMP = NS_BT + 4 * BIAS_LEN * 4, NS_SEL = NS_IMP + 4 * 64 * 33 * 4, NS_END = NS_SEL + 256;
static_assert(NS_END <= 140 * 1024, "NSA LDS map");
constexpr float LOG2E = 1.4426950408889634f;
__device__ __forceinline__ int crow32(int r, int hi) { return (r & 3) + 8 * (r >> 2) + 4 * hi; }

struct NsaState { float m, l; f32x16 o[2]; };
__device__ __forceinline__ void ns_reset(NsaState& s) { s.m = -1e30f; s.l = 0.f;
#pragma unroll
    for (int r = 0; r < 16; ++r) { s.o[0][r] = 0.f; s.o[1][r] = 0.f; } }

__device__ __forceinline__ void ns_qk(f32x16& s0, f32x16& s1, const LAS unsigned char* kb, const bf16x8* qf, int q, int hi) {
#pragma unroll
    for (int r = 0; r < 16; ++r) { s0[r] = 0.f; s1[r] = 0.f; }
#pragma unroll
    for (int ks = 0; ks < 4; ++ks) {
        const bf16x8 a0 = *(const LAS bf16x8*)(kb + q * 144 + ks * 32 + hi * 16), a1 = *(const LAS bf16x8*)(kb + (32 + q) * 144 + ks * 32 + hi * 16);
        s0 = __builtin_amdgcn_mfma_f32_32x32x16_bf16(a0, qf[ks], s0, 0, 0, 0); s1 = __builtin_amdgcn_mfma_f32_32x32x16_bf16(a1, qf[ks], s1, 0, 0, 0);
    }
}
__device__ __forceinline__ void ns_pv(f32x16* o, const f32x16& p0, const f32x16& p1, const LAS unsigned char* vb, int q, int hi) {
    bf16x8 pf[4];
#pragma unroll
    for (int h2 = 0; h2 < 2; ++h2) { const u32x4 a = {cvtpk(p0[8 * h2 + 0], p0[8 * h2 + 1]), cvtpk(p0[8 * h2 + 2], p0[8 * h2 + 3]), cvtpk(p0[8 * h2 + 4], p0[8 * h2 + 5]), cvtpk(p0[8 * h2 + 6], p0[8 * h2 + 7])};
        const u32x4 b = {cvtpk(p1[8 * h2 + 0], p1[8 * h2 + 1]), cvtpk(p1[8 * h2 + 2], p1[8 * h2 + 3]), cvtpk(p1[8 * h2 + 4], p1[8 * h2 + 5]), cvtpk(p1[8 * h2 + 6], p1[8 * h2 + 7])};
        pf[h2] = __builtin_bit_cast(bf16x8, a); pf[2 + h2] = __builtin_bit_cast(bf16x8, b); }
#pragma unroll
    for (int dt = 0; dt < 2; ++dt)
#pragma unroll
        for (int ks = 0; ks < 4; ++ks) o[dt] = __builtin_amdgcn_mfma_f32_32x32x16_bf16(*(const LAS bf16x8*)(vb + (32 * dt + q) * 144 + ks * 32 + hi * 16), pf[ks], o[dt], 0, 0, 0);
}
template <int MODE>
__device__ __forceinline__ void ns_block(NsaState& st, const LAS unsigned char* kb, const LAS unsigned char* vb, const bf16x8* qf, const LAS float* bt, int dq, bool selbit, int q, int hi) {
    f32x16 s0, s1; ns_qk(s0, s1, kb, qf, q, hi);
    float mx = -1e30f;
#pragma unroll
    for (int r = 0; r < 16; ++r) {
        const int k0 = crow32(r, hi), d0 = dq - k0, d1 = d0 - 32;
        const bool v0 = MODE == 0 ? (selbit && d0 >= 0) : (d0 >= 0 && d0 < 512), v1 = MODE == 0 ? (selbit && d1 >= 0) : (d1 >= 0 && d1 < 512);
        const float x0 = s0[r] * LOG2E + bt[max(d0, -BIAS_PAD) + BIAS_PAD], x1 = s1[r] * LOG2E + bt[max(d1, -BIAS_PAD) + BIAS_PAD];
        s0[r] = v0 ? x0 : -1e30f; s1[r] = v1 ? x1 : -1e30f; mx = fmaxf(mx, fmaxf(s0[r], s1[r]));
    }
    mx = fmaxf(mx, __shfl_xor(mx, 32));
    const float mn = fmaxf(st.m, mx), sc = exp2f(st.m - mn); st.m = mn;
    float ls = 0.f;
#pragma unroll
    for (int r = 0; r < 16; ++r) { s0[r] = (s0[r] > -1e29f) ? exp2f(s0[r] - mn) : 0.f; s1[r] = (s1[r] > -1e29f) ? exp2f(s1[r] - mn) : 0.f; ls += s0[r] + s1[r]; }
    st.l = st.l * sc + ls;
#pragma unroll
    for (int r = 0; r < 16; ++r) { st.o[0][r] *= sc; st.o[1][r] *= sc; }
    ns_pv(st.o, s0, s1, vb, q, hi);
}
__device__ __forceinline__ void ns_finish(f32x16* out, NsaState& st, float gate) {
    const float lt = st.l + __shfl_xor(st.l, 32); const float f = gate / fmaxf(lt, 1e-30f);
#pragma unroll
    for (int r = 0; r < 16; ++r) { out[0][r] += st.o[0][r] * f; out[1][r] += st.o[1][r] * f; }
}
__device__ __forceinline__ void ns_load(u32x4& kr, u32x4& vr, const bf16_t* kblk, const bf16_t* vblk, int tid) { kr = *(const u32x4*)(kblk + tid * 8); vr = *(const u32x4*)(vblk + tid * 8); }
__device__ __forceinline__ void ns_store(LAS unsigned char* lds, int buf, const u32x4& kr, const u32x4& vr, int tid) {
    const int row = tid >> 3, c = tid & 7; *(LAS u32x4*)(lds + NS_KB + buf * 9216 + row * 144 + c * 16) = kr; *(LAS u32x4*)(lds + NS_VB + buf * 9216 + row * 144 + c * 16) = vr; }

__device__ __forceinline__ void nsa_unit(const Args& a, LAS unsigned char* lds, int b, int g, int qi, int& cur_g, int tid, int wave, int lane) {
    unsigned char* ws = a.ws;
    asm volatile("" : "+v"(tid), "+v"(lane));
    const int q = lane & 31, hi = lane >> 5, r = wave >> 1, th = wave & 1, head = g * 4 + r;
    const int tl = 64 * qi + 32 * th + q, row = b * SEQ + tl;
    const bf16_t* nkv = (const bf16_t*)(ws + WS_NKV);
    if (cur_g != g) { __syncthreads(); const float* bt = (const float*)(ws + WS_BTAB) + (size_t)g * 4 * BIAS_LEN;
#pragma unroll 1
        for (int i = tid; i < 4 * BIAS_LEN; i += NTHREADS) ((LAS float*)(lds + NS_BT))[i] = bt[i];
        cur_g = g; }
    const LAS float* btab = (const LAS float*)(lds + NS_BT) + r * BIAS_LEN;
    bf16x8 qf[4];
#pragma unroll
    for (int ks = 0; ks < 4; ++ks) qf[ks] = *(const bf16x8*)((const bf16_t*)(ws + WS_NQ) + (size_t)row * 512 + head * 64 + ks * 16 + hi * 8);
    const float* smr = (const float*)(ws + WS_SM) + (size_t)row * 32 + 8 + head * 3;
    const float gc = sigmoidf_(smr[0]), gs = sigmoidf_(smr[1]), gw = sigmoidf_(smr[2]);
    f32x16 out[2];
#pragma unroll
    for (int rr = 0; rr < 16; ++rr) { out[0][rr] = 0.f; out[1][rr] = 0.f; }
    NsaState st;
    u32x4 kr, vr;
    const int ncb = (qi >= 16) ? 2 : 1;
    {
        const bf16_t* kcb = (const bf16_t*)(ws + WS_KC) + (size_t)(b * 2 + g) * 128 * 64; const bf16_t* vcb = (const bf16_t*)(ws + WS_VCT) + (size_t)(b * 2 + g) * 2 * 4096;
        __syncthreads();
        ns_load(kr, vr, kcb, vcb, tid); ns_store(lds, 0, kr, vr, tid);
        if (ncb == 2) { ns_load(kr, vr, kcb + 4096, vcb + 4096, tid); ns_store(lds, 1, kr, vr, tid); }
        __syncthreads();
        f32x16 s[2][2];
        float mx = -1e30f;
#pragma unroll
        for (int cb = 0; cb < 2; ++cb) {
            if (cb < ncb) {
                ns_qk(s[cb][0], s[cb][1], lds + NS_KB + cb * 9216, qf, q, hi);
#pragma unroll
                for (int T = 0; T < 2; ++T)
#pragma unroll
                    for (int rr = 0; rr < 16; ++rr) { const int c = 64 * cb + 32 * T + crow32(rr, hi), d = tl - 16 * c - 31;
                        const float x = s[cb][T][rr] * LOG2E + btab[max(d, -BIAS_PAD) + BIAS_PAD]; s[cb][T][rr] = (d >= 0) ? x : -1e30f; mx = fmaxf(mx, s[cb][T][rr]); }
            } else {
#pragma unroll
                for (int rr = 0; rr < 16; ++rr) { s[cb][0][rr] = -1e30f; s[cb][1][rr] = -1e30f; }
            }
        }
        mx = fmaxf(mx, __shfl_xor(mx, 32));
        float ls = 0.f;
#pragma unroll
        for (int cb = 0; cb < 2; ++cb)
#pragma unroll
            for (int T = 0; T < 2; ++T)
#pragma unroll
                for (int rr = 0; rr < 16; ++rr) { const float e = (s[cb][T][rr] > -1e29f) ? exp2f(s[cb][T][rr] - mx) : 0.f; s[cb][T][rr] = e; ls += e; }
        ns_pv(out, s[0][0], s[0][1], lds + NS_VB, q, hi);
        if (ncb == 2) ns_pv(out, s[1][0], s[1][1], lds + NS_VB + 9216, q, hi);
        const float lt = ls + __shfl_xor(ls, 32), rinv = 1.0f / fmaxf(lt, 1e-30f);
        { const float f = gc * rinv;
#pragma unroll
          for (int rr = 0; rr < 16; ++rr) { out[0][rr] *= f; out[1][rr] *= f; } }
        if (qi >= 16) {
            LAS float* imp = (LAS float*)(lds + NS_IMP) + (r * 64 + 32 * th + q) * 33;
            float prevB = 0.f;
#pragma unroll
            for (int cb = 0; cb < 2; ++cb)
#pragma unroll
                for (int T = 0; T < 2; ++T)
#pragma unroll
                    for (int q4 = 0; q4 < 4; ++q4) { const int n = cb * 8 + T * 4 + q4; const float p0 = s[cb][T][4 * q4] * rinv, p1 = s[cb][T][4 * q4 + 1] * rinv, p2 = s[cb][T][4 * q4 + 2] * rinv, p3 = s[cb][T][4 * q4 + 3] * rinv;
                        const float An = 2.0f * (p0 + p1 + p2) + p3, pb = __shfl_xor(p3, 32);
                        imp[2 * n + hi] = hi ? (An + pb) : (An + prevB); prevB = pb; }
        }
        __syncthreads();
        if (qi >= 16) {
            const int tq = tid >> 3, sub = tid & 7; const LAS float* ip = (const LAS float*)(lds + NS_IMP) + tq * 33;
            float sc[32];
#pragma unroll
            for (int j = 0; j < 32; ++j) sc[j] = ((ip[j] + ip[64 * 33 + j]) + ip[2 * 64 * 33 + j]) + ip[3 * 64 * 33 + j];
            unsigned bits = 0u;
#pragma unroll
            for (int jj = 0; jj < 4; ++jj) { const int j = sub * 4 + jj; int rank = 0;
                const float mine = ((ip[j] + ip[64 * 33 + j]) + ip[2 * 64 * 33 + j]) + ip[3 * 64 * 33 + j];
#pragma unroll
                for (int j2 = 0; j2 < 32; ++j2) { const bool cand = (j2 >= 1 && j2 <= qi - 2); rank += (cand && (sc[j2] > mine || (sc[j2] == mine && j2 < j))) ? 1 : 0; }
                const bool forced = (j == 0) || (j == qi) || (j == qi - 1);
                if (forced || (j >= 1 && j <= qi - 2 && rank < SEL_TOPK - 3)) bits |= 1u << j; }
            bits |= __shfl_xor(bits, 1); bits |= __shfl_xor(bits, 2); bits |= __shfl_xor(bits, 4);
            if (sub == 0) ((LAS unsigned*)(lds + NS_SEL))[tq] = bits;
        } else if (tid < 64) ((LAS unsigned*)(lds + NS_SEL))[tid] = (qi >= 31) ? 0xffffffffu : ((2u << qi) - 1u);
        __syncthreads();
    }
    const unsigned selm = ((const LAS unsigned*)(lds + NS_SEL))[32 * th + q];
    {
        const bf16_t* kb = nkv + ((size_t)(4 + g) * MTOK + (size_t)b * SEQ) * 64; const bf16_t* vb = (const bf16_t*)(ws + WS_VST) + (size_t)(b * 2 + g) * 32 * 4096;
        ns_reset(st);
        ns_load(kr, vr, kb, vb, tid);
        for (int j = 0; j <= qi; ++j) {
            ns_store(lds, j & 1, kr, vr, tid);
            __syncthreads();
            if (j < qi) ns_load(kr, vr, kb + (size_t)(j + 1) * 4096, vb + (size_t)(j + 1) * 4096, tid);
            ns_block<0>(st, lds + NS_KB + (j & 1) * 9216, lds + NS_VB + (j & 1) * 9216, qf, btab, tl - 64 * j, (selm >> j) & 1u, q, hi);
        }
        ns_finish(out, st, gs);
    }
    {
        const bf16_t* kb = nkv + ((size_t)(8 + g) * MTOK + (size_t)b * SEQ) * 64; const bf16_t* vb = (const bf16_t*)(ws + WS_VWT) + (size_t)(b * 2 + g) * 32 * 4096;
        const int j0 = qi >= 8 ? qi - 8 : 0;
        ns_reset(st);
        __syncthreads();
        ns_load(kr, vr, kb + (size_t)j0 * 4096, vb + (size_t)j0 * 4096, tid);
        for (int j = j0; j <= qi; ++j) {
            ns_store(lds, j & 1, kr, vr, tid);
            __syncthreads();
            if (j < qi) ns_load(kr, vr, kb + (size_t)(j + 1) * 4096, vb + (size_t)(j + 1) * 4096, tid);
            ns_block<1>(st, lds + NS_KB + (j & 1) * 9216, lds + NS_VB + (j & 1) * 9216, qf, btab, tl - 64 * j, true, q, hi);
        }
        ns_finish(out, st, gw);
    }
    bf16_t* yn = (bf16_t*)(ws + WS_QK) + (size_t)row * 1024 + 512 + head * 64;
#pragma unroll
    for (int dt = 0; dt < 2; ++dt)
#pragma unroll
        for (int q4 = 0; q4 < 4; ++q4) { u32x2 w; w.x = cvtpk(out[dt][4 * q4], out[dt][4 * q4 + 1]); w.y = cvtpk(out[dt][4 * q4 + 2], out[dt][4 * q4 + 3]); *(u32x2*)(yn + 32 * dt + 8 * q4 + 4 * hi) = w; }
}

__device__ __forceinline__ void p3_mixers(const Args& a, LAS unsigned char* lds, int tid, int wave, int lane) {
    unsigned* ctr = (unsigned*)(a.ws + WS_CTL);
    LAS unsigned* slot = (LAS unsigned*)(lds + 143 * 1024);
    int cur_g = -1;
    for (int it_ = 0;; ++it_) {
        __syncthreads();
#ifdef DBG_STATIC_Q
        if (tid == 0) *slot = (unsigned)(blockIdx.x + it_ * gridDim.x);
#else
        if (tid == 0) *slot = atomicAdd(ctr, 1u);
#endif
        __syncthreads();
        const int idx = (int)*slot;
        if (idx >= 64 + 1024) break;
        if (idx < 64) {
#ifdef DBG_NO_ML
            { const int b = idx >> 2, h = idx & 3; bf16_t* ym = (bf16_t*)(a.ws + WS_QK) + (size_t)b * SEQ * 1024 + h * 128;
              for (int i = tid; i < SEQ * 16; i += NTHREADS) *(u32x4*)(ym + (size_t)(i >> 4) * 1024 + (i & 15) * 8) = (u32x4){0u, 0u, 0u, 0u}; }
#else
            mlstm_item(a, lds, idx >> 2, idx & 3, tid, wave, lane);
#endif
            cur_g = -1; }
        else { const int u = idx - 64;
#ifdef DBG_NO_NSA
            { const int b = (u & 31) >> 1, g = u & 1, qi = 31 - (u >> 5); bf16_t* yn = (bf16_t*)(a.ws + WS_QK) + ((size_t)b * SEQ + qi * 64) * 1024 + 512 + g * 256;
              for (int i = tid; i < 64 * 32; i += NTHREADS) *(u32x4*)(yn + (size_t)(i >> 5) * 1024 + (i & 31) * 8) = (u32x4){0u, 0u, 0u, 0u}; }
#else
            nsa_unit(a, lds, (u & 31) >> 1, u & 1, 31 - (u >> 5), cur_g, tid, wave, lane);
#endif
        }
    }
}

__global__ void __launch_bounds__(NTHREADS, 2) mega_fwd(Args a) {
    extern __shared__ __attribute__((aligned(16))) unsigned char lds_raw[];
    LAS unsigned char* lds = (LAS unsigned char*)lds_raw;
    const int tid = threadIdx.x, lane = tid & 63, wave = __builtin_amdgcn_readfirstlane(tid >> 6);
    const int G = gridDim.x; const int bx = blockIdx.x; const int vcu = (G % 8 == 0) ? (bx % 8) * (G / 8) + bx / 8 : bx;
    cg::grid_group grid = cg::this_grid();
    unsigned char* ws = a.ws;
    const int lo = a.ph_lo, hi = a.ph_hi;
#define IN(k) (lo <= (k) && (k) < hi)
#define SEAM(k) do { if (IN(k) && IN((k) + 1)) { asm volatile("s_waitcnt vmcnt(0) lgkmcnt(0)" ::: "memory"); __builtin_amdgcn_fence(__ATOMIC_RELEASE, "agent"); asm volatile("s_waitcnt vmcnt(0)" ::: "memory"); grid.sync(); \
      \
    if (tid < 64) { __builtin_amdgcn_fence(__ATOMIC_ACQUIRE, "agent"); asm volatile("s_waitcnt vmcnt(0)" ::: "memory"); } __syncthreads(); } } while (0)

#ifdef DBG_DELAY
    if ((bx & 15) == 3) { const unsigned long long t0 = __builtin_amdgcn_s_memrealtime(); while (__builtin_amdgcn_s_memrealtime() - t0 < 40000ull) __builtin_amdgcn_s_sleep(16); }
#endif
    if (IN(0)) p0_prologue(a, lds, vcu, G, wave, lane);
    SEAM(0);
    if (IN(1)) {
        pg8::StaticOrder S; S.init(ws + WS_XB, 1024, ws + WS_W1T, 1024, MTOK, N1, G, bx);
        EpiProj E{(const float*)(ws + WS_RSX), (const float*)(ws + WS_BIAS1), ws};
        pg8::gemm_phase<EpiProj, pg8::StaticOrder, true>(lds, pg8::Dims{1024, 1024, 16}, S, E);
    }
    SEAM(1);
#ifndef DBG_NO_P2
    if (IN(2)) p2_prep(a, lds, bx, G, wave, lane);
#endif
    SEAM(2);
    if (IN(3)) {
        p3_mixers(a, lds, tid, wave, lane);
    }
    SEAM(3);
    if (IN(4)) {
        pg8::DualOrder S; S.init(ws + WS_QK, 1024, ws + WS_WBRT, 512, MTOK, 1024, G, bx, (size_t)512 * 2, (size_t)1024 * 512 * 2);
        EpiBranch E{(const bf16_t*)(ws + WS_GT), (bf16_t*)(ws + WS_VO)};
        pg8::gemm_phase<EpiBranch, pg8::DualOrder, true>(lds, pg8::Dims{1024, 512, 8}, S, E);
    }
    SEAM(4);
    if (IN(5)) {
        pg8::StaticOrder S; S.init(ws + WS_VO, 1024, ws + WS_WOUTT, 1024, MTOK, 1024, G, bx);
        EpiResid E{a.x, a.out, (bf16_t*)(ws + WS_XB), (float*)(ws + WS_PART1)};
        pg8::gemm_phase<EpiResid, pg8::StaticOrder, true>(lds, pg8::Dims{1024, 1024, 16}, S, E);
    }
    SEAM(5);
    if (IN(6)) {
#ifdef DBG_DELAY
        if ((bx & 15) == 5) { const unsigned long long t0 = __builtin_amdgcn_s_memrealtime(); while (__builtin_amdgcn_s_memrealtime() - t0 < 40000ull) __builtin_amdgcn_s_sleep(16); }
#endif
        pg8::StaticOrder S; S.init(ws + WS_XB, 1024, ws + WS_WGUT, 1024, MTOK, NGU, G, bx);
        EpiGateUp E{(const float*)(ws + WS_PART1), (bf16_t*)(ws + WS_HID)};
        pg8::gemm_phase<EpiGateUp, pg8::StaticOrder, true>(lds, pg8::Dims{1024, 1024, 16}, S, E);
    }
    SEAM(6);
#if defined(DBG_DUMP_HID)
    if (IN(7)) { const bf16_t* hid = (const bf16_t*)(ws + WS_VO);
        for (size_t i = (size_t)bx * NTHREADS + tid; i < (size_t)MTOK * 256; i += (size_t)G * NTHREADS) { const size_t row = i >> 8, c4 = (i & 255) * 4; const u32x2 v = *(const u32x2*)(hid + row * 1024 + c4);
            *(f32x4*)(a.out + row * 1024 + c4) = (f32x4){bflo(v.x), bfhi(v.x), bflo(v.y), bfhi(v.y)}; } }
    if (0) {
#else
    if (IN(7)) {
#endif
        pg8::StaticOrder S; S.init(ws + WS_HID, D_FF, ws + WS_WDNT, D_FF, MTOK, 1024, G, bx);
        EpiResid E{a.out, a.out, nullptr, (float*)(ws + WS_PART2)};
        pg8::gemm_phase<EpiResid, pg8::StaticOrder, true>(lds, pg8::Dims{D_FF, D_FF, D_FF / 64}, S, E);
    }
    SEAM(7);
#if !defined(DBG_DUMP_HID)
    if (IN(8)) p8_final(a, vcu, G, wave, lane);
#endif
#undef IN
#undef SEAM
}

constexpr int NPHASES = 9;
#ifndef N_LAUNCHES
#define N_LAUNCHES 1
#endif
extern "C" void kernel_launch(void* const* d_in, const int* in_sizes, int n_in, void* d_out, int out_size, void* d_ws, size_t ws_size, hipStream_t stream) {
    static int grid = 0;
    if (grid == 0) {
        if (n_in != 18 || out_size != MTOK * D_MODEL || ws_size < WS_END) { fprintf(stderr, "kernel_launch: unexpected shapes (n_in %d out %d ws %zu)\n", n_in, out_size, ws_size); grid = -1; return; }
        int dev = 0, cus = 0, per_cu = 0;
        if (hipGetDevice(&dev) != hipSuccess || hipDeviceGetAttribute(&cus, hipDeviceAttributeMultiprocessorCount, dev) != hipSuccess) { grid = -1; return; }
        if (hipFuncSetAttribute((const void*)mega_fwd, hipFuncAttributeMaxDynamicSharedMemorySize, LDS_BYTES) != hipSuccess) { fprintf(stderr, "kernel_launch: hipFuncSetAttribute failed\n"); grid = -1; return; }
        if (hipOccupancyMaxActiveBlocksPerMultiprocessor(&per_cu, (const void*)mega_fwd, NTHREADS, LDS_BYTES) != hipSuccess || per_cu < 1) { fprintf(stderr, "kernel_launch: occupancy query says %d blocks per CU\n", per_cu); per_cu = 1; }
        (void)hipGetLastError();
        grid = cus;
    }
    if (grid < 0) return;
    Args a{};
    const float** ap = (const float**)&a;
    for (int i = 0; i < 18; ++i) ap[i] = (const float*)d_in[i];
    a.out = (float*)d_out; a.ws = (unsigned char*)d_ws;
    if (N_LAUNCHES == 1) {
        a.ph_lo = 0; a.ph_hi = NPHASES; a.coop = 1; a.pad = 0;
        void* args[] = {&a};
        hipError_t e = hipLaunchCooperativeKernel((const void*)mega_fwd, dim3(grid), dim3(NTHREADS), args, LDS_BYTES, stream);
        if (e != hipSuccess) fprintf(stderr, "kernel_launch: cooperative launch failed: %s (grid %d)\n", hipGetErrorString(e), grid);
    } else {
        for (int p = 0; p < NPHASES; ++p) {
            a.ph_lo = p; a.ph_hi = p + 1; a.coop = 0; a.pad = 0;
            hipLaunchKernelGGL(mega_fwd, dim3(grid), dim3(NTHREADS), LDS_BYTES, stream, a);
        }
    }
}
```

```cpp
#include <hip/hip_runtime.h>
#include <hip/hip_cooperative_groups.h>
#include <cstdio>
#include <cstdint>
namespace cg = cooperative_groups;

#define LAS __attribute__((address_space(3)))
typedef unsigned short bf16_t;
typedef short bf16x8 __attribute__((ext_vector_type(8)));
typedef short s16x4 __attribute__((ext_vector_type(4)));
typedef float f32x4 __attribute__((ext_vector_type(4)));
typedef float f32x2 __attribute__((ext_vector_type(2)));
typedef float f32x16 __attribute__((ext_vector_type(16)));
typedef unsigned u32x4 __attribute__((ext_vector_type(4)));
typedef unsigned u32x2 __attribute__((ext_vector_type(2)));
typedef __bf16 bf16x2_t __attribute__((ext_vector_type(2)));

constexpr int D_MODEL = 1024, BATCH = 16, SEQ = 2048, MTOK = BATCH * SEQ;
constexpr int M_HEADS = 4, M_HD = 128, M_WIDTH = 512, M_CHUNK = 128, NCHUNK = SEQ / M_CHUNK;
constexpr int N_HEADS = 8, N_G = 2, N_R = 4, N_HD = 64;
constexpr int N_CMP = 127, N_SLC = 32, SEL_TOPK = 16;
constexpr int D_FF = 2816, D_IN = 5408;
constexpr int N1 = 5632;
constexpr int NGU = 2 * D_FF;
constexpr float RMS_EPS = 1e-6f;
constexpr int BIAS_PAD = 64, BIAS_LEN = SEQ + BIAS_PAD;

constexpr size_t KiB = 1024, MiB = 1u << 20;
constexpr size_t WS_CTL   = 0;
constexpr size_t WS_BIAS1 = 4 * KiB;
constexpr size_t WS_PEB   = 28 * KiB;
constexpr size_t WS_WC2T  = 32 * KiB;
constexpr size_t WS_BTAB  = 64 * KiB;
constexpr size_t WS_RSX   = 256 * KiB;
constexpr size_t WS_W1T   = 1 * MiB;
constexpr size_t WS_WGUT  = 12 * MiB;
constexpr size_t WS_WDNT  = 23 * MiB;
constexpr size_t WS_WOUTT = 29 * MiB;
constexpr size_t WS_WBRT  = 31 * MiB;
constexpr size_t WS_WC1T  = 33 * MiB;
constexpr size_t WS_PART1 = 34 * MiB;
constexpr size_t WS_PART2 = 36 * MiB;
constexpr size_t WS_KC    = 38 * MiB;
constexpr size_t WS_VCT   = 38 * MiB + 512 * KiB;
constexpr size_t WS_HAB   = 39 * MiB;
constexpr size_t WS_XB    = 48 * MiB;
constexpr size_t WS_QK    = 112 * MiB;
constexpr size_t WS_VO    = 176 * MiB;
constexpr size_t WS_NQ    = 240 * MiB;
constexpr size_t WS_NKV   = 272 * MiB;
constexpr size_t WS_HID   = 112 * MiB;
constexpr size_t WS_GT    = 320 * MiB;
constexpr size_t WS_SM    = 448 * MiB;
constexpr size_t WS_VST   = 452 * MiB;
constexpr size_t WS_VWT   = 460 * MiB;
constexpr size_t WS_END   = 468 * MiB;

__device__ __forceinline__ unsigned cvtpk(float lo, float hi) { f32x2 v = {lo, hi}; bf16x2_t b = __builtin_convertvector(v, bf16x2_t); return __builtin_bit_cast(unsigned, b); }
__device__ __forceinline__ float bf2f(unsigned short u) { return __uint_as_float(((unsigned)u) << 16); }
__device__ __forceinline__ float bflo(unsigned u) { return __uint_as_float(u << 16); }
__device__ __forceinline__ float bfhi(unsigned u) { return __uint_as_float(u & 0xffff0000u); }
__device__ __forceinline__ float sigmoidf_(float x) { return __builtin_amdgcn_rcpf(1.0f + __expf(-x)); }
__device__ __forceinline__ float wave_sum(float v) {
#pragma unroll
    for (int o = 1; o < 64; o <<= 1) v += __shfl_xor(v, o);
    return v;
}

namespace pg8 {
constexpr int BM = 256, BK = 64, HALF = 128, HTB = HALF * BK * 2  , STAGE_BYTES = 8 * HTB, NXCD = 8, WGM = 8;
__host__ __device__ __forceinline__ int lds_byte(int r, int c) { const int st = (r >> 4) * 2 + (c >> 5), rr = r & 15, cc = c & 31, ob = rr * 64 + cc * 2; return st * 1024 + (ob ^ (((ob >> 9) & 1) << 5)); }
__host__ __device__ __forceinline__ void stage_rc(int b, int& R, int& C) { const int st = b / 1024, sb = b % 1024, swz = sb ^ (((sb >> 9) & 1) << 5); R = (st >> 1) * 16 + swz / 64; C = (st & 1) * 32 + (swz % 64) / 2; }

struct Unit { int pm, pn, seg; const char* A; const char* B; };
struct Dims { int lda, ldb, nt; };

__device__ __forceinline__ void tile_of(int L, int nM, int nN, int& pm, int& pn) {
    const int nwg = nM * nN; int wgid = L; { const int q = nwg / NXCD, r = nwg % NXCD, xcd = wgid % NXCD, off = wgid / NXCD; wgid = (xcd < r ? xcd * (q + 1) : r * (q + 1) + (xcd - r) * q) + off; }
    const int nig = WGM * nN, gid = wgid / nig, fm = gid * WGM, gsz = (nM - fm) < WGM ? (nM - fm) : WGM;
    pm = fm + ((wgid % nig) % gsz); pn = (wgid % nig) / gsz;
}
struct StaticOrder {
    int nM, nN, nwg, G, c; const char* A; const char* B; size_t tstepA, tstepB;
    __device__ void init(const void* A_, int lda, const void* B_, int ldb, int M, int N, int G_, int c_) { nM = M / BM; nN = N / BM; nwg = nM * nN; G = G_; c = c_; A = (const char*)A_; B = (const char*)B_; tstepA = (size_t)BM * lda * 2; tstepB = (size_t)BM * ldb * 2; }
    __device__ __forceinline__ bool next(int i, Unit& u) const {
        const long L = (long)i * G + c; if (L >= nwg) return false;
        tile_of((int)L, nM, nN, u.pm, u.pn); u.seg = 0; u.A = A + (size_t)u.pm * tstepA; u.B = B + (size_t)u.pn * tstepB; return true;
    }
    __device__ __forceinline__ bool carry(const Unit&) const { return false; }
};
struct DualOrder {
    int nM, nN, nwg, G, c; const char* A; const char* B; size_t tstepA, tstepB, segA, segB;
    __device__ void init(const void* A_, int lda, const void* B_, int ldb, int M, int N, int G_, int c_, size_t segA_, size_t segB_) { nM = M / BM; nN = N / BM; nwg = nM * nN; G = G_; c = c_; A = (const char*)A_; B = (const char*)B_; tstepA = (size_t)BM * lda * 2; tstepB = (size_t)BM * ldb * 2; segA = segA_; segB = segB_; }
    __device__ __forceinline__ bool next(int i, Unit& u) const {
        const long L = (long)(i >> 1) * G + c; if (L >= nwg) return false;
        tile_of((int)L, nM, nN, u.pm, u.pn); u.seg = i & 1; u.A = A + (size_t)u.pm * tstepA + (size_t)u.seg * segA; u.B = B + (size_t)u.pn * tstepB + (size_t)u.seg * segB; return true;
    }
    __device__ __forceinline__ bool carry(const Unit& u) const { return u.seg == 0; }
};

template <class Epi, class Sched, bool ALIGN_EPI>
__device__ __forceinline__ void gemm_phase(LAS unsigned char* lds, const Dims g, const Sched& S, const Epi& E) {
    const int tid = threadIdx.x, wid = __builtin_amdgcn_readfirstlane(tid >> 6), lane = tid & 63, wr = wid >> 2, wc = wid & 3, fr = lane & 15, fq = lane >> 4;
    const int nt = g.nt;
    unsigned voffA[2], voffB[2];
#pragma unroll
    for (int i = 0; i < 2; ++i) { int R, C; stage_rc(tid * 16 + i * 8192, R, C); voffA[i] = (unsigned)(R * g.lda + C) * 2u; voffB[i] = (unsigned)(R * g.ldb + C) * 2u; }
    const size_t kstep = (size_t)(BK * 2);
    const size_t hstepA = (size_t)HALF * g.lda * 2, hstepB = (size_t)HALF * g.ldb * 2;
    const unsigned ldsw = (unsigned)wid * 1024u;
    const int aoff = lds_byte(wr * 64 + fr, fq * 8), boff = lds_byte(wc * 32 + fr, fq * 8);
#define PG8_SA(b, h) (((b) * 2 + (h)) * HTB)
#define PG8_SB(b, h) ((4 + (b) * 2 + (h)) * HTB)
#define PG8_STAGE(bufoff, gbase, voff) do { _Pragma("unroll") for (int _i = 0; _i < 2; ++_i) \
        __builtin_amdgcn_global_load_lds((const unsigned*)((const char*)(gbase) + (voff)[_i]), (LAS unsigned*)(lds + (bufoff) + ldsw + _i * 8192), 16, 0, 0); } while (0)
#define PG8_LDA(dst, b, h) do { _Pragma("unroll") for (int m = 0; m < 4; ++m) _Pragma("unroll") for (int k = 0; k < 2; ++k) dst[m][k] = *(const LAS bf16x8*)(lds + PG8_SA(b, h) + aoff + m * 2048 + k * 1024); } while (0)
#define PG8_LDB(dst, b, h) do { _Pragma("unroll") for (int n = 0; n < 2; ++n) _Pragma("unroll") for (int k = 0; k < 2; ++k) dst[n][k] = *(const LAS bf16x8*)(lds + PG8_SB(b, h) + boff + n * 2048 + k * 1024); } while (0)
#define PG8_MMA(ai, bj, At, Bt) do { __builtin_amdgcn_s_setprio(1); _Pragma("unroll") for (int m = 0; m < 4; ++m) _Pragma("unroll") for (int n = 0; n < 2; ++n) _Pragma("unroll") for (int k = 0; k < 2; ++k) \
        acc[ai][bj][m][n] = __builtin_amdgcn_mfma_f32_16x16x32_bf16(Bt[n][k], At[m][k], acc[ai][bj][m][n], 0, 0, 0); __builtin_amdgcn_s_setprio(0); } while (0)
#define PG8_WAIT_V(n) asm volatile("s_waitcnt vmcnt(" #n ")" ::: "memory")
#define PG8_WAIT_L(n) asm volatile("s_waitcnt lgkmcnt(" #n ")" ::: "memory")
#define PG8_BAR __builtin_amdgcn_s_barrier()
#define PG8_SCHED __builtin_amdgcn_sched_barrier(0)
    Unit cur, nxt; int ui = 0;
    if (!S.next(0, cur)) return;
    f32x4 acc[2][2][4][2];
#pragma unroll
    for (int a = 0; a < 2; ++a)
#pragma unroll
        for (int b = 0; b < 2; ++b)
#pragma unroll
            for (int m = 0; m < 4; ++m)
#pragma unroll
                for (int n = 0; n < 2; ++n) acc[a][b][m][n] = (f32x4){0.f, 0.f, 0.f, 0.f};
    bf16x8 At[4][2], B0[2][2], B1[2][2];
    const char* cA = cur.A; const char* cB = cur.B;
    PG8_STAGE(PG8_SB(0, 0), cB, voffB); PG8_STAGE(PG8_SB(0, 1), cB + hstepB, voffB); PG8_STAGE(PG8_SA(0, 0), cA, voffA); PG8_STAGE(PG8_SA(0, 1), cA + hstepA, voffA);
    if (wr == 1) PG8_BAR;
    PG8_WAIT_V(2); PG8_BAR;
    PG8_STAGE(PG8_SB(1, 0), cB + kstep, voffB); PG8_STAGE(PG8_SA(1, 0), cA + kstep, voffA); PG8_STAGE(PG8_SB(1, 1), cB + hstepB + kstep, voffB);
    PG8_WAIT_V(6); PG8_BAR;
    for (;;) {
        const bool has_next = S.next(ui + 1, nxt);
        const char* nA = has_next ? nxt.A : cA; const char* nB = has_next ? nxt.B : cB;
        for (int t = 0; t < nt; t += 2) {
            const bool last = (t == nt - 2);
            const char* a1 = cA + (size_t)(t + 1) * kstep;
            const char* a2 = last ? nA : cA + (size_t)(t + 2) * kstep; const char* b2 = last ? nB : cB + (size_t)(t + 2) * kstep;
            const char* a3 = a2 + kstep; const char* b3 = b2 + kstep;
            PG8_LDB(B0, 0, 0); PG8_LDB(B1, 0, 1); PG8_SCHED; PG8_LDA(At, 0, 0); PG8_STAGE(PG8_SA(1, 1), a1 + hstepA, voffA);
            PG8_WAIT_V(8); PG8_WAIT_L(0); PG8_BAR; PG8_MMA(0, 0, At, B0); PG8_MMA(0, 1, At, B1); PG8_BAR; PG8_SCHED;
            PG8_LDA(At, 0, 1); PG8_STAGE(PG8_SB(0, 0), b2, voffB); PG8_STAGE(PG8_SB(0, 1), b2 + hstepB, voffB); PG8_STAGE(PG8_SA(0, 0), a2, voffA);
            PG8_WAIT_V(8); PG8_WAIT_L(0); PG8_BAR; PG8_MMA(1, 0, At, B0); PG8_MMA(1, 1, At, B1); PG8_BAR; PG8_SCHED;
            PG8_LDB(B0, 1, 0); PG8_LDB(B1, 1, 1); PG8_SCHED; PG8_LDA(At, 1, 0); PG8_STAGE(PG8_SA(0, 1), a2 + hstepA, voffA);
            PG8_WAIT_V(8); PG8_WAIT_L(0); PG8_BAR; PG8_MMA(0, 0, At, B0); PG8_MMA(0, 1, At, B1); PG8_BAR; PG8_SCHED;
            PG8_LDA(At, 1, 1); PG8_STAGE(PG8_SB(1, 0), b3, voffB); PG8_STAGE(PG8_SB(1, 1), b3 + hstepB, voffB); PG8_STAGE(PG8_SA(1, 0), a3, voffA);
            PG8_WAIT_V(8); PG8_WAIT_L(0); PG8_BAR; PG8_MMA(1, 0, At, B0); PG8_MMA(1, 1, At, B1); PG8_BAR; PG8_SCHED;
        }
        if constexpr (ALIGN_EPI) { if (wr == 0) PG8_BAR; }
        if constexpr (!Epi::AFTER_DRAIN) { E(acc, cur, wr, wc, fr, fq); }
        if (!has_next) break;
        if (!S.carry(cur)) {
#pragma unroll
            for (int a = 0; a < 2; ++a)
#pragma unroll
                for (int b = 0; b < 2; ++b)
#pragma unroll
                    for (int m = 0; m < 4; ++m)
#pragma unroll
                        for (int n = 0; n < 2; ++n) acc[a][b][m][n] = (f32x4){0.f, 0.f, 0.f, 0.f};
        }
        cur = nxt; cA = nA; cB = nB; ++ui;
        if constexpr (ALIGN_EPI) { if (wr == 1) PG8_BAR; }
    }
    PG8_WAIT_V(0);
    if constexpr (!ALIGN_EPI) { if (wr == 0) PG8_BAR; }
    PG8_BAR;
    if constexpr (Epi::AFTER_DRAIN) { E.fused(acc, cur, wr, wc, fr, fq, lds, wid, lane); }
#undef PG8_SA
#undef PG8_SB
#undef PG8_STAGE
#undef PG8_LDA
#undef PG8_LDB
#undef PG8_MMA
#undef PG8_WAIT_V
#undef PG8_WAIT_L
#undef PG8_BAR
#undef PG8_SCHED
}
}

typedef f32x4 acc_t[2][2][4][2];

struct EpiProj {
    static constexpr bool AFTER_DRAIN = false;
    const float* rstd; const float* bias; unsigned char* ws;
    __device__ __forceinline__ void operator()(acc_t& acc, const pg8::Unit& u, int wr, int wc, int fr, int fq) const {
        const int pn = u.pn, row0 = u.pm * 256 + wr * 64 + fr;
        f32x4 bv[2][2];
#pragma unroll
        for (int bj = 0; bj < 2; ++bj)
#pragma unroll
            for (int n = 0; n < 2; ++n) bv[bj][n] = *(const f32x4*)(bias + pn * 256 + bj * 128 + wc * 32 + n * 16 + 4 * fq);
        if (pn == 21) {
            if (wc == 0) {
                float* sm = (float*)(ws + WS_SM);
                float rsv[2][4];
#pragma unroll
                for (int ai = 0; ai < 2; ++ai)
#pragma unroll
                    for (int m = 0; m < 4; ++m) rsv[ai][m] = rstd[row0 + ai * 128 + m * 16];
#pragma unroll
                for (int ai = 0; ai < 2; ++ai)
#pragma unroll
                    for (int m = 0; m < 4; ++m) { const int row = row0 + ai * 128 + m * 16; const float rs = rsv[ai][m];
#pragma unroll
                        for (int n = 0; n < 2; ++n) *(f32x4*)(sm + (size_t)row * 32 + n * 16 + 4 * fq) = acc[ai][0][m][n] * rs + bv[0][n]; }
            }
            return;
        }
        bf16_t* cb[2]; int ld, mode = 0;
        if (pn < 8) { bf16_t* b = (bf16_t*)(ws + (pn < 4 ? WS_QK : WS_VO)) + (pn & 3) * 256 + wc * 32; cb[0] = b; cb[1] = b + 128; ld = 1024; mode = (pn >= 6) ? 1 : 0; }
        else if (pn < 10) { bf16_t* b = (bf16_t*)(ws + WS_NQ) + (pn - 8) * 256 + wc * 32; cb[0] = b; cb[1] = b + 128; ld = 512; mode = 2; }
        else if (pn < 13) { bf16_t* b = (bf16_t*)(ws + WS_NKV) + (size_t)((pn - 10) * 4 + (wc >> 1)) * MTOK * 64 + 32 * (wc & 1); cb[0] = b; cb[1] = b + (size_t)2 * MTOK * 64; ld = 64; }
        else { bf16_t* b = (bf16_t*)(ws + WS_GT) + (pn - 13) * 256 + wc * 32; cb[0] = b; cb[1] = b + 128; ld = 2048; mode = 1; }
        float rsv[2][4];
#pragma unroll
        for (int ai = 0; ai < 2; ++ai)
#pragma unroll
            for (int m = 0; m < 4; ++m) rsv[ai][m] = rstd[row0 + ai * 128 + m * 16];
#pragma unroll
        for (int ai = 0; ai < 2; ++ai)
#pragma unroll
            for (int m = 0; m < 4; ++m) { const int row = row0 + ai * 128 + m * 16; const float rs = rsv[ai][m];
#pragma unroll
                for (int bj = 0; bj < 2; ++bj)
#pragma unroll
                    for (int n = 0; n < 2; ++n) { f32x4 v = acc[ai][bj][m][n] * rs + bv[bj][n];
                        if (mode == 1) { v[0] = sigmoidf_(v[0]); v[1] = sigmoidf_(v[1]); v[2] = sigmoidf_(v[2]); v[3] = sigmoidf_(v[3]); }
                        else if (mode == 2) v = v * 0.125f;
                        u32x2 w; w.x = cvtpk(v[0], v[1]); w.y = cvtpk(v[2], v[3]);
                        *(u32x2*)(cb[bj] + (size_t)row * ld + n * 16 + 4 * fq) = w; } }
    }
};

struct EpiBranch {
    static constexpr bool AFTER_DRAIN = false;
    const bf16_t* gt; bf16_t* mixed;
    __device__ __forceinline__ void operator()(acc_t& acc, const pg8::Unit& u, int wr, int wc, int fr, int fq) const {
        const int row0 = u.pm * 256 + wr * 64 + fr, col0 = u.pn * 256 + wc * 32 + 4 * fq;
        const bool s0 = (u.seg == 0);
#pragma unroll
        for (int ai = 0; ai < 2; ++ai)
#pragma unroll
            for (int m = 0; m < 4; ++m) {
                const bf16_t* gp = gt + (size_t)(row0 + ai * 128 + m * 16) * 2048 + col0;
                u32x2 q1[2][2], q0[2][2];
#pragma unroll
                for (int bj = 0; bj < 2; ++bj)
#pragma unroll
                    for (int n = 0; n < 2; ++n) { q1[bj][n] = *(const u32x2*)(gp + 1024 + bj * 128 + n * 16); q0[bj][n] = s0 ? *(const u32x2*)(gp + bj * 128 + n * 16) : (u32x2){0x3f803f80u, 0x3f803f80u}; }
#pragma unroll
                for (int bj = 0; bj < 2; ++bj)
#pragma unroll
                    for (int n = 0; n < 2; ++n) { const u32x2 a0 = q0[bj][n], a1 = q1[bj][n];
                        const f32x4 g0 = {bflo(a0.x), bfhi(a0.x), bflo(a0.y), bfhi(a0.y)}, g1 = {bflo(a1.x), bfhi(a1.x), bflo(a1.y), bfhi(a1.y)};
                        f32x4 a = acc[ai][bj][m][n];
#pragma unroll
                        for (int e = 0; e < 4; ++e) a[e] = s0 ? a[e] * g0[e] * __builtin_amdgcn_rcpf(fmaxf(g1[e], 1e-18f)) : a[e] * g1[e];
                        acc[ai][bj][m][n] = a; }
                asm volatile("" ::: "memory");
            }
        if (!s0) {
#pragma unroll
            for (int ai = 0; ai < 2; ++ai)
#pragma unroll
                for (int m = 0; m < 4; ++m)
#pragma unroll
                    for (int bj = 0; bj < 2; ++bj)
#pragma unroll
                        for (int n = 0; n < 2; ++n) { const f32x4 v = acc[ai][bj][m][n]; u32x2 w; w.x = cvtpk(v[0], v[1]); w.y = cvtpk(v[2], v[3]);
                            *(u32x2*)(mixed + (size_t)(row0 + ai * 128 + m * 16) * 1024 + col0 + bj * 128 + n * 16) = w; }
        }
    }
};

struct EpiResid {
    static constexpr bool AFTER_DRAIN = false;
    const float* base; float* out; bf16_t* outb; float* part;
    __device__ __forceinline__ void operator()(acc_t& acc, const pg8::Unit& u, int wr, int wc, int fr, int fq) const {
        int row0 = u.pm * 256 + wr * 64 + fr; const int col0 = u.pn * 256 + wc * 32 + 4 * fq;
#pragma unroll
        for (int ai = 0; ai < 2; ++ai)
#pragma unroll
            for (int mh = 0; mh < 4; ++mh) {
                if ((mh & 1) == 0) asm volatile("" : "+v"(row0) :: "memory");
                f32x4 r[2][2];
#pragma unroll
                for (int bj = 0; bj < 2; ++bj)
#pragma unroll
                    for (int n = 0; n < 2; ++n) r[bj][n] = *(const f32x4*)(base + (size_t)(row0 + ai * 128 + mh * 16) * 1024 + col0 + bj * 128 + n * 16);
#pragma unroll
                for (int bj = 0; bj < 2; ++bj)
#pragma unroll
                    for (int n = 0; n < 2; ++n) acc[ai][bj][mh][n] += r[bj][n];
                if (mh & 1) asm volatile("" : "+v"(acc[ai][0][mh][0]), "+v"(acc[ai][1][mh][1]) :: "memory");
            }
#pragma unroll
        for (int ai = 0; ai < 2; ++ai)
#pragma unroll
            for (int m = 0; m < 4; ++m) { const int row = row0 + ai * 128 + m * 16; float ss = 0.f;
#pragma unroll
                for (int bj = 0; bj < 2; ++bj)
#pragma unroll
                    for (int n = 0; n < 2; ++n) { const size_t off = (size_t)row * 1024 + col0 + bj * 128 + n * 16;
                        const f32x4 v = acc[ai][bj][m][n];
                        ss += (v[0] * v[0] + v[1] * v[1]) + (v[2] * v[2] + v[3] * v[3]);
                        *(f32x4*)(out + off) = v;
                        if (outb) { u32x2 w; w.x = cvtpk(v[0], v[1]); w.y = cvtpk(v[2], v[3]); *(u32x2*)(outb + off) = w; } }
                ss += __shfl_xor(ss, 16); ss += __shfl_xor(ss, 32);
                if (fq == 0) part[((size_t)u.pn * MTOK + row) * 4 + wc] = ss; }
    }
};

struct EpiGateUp {
    static constexpr bool AFTER_DRAIN = false;
    const float* part; bf16_t* hid;
    __device__ __forceinline__ void operator()(acc_t& acc, const pg8::Unit& u, int wr, int wc, int fr, int fq) const {
        const int row0 = u.pm * 256 + wr * 64 + fr, col0 = u.pn * 128 + wc * 16 + 4 * fq;
        float rsv[2][4];
        { f32x4 pp[2][4];
#pragma unroll
          for (int ai = 0; ai < 2; ++ai)
#pragma unroll
            for (int m = 0; m < 4; ++m) pp[ai][m] = *(const f32x4*)(part + ((size_t)fq * MTOK + row0 + ai * 128 + m * 16) * 4);
#pragma unroll
          for (int ai = 0; ai < 2; ++ai)
#pragma unroll
            for (int m = 0; m < 4; ++m) { float s = (pp[ai][m][0] + pp[ai][m][1]) + (pp[ai][m][2] + pp[ai][m][3]); s += __shfl_xor(s, 16); s += __shfl_xor(s, 32); rsv[ai][m] = rsqrtf(s * (1.0f / 1024.0f) + RMS_EPS); } }
#pragma unroll
        for (int ai = 0; ai < 2; ++ai)
#pragma unroll
            for (int m = 0; m < 4; ++m) { const int row = row0 + ai * 128 + m * 16;
                const float rs = rsv[ai][m];
#pragma unroll
                for (int bj = 0; bj < 2; ++bj) { const f32x4 g = acc[ai][bj][m][0] * rs, up = acc[ai][bj][m][1] * rs; f32x4 y;
#pragma unroll
                    for (int e = 0; e < 4; ++e) y[e] = g[e] * sigmoidf_(g[e]) * up[e];
                    u32x2 w; w.x = cvtpk(y[0], y[1]); w.y = cvtpk(y[2], y[3]);
                    *(u32x2*)(hid + (size_t)row * D_FF + col0 + bj * 64) = w; } }
    }
};

struct Args {
    const float* x; const float* g_norm_mix; const float* w_in; const float* b_in; const float* b_fgate; const float* conv_qk; const float* g_mlstm_head; const float* pe_cmp;
    const float* w_cmp1; const float* w_cmp2; const float* rel_bias; const float* w_branch; const float* w_out; const float* g_norm_ffn; const float* w_gate; const float* w_up;
    const float* w_down; const float* g_final;
    float* out; unsigned char* ws; int ph_lo, ph_hi, coop, pad;
};
constexpr int NWAVES = 8, NTHREADS = 512;
constexpr int RING_BYTES = 131072, LDS_BYTES = 147456;

__device__ __forceinline__ int rel_bucket_dev(int n) {
    if (n < 16) return n < 0 ? 0 : n;
    int b = 16;
    b += (n >= 21); b += (n >= 27); b += (n >= 35); b += (n >= 46); b += (n >= 59); b += (n >= 77); b += (n >= 99); b += (n >= 128);
    b += (n >= 166); b += (n >= 216); b += (n >= 280); b += (n >= 363); b += (n >= 470); b += (n >= 609); b += (n >= 790);
    return b;
}

struct ColSrc { const float* p; int ld; };
template <class F>
__device__ __forceinline__ void tr_item(const F& f, const float* kscale, bf16_t* WT, int K, int nblk, int item, LAS float* scr, int lane, const float* kfallback) {
    const int kb = item / nblk, nb = item % nblk, k0 = 64 * kb, n0 = 32 * nb;
    const ColSrc cs = f(n0 + (lane & 31));
    float tv[32];
    const float* lp = cs.p ? cs.p : kfallback; const float lmask = cs.p ? 1.0f : 0.0f;
#pragma unroll
    for (int i = 0; i < 32; ++i) { const int kk = 2 * i + (lane >> 5); tv[i] = lp[(size_t)(k0 + kk) * cs.ld]; }
#pragma unroll
    for (int i = 0; i < 32; ++i) tv[i] *= lmask;
    if (kscale) {
#pragma unroll
        for (int i = 0; i < 32; ++i) tv[i] *= kscale[k0 + 2 * i + (lane >> 5)]; }
#pragma unroll
    for (int i = 0; i < 32; ++i) scr[(2 * i + (lane >> 5)) * 33 + (lane & 31)] = tv[i];
    asm volatile("s_waitcnt lgkmcnt(0)" ::: "memory");
    const int c = lane & 7;
#pragma unroll
    for (int j = 0; j < 4; ++j) { const int n = (lane >> 3) + 8 * j; const LAS float* s = scr + (8 * c) * 33 + n;
        u32x4 o; o.x = cvtpk(s[0 * 33], s[1 * 33]); o.y = cvtpk(s[2 * 33], s[3 * 33]); o.z = cvtpk(s[4 * 33], s[5 * 33]); o.w = cvtpk(s[6 * 33], s[7 * 33]);
        *(u32x4*)(WT + (size_t)(n0 + n) * K + k0 + 8 * c) = o; }
    asm volatile("s_waitcnt lgkmcnt(0)" ::: "memory");
}
__device__ __forceinline__ int proj_src_col(int n) {
    if (n < 2048) return n;
    if (n < 2560) return 2056 + (n - 2048);
    if (n < 3328) return 2568 + (n - 2560);
    if (n < 5376) return 3360 + (n - 3328);
    const int x = n - 5376;
    if (x < 8) return 2048 + x;
    if (x < 32) return 3336 + (x - 8);
    return -1;
}
struct SrcW1 { const float* w; __device__ ColSrc operator()(int n) const { const int c = proj_src_col(n); return ColSrc{c >= 0 ? w + c : nullptr, D_IN}; } };
struct SrcGU { const float* wg; const float* wu; __device__ ColSrc operator()(int n) const { const int G = n >> 4; const uintptr_t pg = (uintptr_t)wg, pu = (uintptr_t)wu; const uintptr_t sel = pg ^ ((pg ^ pu) & (uintptr_t)(0 - (long long)(G & 1)));
    return ColSrc{(const float*)sel + 16 * (G >> 1) + (n & 15), D_FF}; } };
struct SrcPlain { const float* w; int ld; __device__ ColSrc operator()(int n) const { return ColSrc{w + n, ld}; } };
struct SrcBr { const float* w; __device__ ColSrc operator()(int n) const { return ColSrc{w + (size_t)(n >> 10) * 512 * 1024 + (n & 1023), 1024}; } };
struct SrcC1 { const float* w; __device__ ColSrc operator()(int n) const { const int j = n >> 8, q = n & 255; return ColSrc{w + (size_t)j * 2048 * 128 + (q >= 128 ? 1024 * 128 : 0) + (q & 127), 128}; } };
struct SrcC2 { const float* w; __device__ ColSrc operator()(int n) const { return ColSrc{w + (size_t)(n >> 6) * 128 * 64 + (n & 63), 64}; } };

__device__ __forceinline__ void p0_prologue(const Args& a, LAS unsigned char* lds, int vcu, int G, int wave, int lane) {
    unsigned char* ws = a.ws;
    LAS float* scr = (LAS float*)(lds + wave * 16384);
    const int gw = vcu * NWAVES + wave, NGW = G * NWAVES;
    constexpr int I_W1 = (1024 / 64) * (N1 / 32), I_GU = (1024 / 64) * (NGU / 32), I_DN = (D_FF / 64) * (1024 / 32), I_OUT = 16 * 32, I_BR = (512 / 64) * (2048 / 32), I_C1 = 16 * (512 / 32), I_C2 = 2 * (128 / 32);
    constexpr int I_PEB = 256, I_BIAS = N1 / 64, I_BT = 8 * (BIAS_LEN / 64);
    constexpr int NITEMS = I_W1 + I_GU + I_DN + I_OUT + I_BR + I_C1 + I_C2 + I_PEB + I_BIAS + I_BT;
    if (blockIdx.x == 0 && threadIdx.x < 64) ((unsigned*)(ws + WS_CTL))[threadIdx.x] = 0u;
    for (int it = gw; it < NITEMS; it += NGW) {
        int r = it;
        if (r < I_W1) { tr_item(SrcW1{a.w_in}, a.g_norm_mix, (bf16_t*)(ws + WS_W1T), 1024, N1 / 32, r, scr, lane, a.w_in); continue; } r -= I_W1;
        if (r < I_GU) { tr_item(SrcGU{a.w_gate, a.w_up}, a.g_norm_ffn, (bf16_t*)(ws + WS_WGUT), 1024, NGU / 32, r, scr, lane, a.w_gate); continue; } r -= I_GU;
        if (r < I_DN) { tr_item(SrcPlain{a.w_down, 1024}, nullptr, (bf16_t*)(ws + WS_WDNT), D_FF, 1024 / 32, r, scr, lane, a.w_down); continue; } r -= I_DN;
        if (r < I_OUT) { tr_item(SrcPlain{a.w_out, 1024}, nullptr, (bf16_t*)(ws + WS_WOUTT), 1024, 1024 / 32, r, scr, lane, a.w_out); continue; } r -= I_OUT;
        if (r < I_BR) { tr_item(SrcBr{a.w_branch}, nullptr, (bf16_t*)(ws + WS_WBRT), 512, 2048 / 32, r, scr, lane, a.w_branch); continue; } r -= I_BR;
        if (r < I_C1) { tr_item(SrcC1{a.w_cmp1}, nullptr, (bf16_t*)(ws + WS_WC1T), 1024, 512 / 32, r, scr, lane, a.w_cmp1); continue; } r -= I_C1;
        if (r < I_C2) { tr_item(SrcC2{a.w_cmp2}, nullptr, (bf16_t*)(ws + WS_WC2T), 128, 128 / 32, r, scr, lane, a.w_cmp2); continue; } r -= I_C2;
        if (r < I_PEB) {
            const int j = r >> 7, n = r & 127; const float* pe = a.pe_cmp + j * 2048; const float* w = a.w_cmp1 + (size_t)j * 2048 * 128 + n; float s = 0.f;
#pragma unroll 8
            for (int i = 0; i < 32; ++i) { const int k = i * 64 + lane; s += pe[k] * w[(size_t)k * 128]; }
            s = wave_sum(s); if (lane == 0) __hip_atomic_store((float*)(ws + WS_PEB) + r, s, __ATOMIC_RELAXED, __HIP_MEMORY_SCOPE_AGENT); continue; } r -= I_PEB;
        if (r < I_BIAS) { const int n = r * 64 + lane; const int c = proj_src_col(n); ((float*)(ws + WS_BIAS1))[n] = c >= 0 ? a.b_in[c] : 0.f; continue; } r -= I_BIAS;
        { const int h = r / (BIAS_LEN / 64), idx = (r % (BIAS_LEN / 64)) * 64 + lane;
          ((float*)(ws + WS_BTAB))[h * BIAS_LEN + idx] = a.rel_bias[rel_bucket_dev(idx - BIAS_PAD) * N_HEADS + h] * 1.4426950408889634f; }
    }
    bf16_t* xb = (bf16_t*)(ws + WS_XB); float* rsx = (float*)(ws + WS_RSX);
    for (int blk = gw; blk < MTOK / 16; blk += NGW) {
        float myrs = 0.f;
#pragma unroll 1
        for (int k4 = 0; k4 < 16; k4 += 4) {
            f32x4 v[4][4]; float s[4];
#pragma unroll
            for (int r = 0; r < 4; ++r) { const f32x4* xr = (const f32x4*)(a.x + (size_t)(blk * 16 + k4 + r) * 1024) + lane;
#pragma unroll
                for (int j = 0; j < 4; ++j) v[r][j] = xr[64 * j]; }
#pragma unroll
            for (int r = 0; r < 4; ++r) { float t = 0.f;
#pragma unroll
                for (int j = 0; j < 4; ++j) t += (v[r][j][0] * v[r][j][0] + v[r][j][1] * v[r][j][1]) + (v[r][j][2] * v[r][j][2] + v[r][j][3] * v[r][j][3]);
                s[r] = wave_sum(t);
                u32x2* o = (u32x2*)(xb + (size_t)(blk * 16 + k4 + r) * 1024) + lane;
#pragma unroll
                for (int j = 0; j < 4; ++j) { u32x2 w; w.x = cvtpk(v[r][j][0], v[r][j][1]); w.y = cvtpk(v[r][j][2], v[r][j][3]); o[64 * j] = w; }
                if (lane == k4 + r) myrs = rsqrtf(s[r] * (1.0f / 1024.0f) + RMS_EPS); }
        }
        if (lane < 16) rsx[blk * 16 + lane] = myrs;
    }
}

__device__ __forceinline__ void p8_final(const Args& a, int vcu, int G, int wave, int lane) {
    const float* part = (const float*)(a.ws + WS_PART2);
    const int gw = vcu * NWAVES + wave, NGW = G * NWAVES;
    f32x4 gv[4];
#pragma unroll
    for (int j = 0; j < 4; ++j) gv[j] = ((const f32x4*)a.g_final)[lane + 64 * j];
    for (int m = gw; m < MTOK; m += NGW) {
        float p = (lane < 16) ? part[((size_t)(lane >> 2) * MTOK + m) * 4 + (lane & 3)] : 0.f;
        p += __shfl_xor(p, 1); p += __shfl_xor(p, 2); p += __shfl_xor(p, 4); p += __shfl_xor(p, 8);
        const float rs = rsqrtf(__shfl(p, 0) * (1.0f / 1024.0f) + RMS_EPS);
        f32x4* xr = (f32x4*)(a.out + (size_t)m * 1024) + lane;
#pragma unroll
        for (int j = 0; j < 4; ++j) xr[64 * j] = xr[64 * j] * rs * gv[j];
    }
}

__device__ __forceinline__ int kpos16(int key) { return (key & ~12) | ((key & 4) << 1) | ((key & 8) >> 1); }
__device__ __forceinline__ float siluf_(float x) { return x * sigmoidf_(x); }

__device__ __forceinline__ void p2_conv_item(const Args& a, int item, int tid) {
    const bf16_t* qk = (const bf16_t*)(a.ws + WS_QK); bf16_t* qc = (bf16_t*)(a.ws + WS_XB);
    const int cg8 = tid & 127, tg = tid >> 7, ch = cg8 * 8, row0 = item * 32 + tg * 8, tl0 = row0 & (SEQ - 1);
    float w[4][8];
#pragma unroll
    for (int j = 0; j < 4; ++j) { const f32x4 w0 = *(const f32x4*)(a.conv_qk + j * 1024 + ch), w1 = *(const f32x4*)(a.conv_qk + j * 1024 + ch + 4);
        w[j][0] = w0[0]; w[j][1] = w0[1]; w[j][2] = w0[2]; w[j][3] = w0[3]; w[j][4] = w1[0]; w[j][5] = w1[1]; w[j][6] = w1[2]; w[j][7] = w1[3]; }
    const float osc = (ch >= 512) ? 0.08838834764831845f : 1.0f;
    float xw[3][8];
#pragma unroll
    for (int k = 0; k < 3; ++k) { const int tl = tl0 - 3 + k; u32x4 v = (u32x4){0u, 0u, 0u, 0u}; if (tl >= 0) v = *(const u32x4*)(qk + (size_t)(row0 - 3 + k) * 1024 + ch);
        xw[k][0] = bflo(v.x); xw[k][1] = bfhi(v.x); xw[k][2] = bflo(v.y); xw[k][3] = bfhi(v.y); xw[k][4] = bflo(v.z); xw[k][5] = bfhi(v.z); xw[k][6] = bflo(v.w); xw[k][7] = bfhi(v.w); }
#pragma unroll
    for (int t = 0; t < 8; ++t) {
        const u32x4 v = *(const u32x4*)(qk + (size_t)(row0 + t) * 1024 + ch);
        float x[8] = {bflo(v.x), bfhi(v.x), bflo(v.y), bfhi(v.y), bflo(v.z), bfhi(v.z), bflo(v.w), bfhi(v.w)}; float y[8];
#pragma unroll
        for (int e = 0; e < 8; ++e) { const float s = w[0][e] * xw[0][e] + w[1][e] * xw[1][e] + w[2][e] * xw[2][e] + w[3][e] * x[e]; y[e] = siluf_(s) * osc; xw[0][e] = xw[1][e]; xw[1][e] = xw[2][e]; xw[2][e] = x[e]; }
        u32x4 o; o.x = cvtpk(y[0], y[1]); o.y = cvtpk(y[2], y[3]); o.z = cvtpk(y[4], y[5]); o.w = cvtpk(y[6], y[7]);
        *(u32x4*)(qc + (size_t)(row0 + t) * 1024 + ch) = o;
    }
}
__device__ __forceinline__ void p2_vt_item(const Args& a, int it, LAS unsigned char* scr, int lane) {
    const int which = it >> 10, rem = it & 1023, bg = rem >> 5, blk = rem & 31, b = bg >> 1, g = bg & 1;
    const bf16_t* src = (const bf16_t*)(a.ws + WS_NKV) + ((size_t)((which ? 10 : 6) + g) * MTOK + (size_t)b * SEQ + blk * 64) * 64;
    bf16_t* dst = (bf16_t*)(a.ws + (which ? WS_VWT : WS_VST)) + (size_t)(bg * 32 + blk) * 4096;
    LAS unsigned short* s = (LAS unsigned short*)scr;
#pragma unroll
    for (int i = 0; i < 8; ++i) { const int key = i * 8 + (lane >> 3), c = lane & 7; const u32x4 v = *(const u32x4*)(src + key * 64 + c * 8); const int p = (key & ~15) | kpos16(key & 15);
        s[(c * 8 + 0) * 72 + p] = (unsigned short)(v.x & 0xffff); s[(c * 8 + 1) * 72 + p] = (unsigned short)(v.x >> 16); s[(c * 8 + 2) * 72 + p] = (unsigned short)(v.y & 0xffff); s[(c * 8 + 3) * 72 + p] = (unsigned short)(v.y >> 16);
        s[(c * 8 + 4) * 72 + p] = (unsigned short)(v.z & 0xffff); s[(c * 8 + 5) * 72 + p] = (unsigned short)(v.z >> 16); s[(c * 8 + 6) * 72 + p] = (unsigned short)(v.w & 0xffff); s[(c * 8 + 7) * 72 + p] = (unsigned short)(v.w >> 16); }
    asm volatile("s_waitcnt lgkmcnt(0)" ::: "memory");
#pragma unroll
    for (int i = 0; i < 8; ++i) { const int d = i * 8 + (lane >> 3), c = lane & 7; *(u32x4*)(dst + d * 64 + c * 8) = *(const LAS u32x4*)(scr + d * 144 + c * 16); }
    asm volatile("s_waitcnt lgkmcnt(0)" ::: "memory");
}
struct CmpOrder {
    int c; const char* A; const char* B;
    __device__ __forceinline__ bool next(int i, pg8::Unit& u) const { if (i != 0 || c >= 32) return false; u.pm = c & 7; u.pn = c >> 3; u.seg = 0; u.A = A + (size_t)(c >> 3) * MTOK * 64 * 2 + (size_t)(c & 7) * 256 * 1024 * 2; u.B = B + (size_t)(c >> 4) * 256 * 1024 * 2; return true; }
    __device__ __forceinline__ bool carry(const pg8::Unit&) const { return false; }
};
struct EpiCmp {
    static constexpr bool AFTER_DRAIN = true;
    const float* peb; const bf16_t* wc2t; bf16_t* kc; bf16_t* vct;
    __device__ __forceinline__ void operator()(acc_t&, const pg8::Unit&, int, int, int, int) const {}
    __device__ __forceinline__ void fused(acc_t& acc, const pg8::Unit& u, int wr, int wc, int fr, int fq, LAS unsigned char* lds, int wid, int lane) const {
        const int p = u.pn, jj = p >> 1, g = p & 1;
        LAS float* hb = (LAS float*)lds;
#pragma unroll
        for (int ai = 0; ai < 2; ++ai)
#pragma unroll
            for (int m = 0; m < 4; ++m) { const int r = ai * 128 + wr * 64 + m * 16 + fr;
#pragma unroll
                for (int n = 0; n < 2; ++n) { const int cu = (32 * wc + 16 * n + 4 * fq) >> 2; *(LAS f32x4*)(hb + r * 128 + ((cu ^ (r & 15)) << 2)) = acc[ai][1][m][n]; } }
        asm volatile("s_waitcnt lgkmcnt(0)" ::: "memory"); __builtin_amdgcn_s_barrier(); asm volatile("" ::: "memory");
#pragma unroll
        for (int ai = 0; ai < 2; ++ai)
#pragma unroll
            for (int m = 0; m < 4; ++m) { const int r = ai * 128 + wr * 64 + m * 16 + fr, r1 = (r + 1) & 255;
#pragma unroll
                for (int n = 0; n < 2; ++n) { const int col = 32 * wc + 16 * n + 4 * fq, cu = col >> 2;
                    const f32x4 bt = *(const LAS f32x4*)(hb + r1 * 128 + ((cu ^ (r1 & 15)) << 2)); const f32x4 pb = *(const f32x4*)(peb + jj * 128 + col);
                    f32x4 v = acc[ai][0][m][n] + bt + pb; v[0] = siluf_(v[0]); v[1] = siluf_(v[1]); v[2] = siluf_(v[2]); v[3] = siluf_(v[3]); acc[ai][0][m][n] = v; } }
        asm volatile("s_waitcnt lgkmcnt(0)" ::: "memory"); __builtin_amdgcn_s_barrier(); asm volatile("" ::: "memory");
#pragma unroll
        for (int ai = 0; ai < 2; ++ai)
#pragma unroll
            for (int m = 0; m < 4; ++m) { const int r = ai * 128 + wr * 64 + m * 16 + fr;
#pragma unroll
                for (int n = 0; n < 2; ++n) { const int col = 32 * wc + 16 * n + 4 * fq; const f32x4 v = acc[ai][0][m][n]; u32x2 w; w.x = cvtpk(v[0], v[1]); w.y = cvtpk(v[2], v[3]); *(LAS u32x2*)(lds + r * 272 + col * 2) = w; } }
        asm volatile("s_waitcnt lgkmcnt(0)" ::: "memory"); __builtin_amdgcn_s_barrier(); asm volatile("" ::: "memory");
        const bf16_t* w2 = wc2t + jj * 64 * 128;
        bf16x8 wf[4][4];
#pragma unroll
        for (int dt = 0; dt < 4; ++dt)
#pragma unroll
            for (int s = 0; s < 4; ++s) wf[dt][s] = *(const bf16x8*)(w2 + (dt * 16 + fr) * 128 + 32 * s + 8 * fq);
#pragma unroll
        for (int rt = 0; rt < 2; ++rt) {
            const int r = wid * 32 + rt * 16 + fr; bf16x8 hf[4];
#pragma unroll
            for (int s = 0; s < 4; ++s) hf[s] = *(const LAS bf16x8*)(lds + r * 272 + (32 * s + 8 * fq) * 2);
            const int crow = u.pm * 256 + r, b = crow >> 7, c = crow & 127; const bool zero = (c == 127);
#pragma unroll
            for (int dt = 0; dt < 4; ++dt) { f32x4 o = {0.f, 0.f, 0.f, 0.f};
#pragma unroll
                for (int s = 0; s < 4; ++s) o = __builtin_amdgcn_mfma_f32_16x16x32_bf16(wf[dt][s], hf[s], o, 0, 0, 0);
                if (zero) o = (f32x4){0.f, 0.f, 0.f, 0.f};
                const int dd = dt * 16 + 4 * fq;
                if (jj == 0) { u32x2 w; w.x = cvtpk(o[0], o[1]); w.y = cvtpk(o[2], o[3]); *(u32x2*)(kc + ((size_t)(b * 2 + g) * 128 + c) * 64 + dd) = w; }
                else { bf16_t* vb = vct + ((size_t)(b * 2 + g) * 2 + (c >> 6)) * 4096 + ((c & 48) | kpos16(c & 15));
#pragma unroll
                    for (int e = 0; e < 4; ++e) vb[(dd + e) * 64] = (bf16_t)(cvtpk(o[e], 0.f) & 0xffff); } }
        }
    }
};
__device__ __forceinline__ void p2_prep(const Args& a, LAS unsigned char* lds, int bx, int G, int wave, int lane) {
    unsigned char* ws = a.ws;
    {
        CmpOrder S{bx, (const char*)(ws + WS_NKV), (const char*)(ws + WS_WC1T)};
        EpiCmp E{(const float*)(ws + WS_PEB), (const bf16_t*)(ws + WS_WC2T), (bf16_t*)(ws + WS_KC), (bf16_t*)(ws + WS_VCT)};
        pg8::gemm_phase<EpiCmp, CmpOrder, false>(lds, pg8::Dims{1024, 1024, 16}, S, E);
        __syncthreads();
    }
    for (int it = bx; it < MTOK / 32; it += G) p2_conv_item(a, it, threadIdx.x);
    for (int it = bx * NWAVES + wave; it < 2048; it += G * NWAVES) p2_vt_item(a, it, lds + wave * 16384, lane);
}

__device__ __forceinline__ int jpos32(int jj) { return ((jj & 12) << 1) | ((jj & 16) >> 2) | (jj & 3); }
__device__ __forceinline__ float logsigf_(float x) { return fminf(x, 0.f) - log1pf(__expf(-fabsf(x))); }
constexpr int ML_KS = 0, ML_VTS = 34816, ML_CS = 69632, ML_GV = 108800, ML_PM = ML_GV + 8192, ML_BC = ML_PM + 8192, ML_GH = ML_BC + 8192, ML_SCB = ML_GH + 512, ML_END = ML_SCB + 128;
static_assert(ML_END <= 140 * 1024, "mLSTM LDS map");
__device__ __forceinline__ void mlstm_item(const Args& a, LAS unsigned char* lds, int b, int h, int tid, int wave, int lane) {
    const bf16_t* qc = (const bf16_t*)(a.ws + WS_XB); const bf16_t* vo = (const bf16_t*)(a.ws + WS_VO); const float* sm = (const float*)(a.ws + WS_SM); bf16_t* ys = (bf16_t*)(a.ws + WS_QK);
    asm volatile("" : "+v"(tid), "+v"(lane));
    const int w = wave, fr = lane & 15, g = lane >> 4;
    LAS float* GV = (LAS float*)(lds + ML_GV); LAS float* PM = (LAS float*)(lds + ML_PM); LAS float* BC = (LAS float*)(lds + ML_BC); LAS float* GH = (LAS float*)(lds + ML_GH); LAS float* SCB = (LAS float*)(lds + ML_SCB);
    {
        const float bfg = a.b_fgate[h];
#pragma unroll 1
        for (int cc = 0; cc < 2; ++cc) {
            const int c = 2 * w + cc, r0 = b * SEQ + c * M_CHUNK, j0 = 2 * lane, j1 = j0 + 1;
            const float ip0 = sm[(size_t)(r0 + j0) * 32 + h], ip1 = sm[(size_t)(r0 + j1) * 32 + h];
            const float lf0 = logsigf_(sm[(size_t)(r0 + j0) * 32 + 4 + h] + bfg), lf1 = logsigf_(sm[(size_t)(r0 + j1) * 32 + 4 + h] + bfg);
            float s = lf0 + lf1;
#pragma unroll
            for (int o = 1; o < 64; o <<= 1) { const float t = __shfl_up(s, o); if (lane >= o) s += t; }
            const float bc1 = s, bc0 = s - lf1, gv0 = ip0 - bc0, gv1 = ip1 - bc1;
            float pm = fmaxf(gv0, gv1);
#pragma unroll
            for (int o = 1; o < 64; o <<= 1) { const float t = __shfl_up(pm, o); if (lane >= o) pm = fmaxf(pm, t); }
            float ex = __shfl_up(pm, 1); if (lane == 0) ex = -INFINITY;
            GV[c * 128 + j0] = gv0; GV[c * 128 + j1] = gv1; PM[c * 128 + j0] = fmaxf(ex, gv0); PM[c * 128 + j1] = pm; BC[c * 128 + j0] = bc0; BC[c * 128 + j1] = bc1;
            if (lane == 63) { SCB[2 * c] = bc1; SCB[2 * c + 1] = pm; }
        }
        if (tid < 128) GH[tid] = a.g_mlstm_head[h * 128 + tid];
    }
    float m_prev = 0.f;
    f32x4 ct[9];
#pragma unroll
    for (int vt = 0; vt < 9; ++vt) ct[vt] = (f32x4){0.f, 0.f, 0.f, 0.f};
    bf16x8 ones; { const short o = (fr == 0) ? (short)0x3F80 : (short)0; ones = (bf16x8){o, o, o, o, o, o, o, o}; }
    u32x4 kreg[4], vreg[4]; bf16x8 qf[4];
    const int pj = tid >> 4, pch = tid & 15;
#define ML_PREFETCH(c_) do { const int r0_ = b * SEQ + (c_) * M_CHUNK; \
        _Pragma("unroll") for (int i = 0; i < 4; ++i) { kreg[i] = *(const u32x4*)(qc + (size_t)(r0_ + pj + 32 * i) * 1024 + 512 + h * 128 + pch * 8); vreg[i] = *(const u32x4*)(vo + (size_t)(r0_ + pj + 32 * i) * 1024 + h * 128 + pch * 8); } } while (0)
#define ML_PREFETCH_Q(c_) do { const int r0_ = b * SEQ + (c_) * M_CHUNK; \
        _Pragma("unroll") for (int s = 0; s < 4; ++s) qf[s] = *(const bf16x8*)(qc + (size_t)(r0_ + 16 * w + fr) * 1024 + h * 128 + 32 * s + 8 * g); } while (0)
    ML_PREFETCH(0); ML_PREFETCH_Q(0);
    for (int c = 0; c < NCHUNK; ++c) {
        const int r0 = b * SEQ + c * M_CHUNK, irow = r0 + 16 * w + fr;
#pragma unroll
        for (int i = 0; i < 4; ++i) { const int j = pj + 32 * i;
            *(LAS u32x4*)(lds + ML_KS + j * 272 + pch * 16) = kreg[i];
            const u32x4 v = vreg[i]; const int p = (j & ~31) | jpos32(j & 31);
            LAS unsigned short* d = (LAS unsigned short*)(lds + ML_VTS + (pch * 8) * 272 + p * 2);
            d[0 * 136] = (unsigned short)(v.x & 0xffff); d[1 * 136] = (unsigned short)(v.x >> 16); d[2 * 136] = (unsigned short)(v.y & 0xffff); d[3 * 136] = (unsigned short)(v.y >> 16);
            d[4 * 136] = (unsigned short)(v.z & 0xffff); d[5 * 136] = (unsigned short)(v.z >> 16); d[6 * 136] = (unsigned short)(v.w & 0xffff); d[7 * 136] = (unsigned short)(v.w >> 16); }
#pragma unroll
        for (int vt = 0; vt < 9; ++vt)
#pragma unroll
            for (int r = 0; r < 4; ++r) *(LAS unsigned short*)(lds + ML_CS + (16 * vt + 4 * g + r) * 272 + (16 * w + fr) * 2) = (unsigned short)(cvtpk(ct[vt][r], 0.f) & 0xffff);
        __syncthreads();
        if (c + 1 < NCHUNK) ML_PREFETCH(c + 1);
        const float Ml = fmaxf(SCB[2 * c + 1], m_prev), m_new = SCB[2 * c] + Ml, decay = __expf(m_prev - Ml);
        const float Mi = fmaxf(PM[c * 128 + 16 * w + fr], m_prev), bci = BC[c * 128 + 16 * w + fr];
        const float sint = __expf(m_prev - Mi);
        unsigned pk[8][2];
#pragma unroll
        for (int jt = 0; jt < 8; ++jt) {
            pk[jt][0] = 0u; pk[jt][1] = 0u;
            if (jt <= w) {
                f32x4 st = {0.f, 0.f, 0.f, 0.f};
#pragma unroll
                for (int s = 0; s < 4; ++s) st = __builtin_amdgcn_mfma_f32_16x16x32_bf16(*(const LAS bf16x8*)(lds + ML_KS + (16 * jt + fr) * 272 + (32 * s + 8 * g) * 2), qf[s], st, 0, 0, 0);
                const f32x4 gvv = *(const LAS f32x4*)(lds + ML_GV + (c * 128 + 16 * jt + 4 * g) * 4); float p[4];
#pragma unroll
                for (int r = 0; r < 4; ++r) { const bool ok = (jt < w) || (4 * g + r <= fr); p[r] = ok ? st[r] * __expf(gvv[r] - Mi) : 0.f; }
                pk[jt][0] = cvtpk(p[0], p[1]); pk[jt][1] = cvtpk(p[2], p[3]);
            }
        }
        u32x2 so[8];
#pragma unroll
        for (int vt = 0; vt < 8; ++vt) so[vt] = *(const u32x2*)(vo + (size_t)irow * 1024 + 512 + h * 128 + 16 * vt + 4 * g);
        f32x4 hacc[9];
#pragma unroll
        for (int vt = 0; vt < 9; ++vt) {
            f32x4 hh = {0.f, 0.f, 0.f, 0.f};
#pragma unroll
            for (int s = 0; s < 4; ++s) hh = __builtin_amdgcn_mfma_f32_16x16x32_bf16(*(const LAS bf16x8*)(lds + ML_CS + (16 * vt + fr) * 272 + (32 * s + 8 * g) * 2), qf[s], hh, 0, 0, 0);
            hh = hh * sint;
#pragma unroll
            for (int s = 0; s < 4; ++s) if (2 * s <= w) {
                const bf16x8 av = (vt < 8) ? *(const LAS bf16x8*)(lds + ML_VTS + (16 * vt + fr) * 272 + (32 * s + 8 * g) * 2) : ones;
                const u32x4 pb = {pk[2 * s][0], pk[2 * s][1], pk[2 * s + 1][0], pk[2 * s + 1][1]};
                hh = __builtin_amdgcn_mfma_f32_16x16x32_bf16(av, __builtin_bit_cast(bf16x8, pb), hh, 0, 0, 0); }
            hacc[vt] = hh;
            if (vt & 1) asm volatile("" ::: "memory");
        }
        if (c + 1 < NCHUNK) ML_PREFETCH_Q(c + 1);
        {
            const float den = __shfl(hacc[8][0], fr);
            const float inv = 1.0f / fmaxf(fabsf(den), __expf(-(bci + Mi)));
            float ss = 0.f;
#pragma unroll
            for (int vt = 0; vt < 8; ++vt) { hacc[vt] = hacc[vt] * inv; ss += (hacc[vt][0] * hacc[vt][0] + hacc[vt][1] * hacc[vt][1]) + (hacc[vt][2] * hacc[vt][2] + hacc[vt][3] * hacc[vt][3]); }
            ss += __shfl_xor(ss, 16); ss += __shfl_xor(ss, 32);
            const float rs = rsqrtf(ss * (1.0f / 128.0f) + RMS_EPS);
#pragma unroll
            for (int vt = 0; vt < 8; ++vt) { const int v0 = 16 * vt + 4 * g;
                const f32x4 gh = *(const LAS f32x4*)(lds + ML_GH + v0 * 4);
                const f32x4 y = {hacc[vt][0] * rs * gh[0] * bflo(so[vt].x), hacc[vt][1] * rs * gh[1] * bfhi(so[vt].x), hacc[vt][2] * rs * gh[2] * bflo(so[vt].y), hacc[vt][3] * rs * gh[3] * bfhi(so[vt].y)};
                u32x2 o; o.x = cvtpk(y[0], y[1]); o.y = cvtpk(y[2], y[3]); *(u32x2*)(ys + (size_t)irow * 1024 + h * 128 + v0) = o; }
        }
        {
            bf16x8 kb[4];
#pragma unroll
            for (int s = 0; s < 4; ++s) {
                const f32x4 g0 = *(const LAS f32x4*)(lds + ML_GV + (c * 128 + 32 * s + 4 * g) * 4), g1 = *(const LAS f32x4*)(lds + ML_GV + (c * 128 + 32 * s + 16 + 4 * g) * 4); float kv[8];
#pragma unroll
                for (int e = 0; e < 4; ++e) { kv[e] = bf2f(*(const LAS unsigned short*)(lds + ML_KS + (32 * s + 4 * g + e) * 272 + (16 * w + fr) * 2)) * __expf(g0[e] - Ml);
                    kv[4 + e] = bf2f(*(const LAS unsigned short*)(lds + ML_KS + (32 * s + 16 + 4 * g + e) * 272 + (16 * w + fr) * 2)) * __expf(g1[e] - Ml); }
                const u32x4 kk = {cvtpk(kv[0], kv[1]), cvtpk(kv[2], kv[3]), cvtpk(kv[4], kv[5]), cvtpk(kv[6], kv[7])}; kb[s] = __builtin_bit_cast(bf16x8, kk);
            }
#pragma unroll
            for (int vt = 0; vt < 9; ++vt) { f32x4 cc = ct[vt] * decay;
#pragma unroll
                for (int s = 0; s < 4; ++s) { const bf16x8 av = (vt < 8) ? *(const LAS bf16x8*)(lds + ML_VTS + (16 * vt + fr) * 272 + (32 * s + 8 * g) * 2) : ones;
                    cc = __builtin_amdgcn_mfma_f32_16x16x32_bf16(av, kb[s], cc, 0, 0, 0); }
                ct[vt] = cc;
                if (vt & 1) asm volatile("" ::: "memory"); }
            m_prev = m_new;
        }
        __syncthreads();
    }
#undef ML_PREFETCH
#undef ML_PREFETCH_Q
}

constexpr int NS_KB = 0, NS_VB = 18432, NS_BT = 36864, NS_IMP = NS_BT + 4 * BIAS_LEN * 4, NS_SEL = NS_IMP + 4 * 64 * 33 * 4, NS_END = NS_SEL + 256;
static_assert(NS_END <= 140 * 1024, "NSA LDS map");
constexpr float LOG2E = 1.4426950408889634f;
__device__ __forceinline__ int crow32(int r, int hi) { return (r & 3) + 8 * (r >> 2) + 4 * hi; }

struct NsaState { float m, l; f32x16 o[2]; };
__device__ __forceinline__ void ns_reset(NsaState& s) { s.m = -1e30f; s.l = 0.f;
#pragma unroll
    for (int r = 0; r < 16; ++r) { s.o[0][r] = 0.f; s.o[1][r] = 0.f; } }

__device__ __forceinline__ void ns_qk(f32x16& s0, f32x16& s1, const LAS unsigned char* kb, const bf16x8* qf, int q, int hi) {
#pragma unroll
    for (int r = 0; r < 16; ++r) { s0[r] = 0.f; s1[r] = 0.f; }
#pragma unroll
    for (int ks = 0; ks < 4; ++ks) {
        const bf16x8 a0 = *(const LAS bf16x8*)(kb + q * 144 + ks * 32 + hi * 16), a1 = *(const LAS bf16x8*)(kb + (32 + q) * 144 + ks * 32 + hi * 16);
        s0 = __builtin_amdgcn_mfma_f32_32x32x16_bf16(a0, qf[ks], s0, 0, 0, 0); s1 = __builtin_amdgcn_mfma_f32_32x32x16_bf16(a1, qf[ks], s1, 0, 0, 0);
    }
}
__device__ __forceinline__ void ns_pv(f32x16* o, const f32x16& p0, const f32x16& p1, const LAS unsigned char* vb, int q, int hi) {
    bf16x8 pf[4];
#pragma unroll
    for (int h2 = 0; h2 < 2; ++h2) { const u32x4 a = {cvtpk(p0[8 * h2 + 0], p0[8 * h2 + 1]), cvtpk(p0[8 * h2 + 2], p0[8 * h2 + 3]), cvtpk(p0[8 * h2 + 4], p0[8 * h2 + 5]), cvtpk(p0[8 * h2 + 6], p0[8 * h2 + 7])};
        const u32x4 b = {cvtpk(p1[8 * h2 + 0], p1[8 * h2 + 1]), cvtpk(p1[8 * h2 + 2], p1[8 * h2 + 3]), cvtpk(p1[8 * h2 + 4], p1[8 * h2 + 5]), cvtpk(p1[8 * h2 + 6], p1[8 * h2 + 7])};
        pf[h2] = __builtin_bit_cast(bf16x8, a); pf[2 + h2] = __builtin_bit_cast(bf16x8, b); }
#pragma unroll
    for (int dt = 0; dt < 2; ++dt)
#pragma unroll
        for (int ks = 0; ks < 4; ++ks) o[dt] = __builtin_amdgcn_mfma_f32_32x32x16_bf16(*(const LAS bf16x8*)(vb + (32 * dt + q) * 144 + ks * 32 + hi * 16), pf[ks], o[dt], 0, 0, 0);
}
template <int MODE>
__device__ __forceinline__ void ns_block(NsaState& st, const LAS unsigned char* kb, const LAS unsigned char* vb, const bf16x8* qf, const LAS float* bt, int dq, bool selbit, int q, int hi) {
    f32x16 s0, s1; ns_qk(s0, s1, kb, qf, q, hi);
    float mx = -1e30f;
#pragma unroll
    for (int r = 0; r < 16; ++r) {
        const int k0 = crow32(r, hi), d0 = dq - k0, d1 = d0 - 32;
        const bool v0 = MODE == 0 ? (selbit && d0 >= 0) : (d0 >= 0 && d0 < 512), v1 = MODE == 0 ? (selbit && d1 >= 0) : (d1 >= 0 && d1 < 512);
        const float x0 = s0[r] * LOG2E + bt[max(d0, -BIAS_PAD) + BIAS_PAD], x1 = s1[r] * LOG2E + bt[max(d1, -BIAS_PAD) + BIAS_PAD];
        s0[r] = v0 ? x0 : -1e30f; s1[r] = v1 ? x1 : -1e30f; mx = fmaxf(mx, fmaxf(s0[r], s1[r]));
    }
    mx = fmaxf(mx, __shfl_xor(mx, 32));
    const float mn = fmaxf(st.m, mx), sc = exp2f(st.m - mn); st.m = mn;
    float ls = 0.f;
#pragma unroll
    for (int r = 0; r < 16; ++r) { s0[r] = (s0[r] > -1e29f) ? exp2f(s0[r] - mn) : 0.f; s1[r] = (s1[r] > -1e29f) ? exp2f(s1[r] - mn) : 0.f; ls += s0[r] + s1[r]; }
    st.l = st.l * sc + ls;
#pragma unroll
    for (int r = 0; r < 16; ++r) { st.o[0][r] *= sc; st.o[1][r] *= sc; }
    ns_pv(st.o, s0, s1, vb, q, hi);
}
__device__ __forceinline__ void ns_finish(f32x16* out, NsaState& st, float gate) {
    const float lt = st.l + __shfl_xor(st.l, 32); const float f = gate / fmaxf(lt, 1e-30f);
#pragma unroll
    for (int r = 0; r < 16; ++r) { out[0][r] += st.o[0][r] * f; out[1][r] += st.o[1][r] * f; }
}
__device__ __forceinline__ void ns_load(u32x4& kr, u32x4& vr, const bf16_t* kblk, const bf16_t* vblk, int tid) { kr = *(const u32x4*)(kblk + tid * 8); vr = *(const u32x4*)(vblk + tid * 8); }
__device__ __forceinline__ void ns_store(LAS unsigned char* lds, int buf, const u32x4& kr, const u32x4& vr, int tid) {
    const int row = tid >> 3, c = tid & 7; *(LAS u32x4*)(lds + NS_KB + buf * 9216 + row * 144 + c * 16) = kr; *(LAS u32x4*)(lds + NS_VB + buf * 9216 + row * 144 + c * 16) = vr; }

__device__ __forceinline__ void nsa_unit(const Args& a, LAS unsigned char* lds, int b, int g, int qi, int& cur_g, int tid, int wave, int lane) {
    unsigned char* ws = a.ws;
    asm volatile("" : "+v"(tid), "+v"(lane));
    const int q = lane & 31, hi = lane >> 5, r = wave >> 1, th = wave & 1, head = g * 4 + r;
    const int tl = 64 * qi + 32 * th + q, row = b * SEQ + tl;
    const bf16_t* nkv = (const bf16_t*)(ws + WS_NKV);
    if (cur_g != g) { __syncthreads(); const float* bt = (const float*)(ws + WS_BTAB) + (size_t)g * 4 * BIAS_LEN;
#pragma unroll 1
        for (int i = tid; i < 4 * BIAS_LEN; i += NTHREADS) ((LAS float*)(lds + NS_BT))[i] = bt[i];
        cur_g = g; }
    const LAS float* btab = (const LAS float*)(lds + NS_BT) + r * BIAS_LEN;
    bf16x8 qf[4];
#pragma unroll
    for (int ks = 0; ks < 4; ++ks) qf[ks] = *(const bf16x8*)((const bf16_t*)(ws + WS_NQ) + (size_t)row * 512 + head * 64 + ks * 16 + hi * 8);
    const float* smr = (const float*)(ws + WS_SM) + (size_t)row * 32 + 8 + head * 3;
    const float gc = sigmoidf_(smr[0]), gs = sigmoidf_(smr[1]), gw = sigmoidf_(smr[2]);
    f32x16 out[2];
#pragma unroll
    for (int rr = 0; rr < 16; ++rr) { out[0][rr] = 0.f; out[1][rr] = 0.f; }
    NsaState st;
    u32x4 kr, vr;
    const int ncb = (qi >= 16) ? 2 : 1;
    {
        const bf16_t* kcb = (const bf16_t*)(ws + WS_KC) + (size_t)(b * 2 + g) * 128 * 64; const bf16_t* vcb = (const bf16_t*)(ws + WS_VCT) + (size_t)(b * 2 + g) * 2 * 4096;
        __syncthreads();
        ns_load(kr, vr, kcb, vcb, tid); ns_store(lds, 0, kr, vr, tid);
        if (ncb == 2) { ns_load(kr, vr, kcb + 4096, vcb + 4096, tid); ns_store(lds, 1, kr, vr, tid); }
        __syncthreads();
        f32x16 s[2][2];
        float mx = -1e30f;
#pragma unroll
        for (int cb = 0; cb < 2; ++cb) {
            if (cb < ncb) {
                ns_qk(s[cb][0], s[cb][1], lds + NS_KB + cb * 9216, qf, q, hi);
#pragma unroll
                for (int T = 0; T < 2; ++T)
#pragma unroll
                    for (int rr = 0; rr < 16; ++rr) { const int c = 64 * cb + 32 * T + crow32(rr, hi), d = tl - 16 * c - 31;
                        const float x = s[cb][T][rr] * LOG2E + btab[max(d, -BIAS_PAD) + BIAS_PAD]; s[cb][T][rr] = (d >= 0) ? x : -1e30f; mx = fmaxf(mx, s[cb][T][rr]); }
            } else {
#pragma unroll
                for (int rr = 0; rr < 16; ++rr) { s[cb][0][rr] = -1e30f; s[cb][1][rr] = -1e30f; }
            }
        }
        mx = fmaxf(mx, __shfl_xor(mx, 32));
        float ls = 0.f;
#pragma unroll
        for (int cb = 0; cb < 2; ++cb)
#pragma unroll
            for (int T = 0; T < 2; ++T)
#pragma unroll
                for (int rr = 0; rr < 16; ++rr) { const float e = (s[cb][T][rr] > -1e29f) ? exp2f(s[cb][T][rr] - mx) : 0.f; s[cb][T][rr] = e; ls += e; }
        ns_pv(out, s[0][0], s[0][1], lds + NS_VB, q, hi);
        if (ncb == 2) ns_pv(out, s[1][0], s[1][1], lds + NS_VB + 9216, q, hi);
        const float lt = ls + __shfl_xor(ls, 32), rinv = 1.0f / fmaxf(lt, 1e-30f);
        { const float f = gc * rinv;
#pragma unroll
          for (int rr = 0; rr < 16; ++rr) { out[0][rr] *= f; out[1][rr] *= f; } }
        if (qi >= 16) {
            LAS float* imp = (LAS float*)(lds + NS_IMP) + (r * 64 + 32 * th + q) * 33;
            float prevB = 0.f;
#pragma unroll
            for (int cb = 0; cb < 2; ++cb)
#pragma unroll
                for (int T = 0; T < 2; ++T)
#pragma unroll
                    for (int q4 = 0; q4 < 4; ++q4) { const int n = cb * 8 + T * 4 + q4; const float p0 = s[cb][T][4 * q4] * rinv, p1 = s[cb][T][4 * q4 + 1] * rinv, p2 = s[cb][T][4 * q4 + 2] * rinv, p3 = s[cb][T][4 * q4 + 3] * rinv;
                        const float An = 2.0f * (p0 + p1 + p2) + p3, pb = __shfl_xor(p3, 32);
                        imp[2 * n + hi] = hi ? (An + pb) : (An + prevB); prevB = pb; }
        }
        __syncthreads();
        if (qi >= 16) {
            const int tq = tid >> 3, sub = tid & 7; const LAS float* ip = (const LAS float*)(lds + NS_IMP) + tq * 33;
            float sc[32];
#pragma unroll
            for (int j = 0; j < 32; ++j) sc[j] = ((ip[j] + ip[64 * 33 + j]) + ip[2 * 64 * 33 + j]) + ip[3 * 64 * 33 + j];
            unsigned bits = 0u;
#pragma unroll
            for (int jj = 0; jj < 4; ++jj) { const int j = sub * 4 + jj; int rank = 0;
                const float mine = ((ip[j] + ip[64 * 33 + j]) + ip[2 * 64 * 33 + j]) + ip[3 * 64 * 33 + j];
#pragma unroll
                for (int j2 = 0; j2 < 32; ++j2) { const bool cand = (j2 >= 1 && j2 <= qi - 2); rank += (cand && (sc[j2] > mine || (sc[j2] == mine && j2 < j))) ? 1 : 0; }
                const bool forced = (j == 0) || (j == qi) || (j == qi - 1);
                if (forced || (j >= 1 && j <= qi - 2 && rank < SEL_TOPK - 3)) bits |= 1u << j; }
            bits |= __shfl_xor(bits, 1); bits |= __shfl_xor(bits, 2); bits |= __shfl_xor(bits, 4);
            if (sub == 0) ((LAS unsigned*)(lds + NS_SEL))[tq] = bits;
        } else if (tid < 64) ((LAS unsigned*)(lds + NS_SEL))[tid] = (qi >= 31) ? 0xffffffffu : ((2u << qi) - 1u);
        __syncthreads();
    }
    const unsigned selm = ((const LAS unsigned*)(lds + NS_SEL))[32 * th + q];
    {
        const bf16_t* kb = nkv + ((size_t)(4 + g) * MTOK + (size_t)b * SEQ) * 64; const bf16_t* vb = (const bf16_t*)(ws + WS_VST) + (size_t)(b * 2 + g) * 32 * 4096;
        ns_reset(st);
        ns_load(kr, vr, kb, vb, tid);
        for (int j = 0; j <= qi; ++j) {
            ns_store(lds, j & 1, kr, vr, tid);
            __syncthreads();
            if (j < qi) ns_load(kr, vr, kb + (size_t)(j + 1) * 4096, vb + (size_t)(j + 1) * 4096, tid);
            ns_block<0>(st, lds + NS_KB + (j & 1) * 9216, lds + NS_VB + (j & 1) * 9216, qf, btab, tl - 64 * j, (selm >> j) & 1u, q, hi);
        }
        ns_finish(out, st, gs);
    }
    {
        const bf16_t* kb = nkv + ((size_t)(8 + g) * MTOK + (size_t)b * SEQ) * 64; const bf16_t* vb = (const bf16_t*)(ws + WS_VWT) + (size_t)(b * 2 + g) * 32 * 4096;
        const int j0 = qi >= 8 ? qi - 8 : 0;
        ns_reset(st);
        __syncthreads();
        ns_load(kr, vr, kb + (size_t)j0 * 4096, vb + (size_t)j0 * 4096, tid);
        for (int j = j0; j <= qi; ++j) {
            ns_store(lds, j & 1, kr, vr, tid);
            __syncthreads();
            if (j < qi) ns_load(kr, vr, kb + (size_t)(j + 1) * 4096, vb + (size_t)(j + 1) * 4096, tid);
            ns_block<1>(st, lds + NS_KB + (j & 1) * 9216, lds + NS_VB + (j & 1) * 9216, qf, btab, tl - 64 * j, true, q, hi);
        }
        ns_finish(out, st, gw);
    }
    bf16_t* yn = (bf16_t*)(ws + WS_QK) + (size_t)row * 1024 + 512 + head * 64;
#pragma unroll
    for (int dt = 0; dt < 2; ++dt)
#pragma unroll
        for (int q4 = 0; q4 < 4; ++q4) { u32x2 w; w.x = cvtpk(out[dt][4 * q4], out[dt][4 * q4 + 1]); w.y = cvtpk(out[dt][4 * q4 + 2], out[dt][4 * q4 + 3]); *(u32x2*)(yn + 32 * dt + 8 * q4 + 4 * hi) = w; }
}

__device__ __forceinline__ void p3_mixers(const Args& a, LAS unsigned char* lds, int tid, int wave, int lane, int cword = 0) {
    unsigned* ctr = (unsigned*)(a.ws + WS_CTL) + cword;
    LAS unsigned* slot = (LAS unsigned*)(lds + 143 * 1024);
    int cur_g = -1;
    for (int it_ = 0;; ++it_) {
        __syncthreads();
#ifdef DBG_STATIC_Q
        if (tid == 0) *slot = (unsigned)(blockIdx.x + it_ * gridDim.x);
#else
        if (tid == 0) *slot = atomicAdd(ctr, 1u);
#endif
        __syncthreads();
        const int idx = (int)*slot;
        if (idx >= 64 + 1024) break;
        if (idx < 64) {
#ifdef DBG_NO_ML
            { const int b = idx >> 2, h = idx & 3; bf16_t* ym = (bf16_t*)(a.ws + WS_QK) + (size_t)b * SEQ * 1024 + h * 128;
              for (int i = tid; i < SEQ * 16; i += NTHREADS) *(u32x4*)(ym + (size_t)(i >> 4) * 1024 + (i & 15) * 8) = (u32x4){0u, 0u, 0u, 0u}; }
#else
            mlstm_item(a, lds, idx >> 2, idx & 3, tid, wave, lane);
#endif
            cur_g = -1; }
        else { const int u = idx - 64;
#ifdef DBG_NO_NSA
            { const int b = (u & 31) >> 1, g = u & 1, qi = 31 - (u >> 5); bf16_t* yn = (bf16_t*)(a.ws + WS_QK) + ((size_t)b * SEQ + qi * 64) * 1024 + 512 + g * 256;
              for (int i = tid; i < 64 * 32; i += NTHREADS) *(u32x4*)(yn + (size_t)(i >> 5) * 1024 + (i & 31) * 8) = (u32x4){0u, 0u, 0u, 0u}; }
#else
            nsa_unit(a, lds, (u & 31) >> 1, u & 1, 31 - (u >> 5), cur_g, tid, wave, lane);
#endif
        }
    }
}

__global__ void __launch_bounds__(NTHREADS, 2) mega_fwd(Args a) {
    extern __shared__ __attribute__((aligned(16))) unsigned char lds_raw[];
    LAS unsigned char* lds = (LAS unsigned char*)lds_raw;
    const int tid = threadIdx.x, lane = tid & 63, wave = __builtin_amdgcn_readfirstlane(tid >> 6);
    const int G = gridDim.x; const int bx = blockIdx.x; const int vcu = (G % 8 == 0) ? (bx % 8) * (G / 8) + bx / 8 : bx;
    cg::grid_group grid = cg::this_grid();
    unsigned char* ws = a.ws;
    const int lo = a.ph_lo, hi = a.ph_hi;
#define IN(k) (lo <= (k) && (k) < hi)
#define FULLSYNC() do { asm volatile("s_waitcnt vmcnt(0) lgkmcnt(0)" ::: "memory"); __builtin_amdgcn_fence(__ATOMIC_RELEASE, "agent"); asm volatile("s_waitcnt vmcnt(0)" ::: "memory"); grid.sync(); \
    if (tid < 64) { __builtin_amdgcn_fence(__ATOMIC_ACQUIRE, "agent"); asm volatile("s_waitcnt vmcnt(0)" ::: "memory"); } __syncthreads(); } while (0)
#define SEAM(k) do { if (IN(k) && IN((k) + 1)) { asm volatile("s_waitcnt vmcnt(0) lgkmcnt(0)" ::: "memory"); __builtin_amdgcn_fence(__ATOMIC_RELEASE, "agent"); asm volatile("s_waitcnt vmcnt(0)" ::: "memory"); grid.sync(); \
      \
    if (tid < 64) { __builtin_amdgcn_fence(__ATOMIC_ACQUIRE, "agent"); asm volatile("s_waitcnt vmcnt(0)" ::: "memory"); } __syncthreads(); } } while (0)

#define PH0() p0_prologue(a, lds, vcu, G, wave, lane)
#define PH1() do { pg8::StaticOrder S; S.init(ws + WS_XB, 1024, ws + WS_W1T, 1024, MTOK, N1, G, bx); \
        EpiProj E{(const float*)(ws + WS_RSX), (const float*)(ws + WS_BIAS1), ws}; \
        pg8::gemm_phase<EpiProj, pg8::StaticOrder, true>(lds, pg8::Dims{1024, 1024, 16}, S, E); } while (0)
#define PH2() p2_prep(a, lds, bx, G, wave, lane)
#define PH3() p3_mixers(a, lds, tid, wave, lane, 0)
#define PH4() do { pg8::DualOrder S; S.init(ws + WS_QK, 1024, ws + WS_WBRT, 512, MTOK, 1024, G, bx, (size_t)512 * 2, (size_t)1024 * 512 * 2); \
        EpiBranch E{(const bf16_t*)(ws + WS_GT), (bf16_t*)(ws + WS_VO)}; \
        pg8::gemm_phase<EpiBranch, pg8::DualOrder, true>(lds, pg8::Dims{1024, 512, 8}, S, E); } while (0)
#define PH5() do { pg8::StaticOrder S; S.init(ws + WS_VO, 1024, ws + WS_WOUTT, 1024, MTOK, 1024, G, bx); \
        EpiResid E{a.x, a.out, (bf16_t*)(ws + WS_XB), (float*)(ws + WS_PART1)}; \
        pg8::gemm_phase<EpiResid, pg8::StaticOrder, true>(lds, pg8::Dims{1024, 1024, 16}, S, E); } while (0)
#define PH6() do { pg8::StaticOrder S; S.init(ws + WS_XB, 1024, ws + WS_WGUT, 1024, MTOK, NGU, G, bx); \
        EpiGateUp E{(const float*)(ws + WS_PART1), (bf16_t*)(ws + WS_HID)}; \
        pg8::gemm_phase<EpiGateUp, pg8::StaticOrder, true>(lds, pg8::Dims{1024, 1024, 16}, S, E); } while (0)
#define PH7() do { pg8::StaticOrder S; S.init(ws + WS_HID, D_FF, ws + WS_WDNT, D_FF, MTOK, 1024, G, bx); \
        EpiResid E{a.out, a.out, nullptr, (float*)(ws + WS_PART2)}; \
        pg8::gemm_phase<EpiResid, pg8::StaticOrder, true>(lds, pg8::Dims{D_FF, D_FF, D_FF / 64}, S, E); } while (0)
#define PH8() p8_final(a, vcu, G, wave, lane)
#ifndef DUP_PHASE
#define DUP_PHASE -1
#endif
#define RUN(k, PH) do { if (IN(k)) { PH(); if (DUP_PHASE == (k)) { FULLSYNC(); if ((k) == 3) p3_mixers(a, lds, tid, wave, lane, 1); else PH(); } } } while (0)
    RUN(0, PH0); SEAM(0);
    RUN(1, PH1); SEAM(1);
    RUN(2, PH2); SEAM(2);
    RUN(3, PH3); SEAM(3);
    RUN(4, PH4); SEAM(4);
    RUN(5, PH5); SEAM(5);
    RUN(6, PH6); SEAM(6);
    RUN(7, PH7); SEAM(7);
    RUN(8, PH8);
#undef IN
#undef SEAM
}

constexpr int NPHASES = 9;
#ifndef N_LAUNCHES
#define N_LAUNCHES 1
#endif
extern "C" void kernel_launch(void* const* d_in, const int* in_sizes, int n_in, void* d_out, int out_size, void* d_ws, size_t ws_size, hipStream_t stream) {
    static int grid = 0;
    if (grid == 0) {
        if (n_in != 18 || out_size != MTOK * D_MODEL || ws_size < WS_END) { fprintf(stderr, "kernel_launch: unexpected shapes (n_in %d out %d ws %zu)\n", n_in, out_size, ws_size); grid = -1; return; }
        int dev = 0, cus = 0, per_cu = 0;
        if (hipGetDevice(&dev) != hipSuccess || hipDeviceGetAttribute(&cus, hipDeviceAttributeMultiprocessorCount, dev) != hipSuccess) { grid = -1; return; }
        if (hipFuncSetAttribute((const void*)mega_fwd, hipFuncAttributeMaxDynamicSharedMemorySize, LDS_BYTES) != hipSuccess) { fprintf(stderr, "kernel_launch: hipFuncSetAttribute failed\n"); grid = -1; return; }
        if (hipOccupancyMaxActiveBlocksPerMultiprocessor(&per_cu, (const void*)mega_fwd, NTHREADS, LDS_BYTES) != hipSuccess || per_cu < 1) { fprintf(stderr, "kernel_launch: occupancy query says %d blocks per CU\n", per_cu); per_cu = 1; }
        (void)hipGetLastError();
        grid = cus;
    }
    if (grid < 0) return;
    Args a{};
    const float** ap = (const float**)&a;
    for (int i = 0; i < 18; ++i) ap[i] = (const float*)d_in[i];
    a.out = (float*)d_out; a.ws = (unsigned char*)d_ws;
    if (N_LAUNCHES == 1) {
        a.ph_lo = 0; a.ph_hi = NPHASES; a.coop = 1; a.pad = 0;
        void* args[] = {&a};
        hipError_t e = hipLaunchCooperativeKernel((const void*)mega_fwd, dim3(grid), dim3(NTHREADS), args, LDS_BYTES, stream);
        if (e != hipSuccess) fprintf(stderr, "kernel_launch: cooperative launch failed: %s (grid %d)\n", hipGetErrorString(e), grid);
    } else {
        for (int p = 0; p < NPHASES; ++p) {
            a.ph_lo = p; a.ph_hi = p + 1; a.coop = 0; a.pad = 0;
            hipLaunchKernelGGL(mega_fwd, dim3(grid), dim3(NTHREADS), LDS_BYTES, stream, a);
        }
    }
}
```

```cpp
#include <hip/hip_runtime.h>
#include <hip/hip_cooperative_groups.h>
#include <cstdio>
#include <cstdint>
namespace cg = cooperative_groups;

#define LAS __attribute__((address_space(3)))
typedef unsigned short bf16_t;
typedef short bf16x8 __attribute__((ext_vector_type(8)));
typedef short s16x4 __attribute__((ext_vector_type(4)));
typedef float f32x4 __attribute__((ext_vector_type(4)));
typedef float f32x2 __attribute__((ext_vector_type(2)));
typedef float f32x16 __attribute__((ext_vector_type(16)));
typedef unsigned u32x4 __attribute__((ext_vector_type(4)));
typedef unsigned u32x2 __attribute__((ext_vector_type(2)));
typedef __bf16 bf16x2_t __attribute__((ext_vector_type(2)));

constexpr int D_MODEL = 1024, BATCH = 16, SEQ = 2048, MTOK = BATCH * SEQ;
constexpr int M_HEADS = 4, M_HD = 128, M_WIDTH = 512, M_CHUNK = 128, NCHUNK = SEQ / M_CHUNK;
constexpr int N_HEADS = 8, N_G = 2, N_R = 4, N_HD = 64;
constexpr int N_CMP = 127, N_SLC = 32, SEL_TOPK = 16;
constexpr int D_FF = 2816, D_IN = 5408;
constexpr int N1 = 5632;
constexpr int NGU = 2 * D_FF;
constexpr float RMS_EPS = 1e-6f;
constexpr int BIAS_PAD = 64, BIAS_LEN = SEQ + BIAS_PAD;

constexpr size_t KiB = 1024, MiB = 1u << 20;
constexpr size_t WS_CTL   = 0;
constexpr size_t WS_BIAS1 = 4 * KiB;
constexpr size_t WS_PEB   = 28 * KiB;
constexpr size_t WS_WC2T  = 32 * KiB;
constexpr size_t WS_BTAB  = 64 * KiB;
constexpr size_t WS_RSX   = 256 * KiB;
constexpr size_t WS_W1T   = 1 * MiB;
constexpr size_t WS_WGUT  = 12 * MiB;
constexpr size_t WS_WDNT  = 23 * MiB;
constexpr size_t WS_WOUTT = 29 * MiB;
constexpr size_t WS_WBRT  = 31 * MiB;
constexpr size_t WS_WC1T  = 33 * MiB;
constexpr size_t WS_PART1 = 34 * MiB;
constexpr size_t WS_PART2 = 36 * MiB;
constexpr size_t WS_KC    = 38 * MiB;
constexpr size_t WS_VCT   = 38 * MiB + 512 * KiB;
constexpr size_t WS_HAB   = 39 * MiB;
constexpr size_t WS_XB    = 48 * MiB;
constexpr size_t WS_QK    = 112 * MiB;
constexpr size_t WS_VO    = 176 * MiB;
constexpr size_t WS_NQ    = 240 * MiB;
constexpr size_t WS_NKV   = 272 * MiB;
constexpr size_t WS_HID   = 112 * MiB;
constexpr size_t WS_GT    = 320 * MiB;
constexpr size_t WS_SM    = 448 * MiB;
constexpr size_t WS_VST   = 452 * MiB;
constexpr size_t WS_VWT   = 460 * MiB;
constexpr size_t WS_END   = 468 * MiB;

__device__ __forceinline__ unsigned cvtpk(float lo, float hi) { f32x2 v = {lo, hi}; bf16x2_t b = __builtin_convertvector(v, bf16x2_t); return __builtin_bit_cast(unsigned, b); }
__device__ __forceinline__ float bf2f(unsigned short u) { return __uint_as_float(((unsigned)u) << 16); }
__device__ __forceinline__ float bflo(unsigned u) { return __uint_as_float(u << 16); }
__device__ __forceinline__ float bfhi(unsigned u) { return __uint_as_float(u & 0xffff0000u); }
__device__ __forceinline__ float sigmoidf_(float x) { return __builtin_amdgcn_rcpf(1.0f + __expf(-x)); }
__device__ __forceinline__ float wave_sum(float v) {
#pragma unroll
    for (int o = 1; o < 64; o <<= 1) v += __shfl_xor(v, o);
    return v;
}

namespace pg8 {
constexpr int BM = 256, BK = 64, HALF = 128, HTB = HALF * BK * 2  , STAGE_BYTES = 8 * HTB, NXCD = 8, WGM = 8;
__host__ __device__ __forceinline__ int lds_byte(int r, int c) { const int st = (r >> 4) * 2 + (c >> 5), rr = r & 15, cc = c & 31, ob = rr * 64 + cc * 2; return st * 1024 + (ob ^ (((ob >> 9) & 1) << 5)); }
__host__ __device__ __forceinline__ void stage_rc(int b, int& R, int& C) { const int st = b / 1024, sb = b % 1024, swz = sb ^ (((sb >> 9) & 1) << 5); R = (st >> 1) * 16 + swz / 64; C = (st & 1) * 32 + (swz % 64) / 2; }

struct Unit { int pm, pn, seg; const char* A; const char* B; };
struct Dims { int lda, ldb, nt; };

__device__ __forceinline__ void tile_of(int L, int nM, int nN, int& pm, int& pn) {
    const int nwg = nM * nN; int wgid = L; { const int q = nwg / NXCD, r = nwg % NXCD, xcd = wgid % NXCD, off = wgid / NXCD; wgid = (xcd < r ? xcd * (q + 1) : r * (q + 1) + (xcd - r) * q) + off; }
    const int nig = WGM * nN, gid = wgid / nig, fm = gid * WGM, gsz = (nM - fm) < WGM ? (nM - fm) : WGM;
    pm = fm + ((wgid % nig) % gsz); pn = (wgid % nig) / gsz;
}
struct StaticOrder {
    int nM, nN, nwg, G, c; const char* A; const char* B; size_t tstepA, tstepB;
    __device__ void init(const void* A_, int lda, const void* B_, int ldb, int M, int N, int G_, int c_) { nM = M / BM; nN = N / BM; nwg = nM * nN; G = G_; c = c_; A = (const char*)A_; B = (const char*)B_; tstepA = (size_t)BM * lda * 2; tstepB = (size_t)BM * ldb * 2; }
    __device__ __forceinline__ bool next(int i, Unit& u) const {
        const long L = (long)i * G + c; if (L >= nwg) return false;
        tile_of((int)L, nM, nN, u.pm, u.pn); u.seg = 0; u.A = A + (size_t)u.pm * tstepA; u.B = B + (size_t)u.pn * tstepB; return true;
    }
    __device__ __forceinline__ bool carry(const Unit&) const { return false; }
};
struct DualOrder {
    int nM, nN, nwg, G, c; const char* A; const char* B; size_t tstepA, tstepB, segA, segB;
    __device__ void init(const void* A_, int lda, const void* B_, int ldb, int M, int N, int G_, int c_, size_t segA_, size_t segB_) { nM = M / BM; nN = N / BM; nwg = nM * nN; G = G_; c = c_; A = (const char*)A_; B = (const char*)B_; tstepA = (size_t)BM * lda * 2; tstepB = (size_t)BM * ldb * 2; segA = segA_; segB = segB_; }
    __device__ __forceinline__ bool next(int i, Unit& u) const {
        const long L = (long)(i >> 1) * G + c; if (L >= nwg) return false;
        tile_of((int)L, nM, nN, u.pm, u.pn); u.seg = i & 1; u.A = A + (size_t)u.pm * tstepA + (size_t)u.seg * segA; u.B = B + (size_t)u.pn * tstepB + (size_t)u.seg * segB; return true;
    }
    __device__ __forceinline__ bool carry(const Unit& u) const { return u.seg == 0; }
};

template <class Epi, class Sched, bool ALIGN_EPI>
__device__ __forceinline__ void gemm_phase(LAS unsigned char* lds, const Dims g, const Sched& S, const Epi& E) {
    const int tid = threadIdx.x, wid = __builtin_amdgcn_readfirstlane(tid >> 6), lane = tid & 63, wr = wid >> 2, wc = wid & 3, fr = lane & 15, fq = lane >> 4;
    const int nt = g.nt;
    unsigned voffA[2], voffB[2];
#pragma unroll
    for (int i = 0; i < 2; ++i) { int R, C; stage_rc(tid * 16 + i * 8192, R, C); voffA[i] = (unsigned)(R * g.lda + C) * 2u; voffB[i] = (unsigned)(R * g.ldb + C) * 2u; }
    const size_t kstep = (size_t)(BK * 2);
    const size_t hstepA = (size_t)HALF * g.lda * 2, hstepB = (size_t)HALF * g.ldb * 2;
    const unsigned ldsw = (unsigned)wid * 1024u;
    const int aoff = lds_byte(wr * 64 + fr, fq * 8), boff = lds_byte(wc * 32 + fr, fq * 8);
#define PG8_SA(b, h) (((b) * 2 + (h)) * HTB)
#define PG8_SB(b, h) ((4 + (b) * 2 + (h)) * HTB)
#define PG8_STAGE(bufoff, gbase, voff) do { _Pragma("unroll") for (int _i = 0; _i < 2; ++_i) \
        __builtin_amdgcn_global_load_lds((const unsigned*)((const char*)(gbase) + (voff)[_i]), (LAS unsigned*)(lds + (bufoff) + ldsw + _i * 8192), 16, 0, 0); } while (0)
#define PG8_LDA(dst, b, h) do { _Pragma("unroll") for (int m = 0; m < 4; ++m) _Pragma("unroll") for (int k = 0; k < 2; ++k) dst[m][k] = *(const LAS bf16x8*)(lds + PG8_SA(b, h) + aoff + m * 2048 + k * 1024); } while (0)
#define PG8_LDB(dst, b, h) do { _Pragma("unroll") for (int n = 0; n < 2; ++n) _Pragma("unroll") for (int k = 0; k < 2; ++k) dst[n][k] = *(const LAS bf16x8*)(lds + PG8_SB(b, h) + boff + n * 2048 + k * 1024); } while (0)
#define PG8_MMA(ai, bj, At, Bt) do { __builtin_amdgcn_s_setprio(1); _Pragma("unroll") for (int m = 0; m < 4; ++m) _Pragma("unroll") for (int n = 0; n < 2; ++n) _Pragma("unroll") for (int k = 0; k < 2; ++k) \
        acc[ai][bj][m][n] = __builtin_amdgcn_mfma_f32_16x16x32_bf16(Bt[n][k], At[m][k], acc[ai][bj][m][n], 0, 0, 0); __builtin_amdgcn_s_setprio(0); } while (0)
#define PG8_WAIT_V(n) asm volatile("s_waitcnt vmcnt(" #n ")" ::: "memory")
#define PG8_WAIT_L(n) asm volatile("s_waitcnt lgkmcnt(" #n ")" ::: "memory")
#define PG8_BAR __builtin_amdgcn_s_barrier()
#define PG8_SCHED __builtin_amdgcn_sched_barrier(0)
    Unit cur, nxt; int ui = 0;
    if (!S.next(0, cur)) return;
    f32x4 acc[2][2][4][2];
#pragma unroll
    for (int a = 0; a < 2; ++a)
#pragma unroll
        for (int b = 0; b < 2; ++b)
#pragma unroll
            for (int m = 0; m < 4; ++m)
#pragma unroll
                for (int n = 0; n < 2; ++n) acc[a][b][m][n] = (f32x4){0.f, 0.f, 0.f, 0.f};
    bf16x8 At[4][2], B0[2][2], B1[2][2];
    const char* cA = cur.A; const char* cB = cur.B;
    PG8_STAGE(PG8_SB(0, 0), cB, voffB); PG8_STAGE(PG8_SB(0, 1), cB + hstepB, voffB); PG8_STAGE(PG8_SA(0, 0), cA, voffA); PG8_STAGE(PG8_SA(0, 1), cA + hstepA, voffA);
    if (wr == 1) PG8_BAR;
    PG8_WAIT_V(2); PG8_BAR;
    PG8_STAGE(PG8_SB(1, 0), cB + kstep, voffB); PG8_STAGE(PG8_SA(1, 0), cA + kstep, voffA); PG8_STAGE(PG8_SB(1, 1), cB + hstepB + kstep, voffB);
    PG8_WAIT_V(6); PG8_BAR;
    for (;;) {
        const bool has_next = S.next(ui + 1, nxt);
        const char* nA = has_next ? nxt.A : cA; const char* nB = has_next ? nxt.B : cB;
        for (int t = 0; t < nt; t += 2) {
            const bool last = (t == nt - 2);
            const char* a1 = cA + (size_t)(t + 1) * kstep;
            const char* a2 = last ? nA : cA + (size_t)(t + 2) * kstep; const char* b2 = last ? nB : cB + (size_t)(t + 2) * kstep;
            const char* a3 = a2 + kstep; const char* b3 = b2 + kstep;
            PG8_LDB(B0, 0, 0); PG8_LDB(B1, 0, 1); PG8_SCHED; PG8_LDA(At, 0, 0); PG8_STAGE(PG8_SA(1, 1), a1 + hstepA, voffA);
            PG8_WAIT_V(8); PG8_WAIT_L(0); PG8_BAR; PG8_MMA(0, 0, At, B0); PG8_MMA(0, 1, At, B1); PG8_BAR; PG8_SCHED;
            PG8_LDA(At, 0, 1); PG8_STAGE(PG8_SB(0, 0), b2, voffB); PG8_STAGE(PG8_SB(0, 1), b2 + hstepB, voffB); PG8_STAGE(PG8_SA(0, 0), a2, voffA);
            PG8_WAIT_V(8); PG8_WAIT_L(0); PG8_BAR; PG8_MMA(1, 0, At, B0); PG8_MMA(1, 1, At, B1); PG8_BAR; PG8_SCHED;
            PG8_LDB(B0, 1, 0); PG8_LDB(B1, 1, 1); PG8_SCHED; PG8_LDA(At, 1, 0); PG8_STAGE(PG8_SA(0, 1), a2 + hstepA, voffA);
            PG8_WAIT_V(8); PG8_WAIT_L(0); PG8_BAR; PG8_MMA(0, 0, At, B0); PG8_MMA(0, 1, At, B1); PG8_BAR; PG8_SCHED;
            PG8_LDA(At, 1, 1); PG8_STAGE(PG8_SB(1, 0), b3, voffB); PG8_STAGE(PG8_SB(1, 1), b3 + hstepB, voffB); PG8_STAGE(PG8_SA(1, 0), a3, voffA);
            PG8_WAIT_V(8); PG8_WAIT_L(0); PG8_BAR; PG8_MMA(1, 0, At, B0); PG8_MMA(1, 1, At, B1); PG8_BAR; PG8_SCHED;
        }
        if constexpr (ALIGN_EPI) { if (wr == 0) PG8_BAR; }
        if constexpr (!Epi::AFTER_DRAIN) { E(acc, cur, wr, wc, fr, fq); }
        if (!has_next) break;
        if (!S.carry(cur)) {
#pragma unroll
            for (int a = 0; a < 2; ++a)
#pragma unroll
                for (int b = 0; b < 2; ++b)
#pragma unroll
                    for (int m = 0; m < 4; ++m)
#pragma unroll
                        for (int n = 0; n < 2; ++n) acc[a][b][m][n] = (f32x4){0.f, 0.f, 0.f, 0.f};
        }
        cur = nxt; cA = nA; cB = nB; ++ui;
        if constexpr (ALIGN_EPI) { if (wr == 1) PG8_BAR; }
    }
    PG8_WAIT_V(0);
    if constexpr (!ALIGN_EPI) { if (wr == 0) PG8_BAR; }
    PG8_BAR;
    if constexpr (Epi::AFTER_DRAIN) { E.fused(acc, cur, wr, wc, fr, fq, lds, wid, lane); }
#undef PG8_SA
#undef PG8_SB
#undef PG8_STAGE
#undef PG8_LDA
#undef PG8_LDB
#undef PG8_MMA
#undef PG8_WAIT_V
#undef PG8_WAIT_L
#undef PG8_BAR
#undef PG8_SCHED
}
}

typedef f32x4 acc_t[2][2][4][2];

struct EpiProj {
    static constexpr bool AFTER_DRAIN = false;
    const float* rstd; const float* bias; unsigned char* ws;
    __device__ __forceinline__ void operator()(acc_t& acc, const pg8::Unit& u, int wr, int wc, int fr, int fq) const {
        const int pn = u.pn, row0 = u.pm * 256 + wr * 64 + fr;
        f32x4 bv[2][2];
#pragma unroll
        for (int bj = 0; bj < 2; ++bj)
#pragma unroll
            for (int n = 0; n < 2; ++n) bv[bj][n] = *(const f32x4*)(bias + pn * 256 + bj * 128 + wc * 32 + n * 16 + 4 * fq);
        if (pn == 21) {
            if (wc == 0) {
                float* sm = (float*)(ws + WS_SM);
                float rsv[2][4];
#pragma unroll
                for (int ai = 0; ai < 2; ++ai)
#pragma unroll
                    for (int m = 0; m < 4; ++m) rsv[ai][m] = rstd[row0 + ai * 128 + m * 16];
#pragma unroll
                for (int ai = 0; ai < 2; ++ai)
#pragma unroll
                    for (int m = 0; m < 4; ++m) { const int row = row0 + ai * 128 + m * 16; const float rs = rsv[ai][m];
#pragma unroll
                        for (int n = 0; n < 2; ++n) *(f32x4*)(sm + (size_t)row * 32 + n * 16 + 4 * fq) = acc[ai][0][m][n] * rs + bv[0][n]; }
            }
            return;
        }
        bf16_t* cb[2]; int ld, mode = 0;
        if (pn < 8) { bf16_t* b = (bf16_t*)(ws + (pn < 4 ? WS_QK : WS_VO)) + (pn & 3) * 256 + wc * 32; cb[0] = b; cb[1] = b + 128; ld = 1024; mode = (pn >= 6) ? 1 : 0; }
        else if (pn < 10) { bf16_t* b = (bf16_t*)(ws + WS_NQ) + (pn - 8) * 256 + wc * 32; cb[0] = b; cb[1] = b + 128; ld = 512; mode = 2; }
        else if (pn < 13) { bf16_t* b = (bf16_t*)(ws + WS_NKV) + (size_t)((pn - 10) * 4 + (wc >> 1)) * MTOK * 64 + 32 * (wc & 1); cb[0] = b; cb[1] = b + (size_t)2 * MTOK * 64; ld = 64; }
        else { bf16_t* b = (bf16_t*)(ws + WS_GT) + (pn - 13) * 256 + wc * 32; cb[0] = b; cb[1] = b + 128; ld = 2048; mode = 1; }
        float rsv[2][4];
#pragma unroll
        for (int ai = 0; ai < 2; ++ai)
#pragma unroll
            for (int m = 0; m < 4; ++m) rsv[ai][m] = rstd[row0 + ai * 128 + m * 16];
#pragma unroll
        for (int ai = 0; ai < 2; ++ai)
#pragma unroll
            for (int m = 0; m < 4; ++m) { const int row = row0 + ai * 128 + m * 16; const float rs = rsv[ai][m];
#pragma unroll
                for (int bj = 0; bj < 2; ++bj)
#pragma unroll
                    for (int n = 0; n < 2; ++n) { f32x4 v = acc[ai][bj][m][n] * rs + bv[bj][n];
                        if (mode == 1) { v[0] = sigmoidf_(v[0]); v[1] = sigmoidf_(v[1]); v[2] = sigmoidf_(v[2]); v[3] = sigmoidf_(v[3]); }
                        else if (mode == 2) v = v * 0.125f;
                        u32x2 w; w.x = cvtpk(v[0], v[1]); w.y = cvtpk(v[2], v[3]);
                        *(u32x2*)(cb[bj] + (size_t)row * ld + n * 16 + 4 * fq) = w; } }
    }
};

struct EpiBranch {
    static constexpr bool AFTER_DRAIN = false;
    const bf16_t* gt; bf16_t* mixed;
    __device__ __forceinline__ void operator()(acc_t& acc, const pg8::Unit& u, int wr, int wc, int fr, int fq) const {
        const int row0 = u.pm * 256 + wr * 64 + fr, col0 = u.pn * 256 + wc * 32 + 4 * fq;
        const bool s0 = (u.seg == 0);
#pragma unroll
        for (int ai = 0; ai < 2; ++ai)
#pragma unroll
            for (int m = 0; m < 4; ++m) {
                const bf16_t* gp = gt + (size_t)(row0 + ai * 128 + m * 16) * 2048 + col0;
                u32x2 q1[2][2], q0[2][2];
#pragma unroll
                for (int bj = 0; bj < 2; ++bj)
#pragma unroll
                    for (int n = 0; n < 2; ++n) { q1[bj][n] = *(const u32x2*)(gp + 1024 + bj * 128 + n * 16); q0[bj][n] = s0 ? *(const u32x2*)(gp + bj * 128 + n * 16) : (u32x2){0x3f803f80u, 0x3f803f80u}; }
#pragma unroll
                for (int bj = 0; bj < 2; ++bj)
#pragma unroll
                    for (int n = 0; n < 2; ++n) { const u32x2 a0 = q0[bj][n], a1 = q1[bj][n];
                        const f32x4 g0 = {bflo(a0.x), bfhi(a0.x), bflo(a0.y), bfhi(a0.y)}, g1 = {bflo(a1.x), bfhi(a1.x), bflo(a1.y), bfhi(a1.y)};
                        f32x4 a = acc[ai][bj][m][n];
#pragma unroll
                        for (int e = 0; e < 4; ++e) a[e] = s0 ? a[e] * g0[e] * __builtin_amdgcn_rcpf(fmaxf(g1[e], 1e-18f)) : a[e] * g1[e];
                        acc[ai][bj][m][n] = a; }
                asm volatile("" ::: "memory");
            }
        if (!s0) {
#pragma unroll
            for (int ai = 0; ai < 2; ++ai)
#pragma unroll
                for (int m = 0; m < 4; ++m)
#pragma unroll
                    for (int bj = 0; bj < 2; ++bj)
#pragma unroll
                        for (int n = 0; n < 2; ++n) { const f32x4 v = acc[ai][bj][m][n]; u32x2 w; w.x = cvtpk(v[0], v[1]); w.y = cvtpk(v[2], v[3]);
                            *(u32x2*)(mixed + (size_t)(row0 + ai * 128 + m * 16) * 1024 + col0 + bj * 128 + n * 16) = w; }
        }
    }
};

struct EpiResid {
    static constexpr bool AFTER_DRAIN = false;
    const float* base; float* out; bf16_t* outb; float* part;
    __device__ __forceinline__ void operator()(acc_t& acc, const pg8::Unit& u, int wr, int wc, int fr, int fq) const {
        int row0 = u.pm * 256 + wr * 64 + fr; const int col0 = u.pn * 256 + wc * 32 + 4 * fq;
#pragma unroll
        for (int ai = 0; ai < 2; ++ai)
#pragma unroll
            for (int mh = 0; mh < 4; ++mh) {
                if ((mh & 1) == 0) asm volatile("" : "+v"(row0) :: "memory");
                f32x4 r[2][2];
#pragma unroll
                for (int bj = 0; bj < 2; ++bj)
#pragma unroll
                    for (int n = 0; n < 2; ++n) r[bj][n] = *(const f32x4*)(base + (size_t)(row0 + ai * 128 + mh * 16) * 1024 + col0 + bj * 128 + n * 16);
#pragma unroll
                for (int bj = 0; bj < 2; ++bj)
#pragma unroll
                    for (int n = 0; n < 2; ++n) acc[ai][bj][mh][n] += r[bj][n];
                if (mh & 1) asm volatile("" : "+v"(acc[ai][0][mh][0]), "+v"(acc[ai][1][mh][1]) :: "memory");
            }
#pragma unroll
        for (int ai = 0; ai < 2; ++ai)
#pragma unroll
            for (int m = 0; m < 4; ++m) { const int row = row0 + ai * 128 + m * 16; float ss = 0.f;
#pragma unroll
                for (int bj = 0; bj < 2; ++bj)
#pragma unroll
                    for (int n = 0; n < 2; ++n) { const size_t off = (size_t)row * 1024 + col0 + bj * 128 + n * 16;
                        const f32x4 v = acc[ai][bj][m][n];
                        ss += (v[0] * v[0] + v[1] * v[1]) + (v[2] * v[2] + v[3] * v[3]);
                        *(f32x4*)(out + off) = v;
                        if (outb) { u32x2 w; w.x = cvtpk(v[0], v[1]); w.y = cvtpk(v[2], v[3]); *(u32x2*)(outb + off) = w; } }
                ss += __shfl_xor(ss, 16); ss += __shfl_xor(ss, 32);
                if (fq == 0) part[((size_t)u.pn * MTOK + row) * 4 + wc] = ss; }
    }
};

struct EpiGateUp {
    static constexpr bool AFTER_DRAIN = false;
    const float* part; bf16_t* hid;
    __device__ __forceinline__ void operator()(acc_t& acc, const pg8::Unit& u, int wr, int wc, int fr, int fq) const {
        const int row0 = u.pm * 256 + wr * 64 + fr, col0 = u.pn * 128 + wc * 16 + 4 * fq;
        float rsv[2][4];
        { f32x4 pp[2][4];
#pragma unroll
          for (int ai = 0; ai < 2; ++ai)
#pragma unroll
            for (int m = 0; m < 4; ++m) pp[ai][m] = *(const f32x4*)(part + ((size_t)fq * MTOK + row0 + ai * 128 + m * 16) * 4);
#pragma unroll
          for (int ai = 0; ai < 2; ++ai)
#pragma unroll
            for (int m = 0; m < 4; ++m) { float s = (pp[ai][m][0] + pp[ai][m][1]) + (pp[ai][m][2] + pp[ai][m][3]); s += __shfl_xor(s, 16); s += __shfl_xor(s, 32); rsv[ai][m] = rsqrtf(s * (1.0f / 1024.0f) + RMS_EPS); } }
#pragma unroll
        for (int ai = 0; ai < 2; ++ai)
#pragma unroll
            for (int m = 0; m < 4; ++m) { const int row = row0 + ai * 128 + m * 16;
                const float rs = rsv[ai][m];
#pragma unroll
                for (int bj = 0; bj < 2; ++bj) { const f32x4 g = acc[ai][bj][m][0] * rs, up = acc[ai][bj][m][1] * rs; f32x4 y;
#pragma unroll
                    for (int e = 0; e < 4; ++e) y[e] = g[e] * sigmoidf_(g[e]) * up[e];
                    u32x2 w; w.x = cvtpk(y[0], y[1]); w.y = cvtpk(y[2], y[3]);
                    *(u32x2*)(hid + (size_t)row * D_FF + col0 + bj * 64) = w; } }
    }
};

struct Args {
    const float* x; const float* g_norm_mix; const float* w_in; const float* b_in; const float* b_fgate; const float* conv_qk; const float* g_mlstm_head; const float* pe_cmp;
    const float* w_cmp1; const float* w_cmp2; const float* rel_bias; const float* w_branch; const float* w_out; const float* g_norm_ffn; const float* w_gate; const float* w_up;
    const float* w_down; const float* g_final;
    float* out; unsigned char* ws; int ph_lo, ph_hi, coop, pad;
};
constexpr int NWAVES = 8, NTHREADS = 512;
constexpr int RING_BYTES = 131072, LDS_BYTES = 147456;

__device__ __forceinline__ int rel_bucket_dev(int n) {
    if (n < 16) return n < 0 ? 0 : n;
    int b = 16;
    b += (n >= 21); b += (n >= 27); b += (n >= 35); b += (n >= 46); b += (n >= 59); b += (n >= 77); b += (n >= 99); b += (n >= 128);
    b += (n >= 166); b += (n >= 216); b += (n >= 280); b += (n >= 363); b += (n >= 470); b += (n >= 609); b += (n >= 790);
    return b;
}

struct ColSrc { const float* p; int ld; };
template <class F>
__device__ __forceinline__ void tr_item(const F& f, const float* kscale, bf16_t* WT, int K, int nblk, int item, LAS float* scr, int lane, const float* kfallback) {
    const int kb = item / nblk, nb = item % nblk, k0 = 64 * kb, n0 = 32 * nb;
    const ColSrc cs = f(n0 + (lane & 31));
    float tv[32];
    const float* lp = cs.p ? cs.p : kfallback; const float lmask = cs.p ? 1.0f : 0.0f;
#pragma unroll
    for (int i = 0; i < 32; ++i) { const int kk = 2 * i + (lane >> 5); tv[i] = lp[(size_t)(k0 + kk) * cs.ld]; }
#pragma unroll
    for (int i = 0; i < 32; ++i) tv[i] *= lmask;
    if (kscale) {
#pragma unroll
        for (int i = 0; i < 32; ++i) tv[i] *= kscale[k0 + 2 * i + (lane >> 5)]; }
#pragma unroll
    for (int i = 0; i < 32; ++i) scr[(2 * i + (lane >> 5)) * 33 + (lane & 31)] = tv[i];
    asm volatile("s_waitcnt lgkmcnt(0)" ::: "memory");
    const int c = lane & 7;
#pragma unroll
    for (int j = 0; j < 4; ++j) { const int n = (lane >> 3) + 8 * j; const LAS float* s = scr + (8 * c) * 33 + n;
        u32x4 o; o.x = cvtpk(s[0 * 33], s[1 * 33]); o.y = cvtpk(s[2 * 33], s[3 * 33]); o.z = cvtpk(s[4 * 33], s[5 * 33]); o.w = cvtpk(s[6 * 33], s[7 * 33]);
        *(u32x4*)(WT + (size_t)(n0 + n) * K + k0 + 8 * c) = o; }
    asm volatile("s_waitcnt lgkmcnt(0)" ::: "memory");
}
__device__ __forceinline__ int proj_src_col(int n) {
    if (n < 2048) return n;
    if (n < 2560) return 2056 + (n - 2048);
    if (n < 3328) return 2568 + (n - 2560);
    if (n < 5376) return 3360 + (n - 3328);
    const int x = n - 5376;
    if (x < 8) return 2048 + x;
    if (x < 32) return 3336 + (x - 8);
    return -1;
}
struct SrcW1 { const float* w; __device__ ColSrc operator()(int n) const { const int c = proj_src_col(n); return ColSrc{c >= 0 ? w + c : nullptr, D_IN}; } };
struct SrcGU { const float* wg; const float* wu; __device__ ColSrc operator()(int n) const { const int G = n >> 4; const uintptr_t pg = (uintptr_t)wg, pu = (uintptr_t)wu; const uintptr_t sel = pg ^ ((pg ^ pu) & (uintptr_t)(0 - (long long)(G & 1)));
    return ColSrc{(const float*)sel + 16 * (G >> 1) + (n & 15), D_FF}; } };
struct SrcPlain { const float* w; int ld; __device__ ColSrc operator()(int n) const { return ColSrc{w + n, ld}; } };
struct SrcBr { const float* w; __device__ ColSrc operator()(int n) const { return ColSrc{w + (size_t)(n >> 10) * 512 * 1024 + (n & 1023), 1024}; } };
struct SrcC1 { const float* w; __device__ ColSrc operator()(int n) const { const int j = n >> 8, q = n & 255; return ColSrc{w + (size_t)j * 2048 * 128 + (q >= 128 ? 1024 * 128 : 0) + (q & 127), 128}; } };
struct SrcC2 { const float* w; __device__ ColSrc operator()(int n) const { return ColSrc{w + (size_t)(n >> 6) * 128 * 64 + (n & 63), 64}; } };

__device__ __forceinline__ void p0_prologue(const Args& a, LAS unsigned char* lds, int vcu, int G, int wave, int lane) {
    unsigned char* ws = a.ws;
    LAS float* scr = (LAS float*)(lds + wave * 16384);
    const int gw = vcu * NWAVES + wave, NGW = G * NWAVES;
    constexpr int I_W1 = (1024 / 64) * (N1 / 32), I_GU = (1024 / 64) * (NGU / 32), I_DN = (D_FF / 64) * (1024 / 32), I_OUT = 16 * 32, I_BR = (512 / 64) * (2048 / 32), I_C1 = 16 * (512 / 32), I_C2 = 2 * (128 / 32);
    constexpr int I_PEB = 256, I_BIAS = N1 / 64, I_BT = 8 * (BIAS_LEN / 64);
    constexpr int NITEMS = I_W1 + I_GU + I_DN + I_OUT + I_BR + I_C1 + I_C2 + I_PEB + I_BIAS + I_BT;
    if (blockIdx.x == 0 && threadIdx.x < 64) ((unsigned*)(ws + WS_CTL))[threadIdx.x] = 0u;
    for (int it = gw; it < NITEMS; it += NGW) {
        int r = it;
        if (r < I_W1) { tr_item(SrcW1{a.w_in}, a.g_norm_mix, (bf16_t*)(ws + WS_W1T), 1024, N1 / 32, r, scr, lane, a.w_in); continue; } r -= I_W1;
        if (r < I_GU) { tr_item(SrcGU{a.w_gate, a.w_up}, a.g_norm_ffn, (bf16_t*)(ws + WS_WGUT), 1024, NGU / 32, r, scr, lane, a.w_gate); continue; } r -= I_GU;
        if (r < I_DN) { tr_item(SrcPlain{a.w_down, 1024}, nullptr, (bf16_t*)(ws + WS_WDNT), D_FF, 1024 / 32, r, scr, lane, a.w_down); continue; } r -= I_DN;
        if (r < I_OUT) { tr_item(SrcPlain{a.w_out, 1024}, nullptr, (bf16_t*)(ws + WS_WOUTT), 1024, 1024 / 32, r, scr, lane, a.w_out); continue; } r -= I_OUT;
        if (r < I_BR) { tr_item(SrcBr{a.w_branch}, nullptr, (bf16_t*)(ws + WS_WBRT), 512, 2048 / 32, r, scr, lane, a.w_branch); continue; } r -= I_BR;
        if (r < I_C1) { tr_item(SrcC1{a.w_cmp1}, nullptr, (bf16_t*)(ws + WS_WC1T), 1024, 512 / 32, r, scr, lane, a.w_cmp1); continue; } r -= I_C1;
        if (r < I_C2) { tr_item(SrcC2{a.w_cmp2}, nullptr, (bf16_t*)(ws + WS_WC2T), 128, 128 / 32, r, scr, lane, a.w_cmp2); continue; } r -= I_C2;
        if (r < I_PEB) {
            const int j = r >> 7, n = r & 127; const float* pe = a.pe_cmp + j * 2048; const float* w = a.w_cmp1 + (size_t)j * 2048 * 128 + n; float s = 0.f;
#pragma unroll 8
            for (int i = 0; i < 32; ++i) { const int k = i * 64 + lane; s += pe[k] * w[(size_t)k * 128]; }
            s = wave_sum(s); if (lane == 0) __hip_atomic_store((float*)(ws + WS_PEB) + r, s, __ATOMIC_RELAXED, __HIP_MEMORY_SCOPE_AGENT); continue; } r -= I_PEB;
        if (r < I_BIAS) { const int n = r * 64 + lane; const int c = proj_src_col(n); ((float*)(ws + WS_BIAS1))[n] = c >= 0 ? a.b_in[c] : 0.f; continue; } r -= I_BIAS;
        { const int h = r / (BIAS_LEN / 64), idx = (r % (BIAS_LEN / 64)) * 64 + lane;
          ((float*)(ws + WS_BTAB))[h * BIAS_LEN + idx] = a.rel_bias[rel_bucket_dev(idx - BIAS_PAD) * N_HEADS + h] * 1.4426950408889634f; }
    }
    bf16_t* xb = (bf16_t*)(ws + WS_XB); float* rsx = (float*)(ws + WS_RSX);
    for (int blk = gw; blk < MTOK / 16; blk += NGW) {
        float myrs = 0.f;
#pragma unroll 1
        for (int k4 = 0; k4 < 16; k4 += 4) {
            f32x4 v[4][4]; float s[4];
#pragma unroll
            for (int r = 0; r < 4; ++r) { const f32x4* xr = (const f32x4*)(a.x + (size_t)(blk * 16 + k4 + r) * 1024) + lane;
#pragma unroll
                for (int j = 0; j < 4; ++j) v[r][j] = xr[64 * j]; }
#pragma unroll
            for (int r = 0; r < 4; ++r) { float t = 0.f;
#pragma unroll
                for (int j = 0; j < 4; ++j) t += (v[r][j][0] * v[r][j][0] + v[r][j][1] * v[r][j][1]) + (v[r][j][2] * v[r][j][2] + v[r][j][3] * v[r][j][3]);
                s[r] = wave_sum(t);
                u32x2* o = (u32x2*)(xb + (size_t)(blk * 16 + k4 + r) * 1024) + lane;
#pragma unroll
                for (int j = 0; j < 4; ++j) { u32x2 w; w.x = cvtpk(v[r][j][0], v[r][j][1]); w.y = cvtpk(v[r][j][2], v[r][j][3]); o[64 * j] = w; }
                if (lane == k4 + r) myrs = rsqrtf(s[r] * (1.0f / 1024.0f) + RMS_EPS); }
        }
        if (lane < 16) rsx[blk * 16 + lane] = myrs;
    }
}

__device__ __forceinline__ void p8_final(const Args& a, int vcu, int G, int wave, int lane) {
    const float* part = (const float*)(a.ws + WS_PART2);
    const int gw = vcu * NWAVES + wave, NGW = G * NWAVES;
    f32x4 gv[4];
#pragma unroll
    for (int j = 0; j < 4; ++j) gv[j] = ((const f32x4*)a.g_final)[lane + 64 * j];
    for (int m = gw; m < MTOK; m += NGW) {
        float p = (lane < 16) ? part[((size_t)(lane >> 2) * MTOK + m) * 4 + (lane & 3)] : 0.f;
        p += __shfl_xor(p, 1); p += __shfl_xor(p, 2); p += __shfl_xor(p, 4); p += __shfl_xor(p, 8);
        const float rs = rsqrtf(__shfl(p, 0) * (1.0f / 1024.0f) + RMS_EPS);
        f32x4* xr = (f32x4*)(a.out + (size_t)m * 1024) + lane;
#pragma unroll
        for (int j = 0; j < 4; ++j) xr[64 * j] = xr[64 * j] * rs * gv[j];
    }
}

__device__ __forceinline__ int kpos16(int key) { return (key & ~12) | ((key & 4) << 1) | ((key & 8) >> 1); }
__device__ __forceinline__ float siluf_(float x) { return x * sigmoidf_(x); }

__device__ __forceinline__ void p2_conv_item(const Args& a, int item, int tid) {
    const bf16_t* qk = (const bf16_t*)(a.ws + WS_QK); bf16_t* qc = (bf16_t*)(a.ws + WS_XB);
    const int cg8 = tid & 127, tg = tid >> 7, ch = cg8 * 8, row0 = item * 32 + tg * 8, tl0 = row0 & (SEQ - 1);
    float w[4][8];
#pragma unroll
    for (int j = 0; j < 4; ++j) { const f32x4 w0 = *(const f32x4*)(a.conv_qk + j * 1024 + ch), w1 = *(const f32x4*)(a.conv_qk + j * 1024 + ch + 4);
        w[j][0] = w0[0]; w[j][1] = w0[1]; w[j][2] = w0[2]; w[j][3] = w0[3]; w[j][4] = w1[0]; w[j][5] = w1[1]; w[j][6] = w1[2]; w[j][7] = w1[3]; }
    const float osc = (ch >= 512) ? 0.08838834764831845f : 1.0f;
    float xw[3][8];
#pragma unroll
    for (int k = 0; k < 3; ++k) { const int tl = tl0 - 3 + k; u32x4 v = (u32x4){0u, 0u, 0u, 0u}; if (tl >= 0) v = *(const u32x4*)(qk + (size_t)(row0 - 3 + k) * 1024 + ch);
        xw[k][0] = bflo(v.x); xw[k][1] = bfhi(v.x); xw[k][2] = bflo(v.y); xw[k][3] = bfhi(v.y); xw[k][4] = bflo(v.z); xw[k][5] = bfhi(v.z); xw[k][6] = bflo(v.w); xw[k][7] = bfhi(v.w); }
#pragma unroll
    for (int t = 0; t < 8; ++t) {
        const u32x4 v = *(const u32x4*)(qk + (size_t)(row0 + t) * 1024 + ch);
        float x[8] = {bflo(v.x), bfhi(v.x), bflo(v.y), bfhi(v.y), bflo(v.z), bfhi(v.z), bflo(v.w), bfhi(v.w)}; float y[8];
#pragma unroll
        for (int e = 0; e < 8; ++e) { const float s = w[0][e] * xw[0][e] + w[1][e] * xw[1][e] + w[2][e] * xw[2][e] + w[3][e] * x[e]; y[e] = siluf_(s) * osc; xw[0][e] = xw[1][e]; xw[1][e] = xw[2][e]; xw[2][e] = x[e]; }
        u32x4 o; o.x = cvtpk(y[0], y[1]); o.y = cvtpk(y[2], y[3]); o.z = cvtpk(y[4], y[5]); o.w = cvtpk(y[6], y[7]);
        *(u32x4*)(qc + (size_t)(row0 + t) * 1024 + ch) = o;
    }
}
__device__ __forceinline__ void p2_vt_item(const Args& a, int it, LAS unsigned char* scr, int lane) {
    const int which = it >> 10, rem = it & 1023, bg = rem >> 5, blk = rem & 31, b = bg >> 1, g = bg & 1;
    const bf16_t* src = (const bf16_t*)(a.ws + WS_NKV) + ((size_t)((which ? 10 : 6) + g) * MTOK + (size_t)b * SEQ + blk * 64) * 64;
    bf16_t* dst = (bf16_t*)(a.ws + (which ? WS_VWT : WS_VST)) + (size_t)(bg * 32 + blk) * 4096;
    LAS unsigned short* s = (LAS unsigned short*)scr;
#pragma unroll
    for (int i = 0; i < 8; ++i) { const int key = i * 8 + (lane >> 3), c = lane & 7; const u32x4 v = *(const u32x4*)(src + key * 64 + c * 8); const int p = (key & ~15) | kpos16(key & 15);
        s[(c * 8 + 0) * 72 + p] = (unsigned short)(v.x & 0xffff); s[(c * 8 + 1) * 72 + p] = (unsigned short)(v.x >> 16); s[(c * 8 + 2) * 72 + p] = (unsigned short)(v.y & 0xffff); s[(c * 8 + 3) * 72 + p] = (unsigned short)(v.y >> 16);
        s[(c * 8 + 4) * 72 + p] = (unsigned short)(v.z & 0xffff); s[(c * 8 + 5) * 72 + p] = (unsigned short)(v.z >> 16); s[(c * 8 + 6) * 72 + p] = (unsigned short)(v.w & 0xffff); s[(c * 8 + 7) * 72 + p] = (unsigned short)(v.w >> 16); }
    asm volatile("s_waitcnt lgkmcnt(0)" ::: "memory");
#pragma unroll
    for (int i = 0; i < 8; ++i) { const int d = i * 8 + (lane >> 3), c = lane & 7; *(u32x4*)(dst + d * 64 + c * 8) = *(const LAS u32x4*)(scr + d * 144 + c * 16); }
    asm volatile("s_waitcnt lgkmcnt(0)" ::: "memory");
}
struct CmpOrder {
    int c; const char* A; const char* B;
    __device__ __forceinline__ bool next(int i, pg8::Unit& u) const { if (i != 0 || c >= 32) return false; u.pm = c & 7; u.pn = c >> 3; u.seg = 0; u.A = A + (size_t)(c >> 3) * MTOK * 64 * 2 + (size_t)(c & 7) * 256 * 1024 * 2; u.B = B + (size_t)(c >> 4) * 256 * 1024 * 2; return true; }
    __device__ __forceinline__ bool carry(const pg8::Unit&) const { return false; }
};
struct EpiCmp {
    static constexpr bool AFTER_DRAIN = true;
    const float* peb; const bf16_t* wc2t; bf16_t* kc; bf16_t* vct;
    __device__ __forceinline__ void operator()(acc_t&, const pg8::Unit&, int, int, int, int) const {}
    __device__ __forceinline__ void fused(acc_t& acc, const pg8::Unit& u, int wr, int wc, int fr, int fq, LAS unsigned char* lds, int wid, int lane) const {
        const int p = u.pn, jj = p >> 1, g = p & 1;
        LAS float* hb = (LAS float*)lds;
#pragma unroll
        for (int ai = 0; ai < 2; ++ai)
#pragma unroll
            for (int m = 0; m < 4; ++m) { const int r = ai * 128 + wr * 64 + m * 16 + fr;
#pragma unroll
                for (int n = 0; n < 2; ++n) { const int cu = (32 * wc + 16 * n + 4 * fq) >> 2; *(LAS f32x4*)(hb + r * 128 + ((cu ^ (r & 15)) << 2)) = acc[ai][1][m][n]; } }
        asm volatile("s_waitcnt lgkmcnt(0)" ::: "memory"); __builtin_amdgcn_s_barrier(); asm volatile("" ::: "memory");
#pragma unroll
        for (int ai = 0; ai < 2; ++ai)
#pragma unroll
            for (int m = 0; m < 4; ++m) { const int r = ai * 128 + wr * 64 + m * 16 + fr, r1 = (r + 1) & 255;
#pragma unroll
                for (int n = 0; n < 2; ++n) { const int col = 32 * wc + 16 * n + 4 * fq, cu = col >> 2;
                    const f32x4 bt = *(const LAS f32x4*)(hb + r1 * 128 + ((cu ^ (r1 & 15)) << 2)); const f32x4 pb = *(const f32x4*)(peb + jj * 128 + col);
                    f32x4 v = acc[ai][0][m][n] + bt + pb; v[0] = siluf_(v[0]); v[1] = siluf_(v[1]); v[2] = siluf_(v[2]); v[3] = siluf_(v[3]); acc[ai][0][m][n] = v; } }
        asm volatile("s_waitcnt lgkmcnt(0)" ::: "memory"); __builtin_amdgcn_s_barrier(); asm volatile("" ::: "memory");
#pragma unroll
        for (int ai = 0; ai < 2; ++ai)
#pragma unroll
            for (int m = 0; m < 4; ++m) { const int r = ai * 128 + wr * 64 + m * 16 + fr;
#pragma unroll
                for (int n = 0; n < 2; ++n) { const int col = 32 * wc + 16 * n + 4 * fq; const f32x4 v = acc[ai][0][m][n]; u32x2 w; w.x = cvtpk(v[0], v[1]); w.y = cvtpk(v[2], v[3]); *(LAS u32x2*)(lds + r * 272 + col * 2) = w; } }
        asm volatile("s_waitcnt lgkmcnt(0)" ::: "memory"); __builtin_amdgcn_s_barrier(); asm volatile("" ::: "memory");
        const bf16_t* w2 = wc2t + jj * 64 * 128;
        bf16x8 wf[4][4];
#pragma unroll
        for (int dt = 0; dt < 4; ++dt)
#pragma unroll
            for (int s = 0; s < 4; ++s) wf[dt][s] = *(const bf16x8*)(w2 + (dt * 16 + fr) * 128 + 32 * s + 8 * fq);
#pragma unroll
        for (int rt = 0; rt < 2; ++rt) {
            const int r = wid * 32 + rt * 16 + fr; bf16x8 hf[4];
#pragma unroll
            for (int s = 0; s < 4; ++s) hf[s] = *(const LAS bf16x8*)(lds + r * 272 + (32 * s + 8 * fq) * 2);
            const int crow = u.pm * 256 + r, b = crow >> 7, c = crow & 127; const bool zero = (c == 127);
#pragma unroll
            for (int dt = 0; dt < 4; ++dt) { f32x4 o = {0.f, 0.f, 0.f, 0.f};
#pragma unroll
                for (int s = 0; s < 4; ++s) o = __builtin_amdgcn_mfma_f32_16x16x32_bf16(wf[dt][s], hf[s], o, 0, 0, 0);
                if (zero) o = (f32x4){0.f, 0.f, 0.f, 0.f};
                const int dd = dt * 16 + 4 * fq;
                if (jj == 0) { u32x2 w; w.x = cvtpk(o[0], o[1]); w.y = cvtpk(o[2], o[3]); *(u32x2*)(kc + ((size_t)(b * 2 + g) * 128 + c) * 64 + dd) = w; }
                else { bf16_t* vb = vct + ((size_t)(b * 2 + g) * 2 + (c >> 6)) * 4096 + ((c & 48) | kpos16(c & 15));
#pragma unroll
                    for (int e = 0; e < 4; ++e) vb[(dd + e) * 64] = (bf16_t)(cvtpk(o[e], 0.f) & 0xffff); } }
        }
    }
};
__device__ __forceinline__ void p2_prep(const Args& a, LAS unsigned char* lds, int bx, int G, int wave, int lane) {
    unsigned char* ws = a.ws;
    {
        CmpOrder S{bx, (const char*)(ws + WS_NKV), (const char*)(ws + WS_WC1T)};
        EpiCmp E{(const float*)(ws + WS_PEB), (const bf16_t*)(ws + WS_WC2T), (bf16_t*)(ws + WS_KC), (bf16_t*)(ws + WS_VCT)};
        pg8::gemm_phase<EpiCmp, CmpOrder, false>(lds, pg8::Dims{1024, 1024, 16}, S, E);
        __syncthreads();
    }
    for (int it = bx; it < MTOK / 32; it += G) p2_conv_item(a, it, threadIdx.x);
    for (int it = bx * NWAVES + wave; it < 2048; it += G * NWAVES) p2_vt_item(a, it, lds + wave * 16384, lane);
}

__device__ __forceinline__ int jpos32(int jj) { return ((jj & 12) << 1) | ((jj & 16) >> 2) | (jj & 3); }
__device__ __forceinline__ float logsigf_(float x) { return fminf(x, 0.f) - log1pf(__expf(-fabsf(x))); }
constexpr int ML_KS = 0, ML_VTS = 34816, ML_CS = 69632, ML_GV = 108800, ML_PM = ML_GV + 8192, ML_BC = ML_PM + 8192, ML_GH = ML_BC + 8192, ML_SCB = ML_GH + 512, ML_END = ML_SCB + 128;
static_assert(ML_END <= 140 * 1024, "mLSTM LDS map");
__device__ __forceinline__ void mlstm_item(const Args& a, LAS unsigned char* lds, int b, int h, int tid, int wave, int lane) {
    const bf16_t* qc = (const bf16_t*)(a.ws + WS_XB); const bf16_t* vo = (const bf16_t*)(a.ws + WS_VO); const float* sm = (const float*)(a.ws + WS_SM); bf16_t* ys = (bf16_t*)(a.ws + WS_QK);
    asm volatile("" : "+v"(tid), "+v"(lane));
    const int w = wave, fr = lane & 15, g = lane >> 4;
    LAS float* GV = (LAS float*)(lds + ML_GV); LAS float* PM = (LAS float*)(lds + ML_PM); LAS float* BC = (LAS float*)(lds + ML_BC); LAS float* GH = (LAS float*)(lds + ML_GH); LAS float* SCB = (LAS float*)(lds + ML_SCB);
    {
        const float bfg = a.b_fgate[h];
#pragma unroll 1
        for (int cc = 0; cc < 2; ++cc) {
            const int c = 2 * w + cc, r0 = b * SEQ + c * M_CHUNK, j0 = 2 * lane, j1 = j0 + 1;
            const float ip0 = sm[(size_t)(r0 + j0) * 32 + h], ip1 = sm[(size_t)(r0 + j1) * 32 + h];
            const float lf0 = logsigf_(sm[(size_t)(r0 + j0) * 32 + 4 + h] + bfg), lf1 = logsigf_(sm[(size_t)(r0 + j1) * 32 + 4 + h] + bfg);
            float s = lf0 + lf1;
#pragma unroll
            for (int o = 1; o < 64; o <<= 1) { const float t = __shfl_up(s, o); if (lane >= o) s += t; }
            const float bc1 = s, bc0 = s - lf1, gv0 = ip0 - bc0, gv1 = ip1 - bc1;
            float pm = fmaxf(gv0, gv1);
#pragma unroll
            for (int o = 1; o < 64; o <<= 1) { const float t = __shfl_up(pm, o); if (lane >= o) pm = fmaxf(pm, t); }
            float ex = __shfl_up(pm, 1); if (lane == 0) ex = -INFINITY;
            GV[c * 128 + j0] = gv0; GV[c * 128 + j1] = gv1; PM[c * 128 + j0] = fmaxf(ex, gv0); PM[c * 128 + j1] = pm; BC[c * 128 + j0] = bc0; BC[c * 128 + j1] = bc1;
            if (lane == 63) { SCB[2 * c] = bc1; SCB[2 * c + 1] = pm; }
        }
        if (tid < 128) GH[tid] = a.g_mlstm_head[h * 128 + tid];
    }
    float m_prev = 0.f;
    f32x4 ct[9];
#pragma unroll
    for (int vt = 0; vt < 9; ++vt) ct[vt] = (f32x4){0.f, 0.f, 0.f, 0.f};
    bf16x8 ones; { const short o = (fr == 0) ? (short)0x3F80 : (short)0; ones = (bf16x8){o, o, o, o, o, o, o, o}; }
    u32x4 kreg[4], vreg[4]; bf16x8 qf[4];
    const int pj = tid >> 4, pch = tid & 15;
#define ML_PREFETCH(c_) do { const int r0_ = b * SEQ + (c_) * M_CHUNK; \
        _Pragma("unroll") for (int i = 0; i < 4; ++i) { kreg[i] = *(const u32x4*)(qc + (size_t)(r0_ + pj + 32 * i) * 1024 + 512 + h * 128 + pch * 8); vreg[i] = *(const u32x4*)(vo + (size_t)(r0_ + pj + 32 * i) * 1024 + h * 128 + pch * 8); } } while (0)
#define ML_PREFETCH_Q(c_) do { const int r0_ = b * SEQ + (c_) * M_CHUNK; \
        _Pragma("unroll") for (int s = 0; s < 4; ++s) qf[s] = *(const bf16x8*)(qc + (size_t)(r0_ + 16 * w + fr) * 1024 + h * 128 + 32 * s + 8 * g); } while (0)
    ML_PREFETCH(0); ML_PREFETCH_Q(0);
    for (int c = 0; c < NCHUNK; ++c) {
        const int r0 = b * SEQ + c * M_CHUNK, irow = r0 + 16 * w + fr;
#pragma unroll
        for (int i = 0; i < 4; ++i) { const int j = pj + 32 * i;
            *(LAS u32x4*)(lds + ML_KS + j * 272 + pch * 16) = kreg[i];
            const u32x4 v = vreg[i]; const int p = (j & ~31) | jpos32(j & 31);
            LAS unsigned short* d = (LAS unsigned short*)(lds + ML_VTS + (pch * 8) * 272 + p * 2);
            d[0 * 136] = (unsigned short)(v.x & 0xffff); d[1 * 136] = (unsigned short)(v.x >> 16); d[2 * 136] = (unsigned short)(v.y & 0xffff); d[3 * 136] = (unsigned short)(v.y >> 16);
            d[4 * 136] = (unsigned short)(v.z & 0xffff); d[5 * 136] = (unsigned short)(v.z >> 16); d[6 * 136] = (unsigned short)(v.w & 0xffff); d[7 * 136] = (unsigned short)(v.w >> 16); }
#pragma unroll
        for (int vt = 0; vt < 9; ++vt)
#pragma unroll
            for (int r = 0; r < 4; ++r) *(LAS unsigned short*)(lds + ML_CS + (16 * vt + 4 * g + r) * 272 + (16 * w + fr) * 2) = (unsigned short)(cvtpk(ct[vt][r], 0.f) & 0xffff);
        __syncthreads();
        if (c + 1 < NCHUNK) ML_PREFETCH(c + 1);
        const float Ml = fmaxf(SCB[2 * c + 1], m_prev), m_new = SCB[2 * c] + Ml, decay = __expf(m_prev - Ml);
        const float Mi = fmaxf(PM[c * 128 + 16 * w + fr], m_prev), bci = BC[c * 128 + 16 * w + fr];
        const float sint = __expf(m_prev - Mi);
        unsigned pk[8][2];
#pragma unroll
        for (int jt = 0; jt < 8; ++jt) {
            pk[jt][0] = 0u; pk[jt][1] = 0u;
            if (jt <= w) {
                f32x4 st = {0.f, 0.f, 0.f, 0.f};
#pragma unroll
                for (int s = 0; s < 4; ++s) st = __builtin_amdgcn_mfma_f32_16x16x32_bf16(*(const LAS bf16x8*)(lds + ML_KS + (16 * jt + fr) * 272 + (32 * s + 8 * g) * 2), qf[s], st, 0, 0, 0);
                const f32x4 gvv = *(const LAS f32x4*)(lds + ML_GV + (c * 128 + 16 * jt + 4 * g) * 4); float p[4];
#pragma unroll
                for (int r = 0; r < 4; ++r) { const bool ok = (jt < w) || (4 * g + r <= fr); p[r] = ok ? st[r] * __expf(gvv[r] - Mi) : 0.f; }
                pk[jt][0] = cvtpk(p[0], p[1]); pk[jt][1] = cvtpk(p[2], p[3]);
            }
        }
        u32x2 so[8];
#pragma unroll
        for (int vt = 0; vt < 8; ++vt) so[vt] = *(const u32x2*)(vo + (size_t)irow * 1024 + 512 + h * 128 + 16 * vt + 4 * g);
        f32x4 hacc[9];
#pragma unroll
        for (int vt = 0; vt < 9; ++vt) {
            f32x4 hh = {0.f, 0.f, 0.f, 0.f};
#pragma unroll
            for (int s = 0; s < 4; ++s) hh = __builtin_amdgcn_mfma_f32_16x16x32_bf16(*(const LAS bf16x8*)(lds + ML_CS + (16 * vt + fr) * 272 + (32 * s + 8 * g) * 2), qf[s], hh, 0, 0, 0);
            hh = hh * sint;
#pragma unroll
            for (int s = 0; s < 4; ++s) if (2 * s <= w) {
                const bf16x8 av = (vt < 8) ? *(const LAS bf16x8*)(lds + ML_VTS + (16 * vt + fr) * 272 + (32 * s + 8 * g) * 2) : ones;
                const u32x4 pb = {pk[2 * s][0], pk[2 * s][1], pk[2 * s + 1][0], pk[2 * s + 1][1]};
                hh = __builtin_amdgcn_mfma_f32_16x16x32_bf16(av, __builtin_bit_cast(bf16x8, pb), hh, 0, 0, 0); }
            hacc[vt] = hh;
            if (vt & 1) asm volatile("" ::: "memory");
        }
        if (c + 1 < NCHUNK) ML_PREFETCH_Q(c + 1);
        {
            const float den = __shfl(hacc[8][0], fr);
            const float inv = 1.0f / fmaxf(fabsf(den), __expf(-(bci + Mi)));
            float ss = 0.f;
#pragma unroll
            for (int vt = 0; vt < 8; ++vt) { hacc[vt] = hacc[vt] * inv; ss += (hacc[vt][0] * hacc[vt][0] + hacc[vt][1] * hacc[vt][1]) + (hacc[vt][2] * hacc[vt][2] + hacc[vt][3] * hacc[vt][3]); }
            ss += __shfl_xor(ss, 16); ss += __shfl_xor(ss, 32);
            const float rs = rsqrtf(ss * (1.0f / 128.0f) + RMS_EPS);
#pragma unroll
            for (int vt = 0; vt < 8; ++vt) { const int v0 = 16 * vt + 4 * g;
                const f32x4 gh = *(const LAS f32x4*)(lds + ML_GH + v0 * 4);
                const f32x4 y = {hacc[vt][0] * rs * gh[0] * bflo(so[vt].x), hacc[vt][1] * rs * gh[1] * bfhi(so[vt].x), hacc[vt][2] * rs * gh[2] * bflo(so[vt].y), hacc[vt][3] * rs * gh[3] * bfhi(so[vt].y)};
                u32x2 o; o.x = cvtpk(y[0], y[1]); o.y = cvtpk(y[2], y[3]); *(u32x2*)(ys + (size_t)irow * 1024 + h * 128 + v0) = o; }
        }
        {
            bf16x8 kb[4];
#pragma unroll
            for (int s = 0; s < 4; ++s) {
                const f32x4 g0 = *(const LAS f32x4*)(lds + ML_GV + (c * 128 + 32 * s + 4 * g) * 4), g1 = *(const LAS f32x4*)(lds + ML_GV + (c * 128 + 32 * s + 16 + 4 * g) * 4); float kv[8];
#pragma unroll
                for (int e = 0; e < 4; ++e) { kv[e] = bf2f(*(const LAS unsigned short*)(lds + ML_KS + (32 * s + 4 * g + e) * 272 + (16 * w + fr) * 2)) * __expf(g0[e] - Ml);
                    kv[4 + e] = bf2f(*(const LAS unsigned short*)(lds + ML_KS + (32 * s + 16 + 4 * g + e) * 272 + (16 * w + fr) * 2)) * __expf(g1[e] - Ml); }
                const u32x4 kk = {cvtpk(kv[0], kv[1]), cvtpk(kv[2], kv[3]), cvtpk(kv[4], kv[5]), cvtpk(kv[6], kv[7])}; kb[s] = __builtin_bit_cast(bf16x8, kk);
            }
#pragma unroll
            for (int vt = 0; vt < 9; ++vt) { f32x4 cc = ct[vt] * decay;
#pragma unroll
                for (int s = 0; s < 4; ++s) { const bf16x8 av = (vt < 8) ? *(const LAS bf16x8*)(lds + ML_VTS + (16 * vt + fr) * 272 + (32 * s + 8 * g) * 2) : ones;
                    cc = __builtin_amdgcn_mfma_f32_16x16x32_bf16(av, kb[s], cc, 0, 0, 0); }
                ct[vt] = cc;
                if (vt & 1) asm volatile("" ::: "memory"); }
            m_prev = m_new;
        }
        __syncthreads();
    }
#undef ML_PREFETCH
#undef ML_PREFETCH_Q
}

constexpr int NS_KB = 0, NS_VB = 18432, NS_BT = 36864, NS_IMP = NS_BT + 4 * BIAS_LEN * 4, NS_SEL = NS_IMP + 4 * 64 * 33 * 4, NS_END = NS_SEL + 256;
static_assert(NS_END <= 140 * 1024, "NSA LDS map");
constexpr float LOG2E = 1.4426950408889634f;
__device__ __forceinline__ int crow32(int r, int hi) { return (r & 3) + 8 * (r >> 2) + 4 * hi; }

struct NsaState { float m, l; f32x16 o[2]; };
__device__ __forceinline__ void ns_reset(NsaState& s) { s.m = -1e30f; s.l = 0.f;
#pragma unroll
    for (int r = 0; r < 16; ++r) { s.o[0][r] = 0.f; s.o[1][r] = 0.f; } }

__device__ __forceinline__ void ns_qk(f32x16& s0, f32x16& s1, const LAS unsigned char* kb, const bf16x8* qf, int q, int hi) {
#pragma unroll
    for (int r = 0; r < 16; ++r) { s0[r] = 0.f; s1[r] = 0.f; }
#pragma unroll
    for (int ks = 0; ks < 4; ++ks) {
        const bf16x8 a0 = *(const LAS bf16x8*)(kb + q * 144 + ks * 32 + hi * 16), a1 = *(const LAS bf16x8*)(kb + (32 + q) * 144 + ks * 32 + hi * 16);
        s0 = __builtin_amdgcn_mfma_f32_32x32x16_bf16(a0, qf[ks], s0, 0, 0, 0); s1 = __builtin_amdgcn_mfma_f32_32x32x16_bf16(a1, qf[ks], s1, 0, 0, 0);
    }
}
__device__ __forceinline__ void ns_pv(f32x16* o, const f32x16& p0, const f32x16& p1, const LAS unsigned char* vb, int q, int hi) {
    bf16x8 pf[4];
#pragma unroll
    for (int h2 = 0; h2 < 2; ++h2) { const u32x4 a = {cvtpk(p0[8 * h2 + 0], p0[8 * h2 + 1]), cvtpk(p0[8 * h2 + 2], p0[8 * h2 + 3]), cvtpk(p0[8 * h2 + 4], p0[8 * h2 + 5]), cvtpk(p0[8 * h2 + 6], p0[8 * h2 + 7])};
        const u32x4 b = {cvtpk(p1[8 * h2 + 0], p1[8 * h2 + 1]), cvtpk(p1[8 * h2 + 2], p1[8 * h2 + 3]), cvtpk(p1[8 * h2 + 4], p1[8 * h2 + 5]), cvtpk(p1[8 * h2 + 6], p1[8 * h2 + 7])};
        pf[h2] = __builtin_bit_cast(bf16x8, a); pf[2 + h2] = __builtin_bit_cast(bf16x8, b); }
#pragma unroll
    for (int dt = 0; dt < 2; ++dt)
#pragma unroll
        for (int ks = 0; ks < 4; ++ks) o[dt] = __builtin_amdgcn_mfma_f32_32x32x16_bf16(*(const LAS bf16x8*)(vb + (32 * dt + q) * 144 + ks * 32 + hi * 16), pf[ks], o[dt], 0, 0, 0);
}
template <int MODE>
__device__ __forceinline__ void ns_block(NsaState& st, const LAS unsigned char* kb, const LAS unsigned char* vb, const bf16x8* qf, const LAS float* bt, int dq, bool selbit, int q, int hi) {
    f32x16 s0, s1; ns_qk(s0, s1, kb, qf, q, hi);
    float mx = -1e30f;
#pragma unroll
    for (int r = 0; r < 16; ++r) {
        const int k0 = crow32(r, hi), d0 = dq - k0, d1 = d0 - 32;
        const bool v0 = MODE == 0 ? (selbit && d0 >= 0) : (d0 >= 0 && d0 < 512), v1 = MODE == 0 ? (selbit && d1 >= 0) : (d1 >= 0 && d1 < 512);
        const float x0 = s0[r] * LOG2E + bt[max(d0, -BIAS_PAD) + BIAS_PAD], x1 = s1[r] * LOG2E + bt[max(d1, -BIAS_PAD) + BIAS_PAD];
        s0[r] = v0 ? x0 : -1e30f; s1[r] = v1 ? x1 : -1e30f; mx = fmaxf(mx, fmaxf(s0[r], s1[r]));
    }
    mx = fmaxf(mx, __shfl_xor(mx, 32));
    const float mn = fmaxf(st.m, mx), sc = exp2f(st.m - mn); st.m = mn;
    float ls = 0.f;
#pragma unroll
    for (int r = 0; r < 16; ++r) { s0[r] = (s0[r] > -1e29f) ? exp2f(s0[r] - mn) : 0.f; s1[r] = (s1[r] > -1e29f) ? exp2f(s1[r] - mn) : 0.f; ls += s0[r] + s1[r]; }
    st.l = st.l * sc + ls;
#pragma unroll
    for (int r = 0; r < 16; ++r) { st.o[0][r] *= sc; st.o[1][r] *= sc; }
    ns_pv(st.o, s0, s1, vb, q, hi);
}
__device__ __forceinline__ void ns_finish(f32x16* out, NsaState& st, float gate) {
    const float lt = st.l + __shfl_xor(st.l, 32); const float f = gate / fmaxf(lt, 1e-30f);
#pragma unroll
    for (int r = 0; r < 16; ++r) { out[0][r] += st.o[0][r] * f; out[1][r] += st.o[1][r] * f; }
}
__device__ __forceinline__ void ns_load(u32x4& kr, u32x4& vr, const bf16_t* kblk, const bf16_t* vblk, int tid) { kr = *(const u32x4*)(kblk + tid * 8); vr = *(const u32x4*)(vblk + tid * 8); }
__device__ __forceinline__ void ns_store(LAS unsigned char* lds, int buf, const u32x4& kr, const u32x4& vr, int tid) {
    const int row = tid >> 3, c = tid & 7; *(LAS u32x4*)(lds + NS_KB + buf * 9216 + row * 144 + c * 16) = kr; *(LAS u32x4*)(lds + NS_VB + buf * 9216 + row * 144 + c * 16) = vr; }

__device__ __forceinline__ void nsa_unit(const Args& a, LAS unsigned char* lds, int b, int g, int qi, int& cur_g, int tid, int wave, int lane) {
    unsigned char* ws = a.ws;
    asm volatile("" : "+v"(tid), "+v"(lane));
    const int q = lane & 31, hi = lane >> 5, r = wave >> 1, th = wave & 1, head = g * 4 + r;
    const int tl = 64 * qi + 32 * th + q, row = b * SEQ + tl;
    const bf16_t* nkv = (const bf16_t*)(ws + WS_NKV);
    if (cur_g != g) { __syncthreads(); const float* bt = (const float*)(ws + WS_BTAB) + (size_t)g * 4 * BIAS_LEN;
#pragma unroll 1
        for (int i = tid; i < 4 * BIAS_LEN; i += NTHREADS) ((LAS float*)(lds + NS_BT))[i] = bt[i];
        cur_g = g; }
    const LAS float* btab = (const LAS float*)(lds + NS_BT) + r * BIAS_LEN;
    bf16x8 qf[4];
#pragma unroll
    for (int ks = 0; ks < 4; ++ks) qf[ks] = *(const bf16x8*)((const bf16_t*)(ws + WS_NQ) + (size_t)row * 512 + head * 64 + ks * 16 + hi * 8);
    const float* smr = (const float*)(ws + WS_SM) + (size_t)row * 32 + 8 + head * 3;
    const float gc = sigmoidf_(smr[0]), gs = sigmoidf_(smr[1]), gw = sigmoidf_(smr[2]);
    f32x16 out[2];
#pragma unroll
    for (int rr = 0; rr < 16; ++rr) { out[0][rr] = 0.f; out[1][rr] = 0.f; }
    NsaState st;
    u32x4 kr, vr;
    const int ncb = (qi >= 16) ? 2 : 1;
    {
        const bf16_t* kcb = (const bf16_t*)(ws + WS_KC) + (size_t)(b * 2 + g) * 128 * 64; const bf16_t* vcb = (const bf16_t*)(ws + WS_VCT) + (size_t)(b * 2 + g) * 2 * 4096;
        __syncthreads();
        ns_load(kr, vr, kcb, vcb, tid); ns_store(lds, 0, kr, vr, tid);
        if (ncb == 2) { ns_load(kr, vr, kcb + 4096, vcb + 4096, tid); ns_store(lds, 1, kr, vr, tid); }
        __syncthreads();
        f32x16 s[2][2];
        float mx = -1e30f;
#pragma unroll
        for (int cb = 0; cb < 2; ++cb) {
            if (cb < ncb) {
                ns_qk(s[cb][0], s[cb][1], lds + NS_KB + cb * 9216, qf, q, hi);
#pragma unroll
                for (int T = 0; T < 2; ++T)
#pragma unroll
                    for (int rr = 0; rr < 16; ++rr) { const int c = 64 * cb + 32 * T + crow32(rr, hi), d = tl - 16 * c - 31;
                        const float x = s[cb][T][rr] * LOG2E + btab[max(d, -BIAS_PAD) + BIAS_PAD]; s[cb][T][rr] = (d >= 0) ? x : -1e30f; mx = fmaxf(mx, s[cb][T][rr]); }
            } else {
#pragma unroll
                for (int rr = 0; rr < 16; ++rr) { s[cb][0][rr] = -1e30f; s[cb][1][rr] = -1e30f; }
            }
        }
        mx = fmaxf(mx, __shfl_xor(mx, 32));
        float ls = 0.f;
#pragma unroll
        for (int cb = 0; cb < 2; ++cb)
#pragma unroll
            for (int T = 0; T < 2; ++T)
#pragma unroll
                for (int rr = 0; rr < 16; ++rr) { const float e = (s[cb][T][rr] > -1e29f) ? exp2f(s[cb][T][rr] - mx) : 0.f; s[cb][T][rr] = e; ls += e; }
        ns_pv(out, s[0][0], s[0][1], lds + NS_VB, q, hi);
        if (ncb == 2) ns_pv(out, s[1][0], s[1][1], lds + NS_VB + 9216, q, hi);
        const float lt = ls + __shfl_xor(ls, 32), rinv = 1.0f / fmaxf(lt, 1e-30f);
        { const float f = gc * rinv;
#pragma unroll
          for (int rr = 0; rr < 16; ++rr) { out[0][rr] *= f; out[1][rr] *= f; } }
        if (qi >= 16) {
            LAS float* imp = (LAS float*)(lds + NS_IMP) + (r * 64 + 32 * th + q) * 33;
            float prevB = 0.f;
#pragma unroll
            for (int cb = 0; cb < 2; ++cb)
#pragma unroll
                for (int T = 0; T < 2; ++T)
#pragma unroll
                    for (int q4 = 0; q4 < 4; ++q4) { const int n = cb * 8 + T * 4 + q4; const float p0 = s[cb][T][4 * q4] * rinv, p1 = s[cb][T][4 * q4 + 1] * rinv, p2 = s[cb][T][4 * q4 + 2] * rinv, p3 = s[cb][T][4 * q4 + 3] * rinv;
                        const float An = 2.0f * (p0 + p1 + p2) + p3, pb = __shfl_xor(p3, 32);
                        imp[2 * n + hi] = hi ? (An + pb) : (An + prevB); prevB = pb; }
        }
        __syncthreads();
        if (qi >= 16) {
            const int tq = tid >> 3, sub = tid & 7; const LAS float* ip = (const LAS float*)(lds + NS_IMP) + tq * 33;
            float sc[32];
#pragma unroll
            for (int j = 0; j < 32; ++j) sc[j] = ((ip[j] + ip[64 * 33 + j]) + ip[2 * 64 * 33 + j]) + ip[3 * 64 * 33 + j];
            unsigned bits = 0u;
#pragma unroll
            for (int jj = 0; jj < 4; ++jj) { const int j = sub * 4 + jj; int rank = 0;
                const float mine = ((ip[j] + ip[64 * 33 + j]) + ip[2 * 64 * 33 + j]) + ip[3 * 64 * 33 + j];
#pragma unroll
                for (int j2 = 0; j2 < 32; ++j2) { const bool cand = (j2 >= 1 && j2 <= qi - 2); rank += (cand && (sc[j2] > mine || (sc[j2] == mine && j2 < j))) ? 1 : 0; }
                const bool forced = (j == 0) || (j == qi) || (j == qi - 1);
                if (forced || (j >= 1 && j <= qi - 2 && rank < SEL_TOPK - 3)) bits |= 1u << j; }
            bits |= __shfl_xor(bits, 1); bits |= __shfl_xor(bits, 2); bits |= __shfl_xor(bits, 4);
            if (sub == 0) ((LAS unsigned*)(lds + NS_SEL))[tq] = bits;
        } else if (tid < 64) ((LAS unsigned*)(lds + NS_SEL))[tid] = (qi >= 31) ? 0xffffffffu : ((2u << qi) - 1u);
        __syncthreads();
    }
    const unsigned selm = ((const LAS unsigned*)(lds + NS_SEL))[32 * th + q];
    {
        const bf16_t* kb = nkv + ((size_t)(4 + g) * MTOK + (size_t)b * SEQ) * 64; const bf16_t* vb = (const bf16_t*)(ws + WS_VST) + (size_t)(b * 2 + g) * 32 * 4096;
        ns_reset(st);
        ns_load(kr, vr, kb, vb, tid);
        for (int j = 0; j <= qi; ++j) {
            ns_store(lds, j & 1, kr, vr, tid);
            __syncthreads();
            if (j < qi) ns_load(kr, vr, kb + (size_t)(j + 1) * 4096, vb + (size_t)(j + 1) * 4096, tid);
            ns_block<0>(st, lds + NS_KB + (j & 1) * 9216, lds + NS_VB + (j & 1) * 9216, qf, btab, tl - 64 * j, (selm >> j) & 1u, q, hi);
        }
        ns_finish(out, st, gs);
    }
    {
        const bf16_t* kb = nkv + ((size_t)(8 + g) * MTOK + (size_t)b * SEQ) * 64; const bf16_t* vb = (const bf16_t*)(ws + WS_VWT) + (size_t)(b * 2 + g) * 32 * 4096;
        const int j0 = qi >= 8 ? qi - 8 : 0;
        ns_reset(st);
        __syncthreads();
        ns_load(kr, vr, kb + (size_t)j0 * 4096, vb + (size_t)j0 * 4096, tid);
        for (int j = j0; j <= qi; ++j) {
            ns_store(lds, j & 1, kr, vr, tid);
            __syncthreads();
            if (j < qi) ns_load(kr, vr, kb + (size_t)(j + 1) * 4096, vb + (size_t)(j + 1) * 4096, tid);
            ns_block<1>(st, lds + NS_KB + (j & 1) * 9216, lds + NS_VB + (j & 1) * 9216, qf, btab, tl - 64 * j, true, q, hi);
        }
        ns_finish(out, st, gw);
    }
    bf16_t* yn = (bf16_t*)(ws + WS_QK) + (size_t)row * 1024 + 512 + head * 64;
#pragma unroll
    for (int dt = 0; dt < 2; ++dt)
#pragma unroll
        for (int q4 = 0; q4 < 4; ++q4) { u32x2 w; w.x = cvtpk(out[dt][4 * q4], out[dt][4 * q4 + 1]); w.y = cvtpk(out[dt][4 * q4 + 2], out[dt][4 * q4 + 3]); *(u32x2*)(yn + 32 * dt + 8 * q4 + 4 * hi) = w; }
}

__device__ __forceinline__ void p3_mixers(const Args& a, LAS unsigned char* lds, int tid, int wave, int lane, int cword = 0) {
    unsigned* ctr = (unsigned*)(a.ws + WS_CTL) + cword;
    LAS unsigned* slot = (LAS unsigned*)(lds + 143 * 1024);
    int cur_g = -1;
    for (int it_ = 0;; ++it_) {
        __syncthreads();
#ifdef DBG_STATIC_Q
        if (tid == 0) *slot = (unsigned)(blockIdx.x + it_ * gridDim.x);
#else
        if (tid == 0) *slot = atomicAdd(ctr, 1u);
#endif
        __syncthreads();
        const int idx = (int)*slot;
        if (idx >= 64 + 1024) break;
        if (idx < 64) {
#ifdef DBG_NO_ML
            { const int b = idx >> 2, h = idx & 3; bf16_t* ym = (bf16_t*)(a.ws + WS_QK) + (size_t)b * SEQ * 1024 + h * 128;
              for (int i = tid; i < SEQ * 16; i += NTHREADS) *(u32x4*)(ym + (size_t)(i >> 4) * 1024 + (i & 15) * 8) = (u32x4){0u, 0u, 0u, 0u}; }
#else
            mlstm_item(a, lds, idx >> 2, idx & 3, tid, wave, lane);
#endif
            cur_g = -1; }
        else { const int u = idx - 64;
#ifdef DBG_NO_NSA
            { const int b = (u & 31) >> 1, g = u & 1, qi = 31 - (u >> 5); bf16_t* yn = (bf16_t*)(a.ws + WS_QK) + ((size_t)b * SEQ + qi * 64) * 1024 + 512 + g * 256;
              for (int i = tid; i < 64 * 32; i += NTHREADS) *(u32x4*)(yn + (size_t)(i >> 5) * 1024 + (i & 31) * 8) = (u32x4){0u, 0u, 0u, 0u}; }
#else
            nsa_unit(a, lds, (u & 31) >> 1, u & 1, 31 - (u >> 5), cur_g, tid, wave, lane);
#endif
        }
    }
}

__global__ void __launch_bounds__(NTHREADS, 2) mega_fwd(Args a) {
    extern __shared__ __attribute__((aligned(16))) unsigned char lds_raw[];
    LAS unsigned char* lds = (LAS unsigned char*)lds_raw;
    const int tid = threadIdx.x, lane = tid & 63, wave = __builtin_amdgcn_readfirstlane(tid >> 6);
    const int G = gridDim.x; const int bx = blockIdx.x; const int vcu = (G % 8 == 0) ? (bx % 8) * (G / 8) + bx / 8 : bx;
    cg::grid_group grid = cg::this_grid();
    unsigned char* ws = a.ws;
    const int lo = a.ph_lo, hi = a.ph_hi;
#define IN(k) (lo <= (k) && (k) < hi)
#define FULLSYNC() do { asm volatile("s_waitcnt vmcnt(0) lgkmcnt(0)" ::: "memory"); grid.sync(); \
    if (tid < 64) { __builtin_amdgcn_fence(__ATOMIC_ACQUIRE, "agent"); asm volatile("s_waitcnt vmcnt(0)" ::: "memory"); } __syncthreads(); } while (0)
#define SEAM(k) do { if (IN(k) && IN((k) + 1)) FULLSYNC(); } while (0)

#define PH0() p0_prologue(a, lds, vcu, G, wave, lane)
#define PH1() do { pg8::StaticOrder S; S.init(ws + WS_XB, 1024, ws + WS_W1T, 1024, MTOK, N1, G, bx); \
        EpiProj E{(const float*)(ws + WS_RSX), (const float*)(ws + WS_BIAS1), ws}; \
        pg8::gemm_phase<EpiProj, pg8::StaticOrder, true>(lds, pg8::Dims{1024, 1024, 16}, S, E); } while (0)
#define PH2() p2_prep(a, lds, bx, G, wave, lane)
#define PH3() p3_mixers(a, lds, tid, wave, lane, 0)
#define PH4() do { pg8::DualOrder S; S.init(ws + WS_QK, 1024, ws + WS_WBRT, 512, MTOK, 1024, G, bx, (size_t)512 * 2, (size_t)1024 * 512 * 2); \
        EpiBranch E{(const bf16_t*)(ws + WS_GT), (bf16_t*)(ws + WS_VO)}; \
        pg8::gemm_phase<EpiBranch, pg8::DualOrder, true>(lds, pg8::Dims{1024, 512, 8}, S, E); } while (0)
#define PH5() do { pg8::StaticOrder S; S.init(ws + WS_VO, 1024, ws + WS_WOUTT, 1024, MTOK, 1024, G, bx); \
        EpiResid E{a.x, a.out, (bf16_t*)(ws + WS_XB), (float*)(ws + WS_PART1)}; \
        pg8::gemm_phase<EpiResid, pg8::StaticOrder, true>(lds, pg8::Dims{1024, 1024, 16}, S, E); } while (0)
#define PH6() do { pg8::StaticOrder S; S.init(ws + WS_XB, 1024, ws + WS_WGUT, 1024, MTOK, NGU, G, bx); \
        EpiGateUp E{(const float*)(ws + WS_PART1), (bf16_t*)(ws + WS_HID)}; \
        pg8::gemm_phase<EpiGateUp, pg8::StaticOrder, true>(lds, pg8::Dims{1024, 1024, 16}, S, E); } while (0)
#define PH7() do { pg8::StaticOrder S; S.init(ws + WS_HID, D_FF, ws + WS_WDNT, D_FF, MTOK, 1024, G, bx); \
        EpiResid E{a.out, a.out, nullptr, (float*)(ws + WS_PART2)}; \
        pg8::gemm_phase<EpiResid, pg8::StaticOrder, true>(lds, pg8::Dims{D_FF, D_FF, D_FF / 64}, S, E); } while (0)
#define PH8() p8_final(a, vcu, G, wave, lane)
#ifndef DUP_PHASE
#define DUP_PHASE -1
#endif
#define RUN(k, PH) do { if (IN(k)) { PH(); if (DUP_PHASE == (k)) { FULLSYNC(); if ((k) == 3) p3_mixers(a, lds, tid, wave, lane, 1); else PH(); } } } while (0)
    RUN(0, PH0); SEAM(0);
    RUN(1, PH1); SEAM(1);
    RUN(2, PH2); SEAM(2);
    RUN(3, PH3); SEAM(3);
    RUN(4, PH4); SEAM(4);
    RUN(5, PH5); SEAM(5);
    RUN(6, PH6); SEAM(6);
    RUN(7, PH7); SEAM(7);
    RUN(8, PH8);
#undef IN
#undef SEAM
}

constexpr int NPHASES = 9;
#ifndef N_LAUNCHES
#define N_LAUNCHES 1
#endif
extern "C" void kernel_launch(void* const* d_in, const int* in_sizes, int n_in, void* d_out, int out_size, void* d_ws, size_t ws_size, hipStream_t stream) {
    static int grid = 0;
    if (grid == 0) {
        if (n_in != 18 || out_size != MTOK * D_MODEL || ws_size < WS_END) { fprintf(stderr, "kernel_launch: unexpected shapes (n_in %d out %d ws %zu)\n", n_in, out_size, ws_size); grid = -1; return; }
        int dev = 0, cus = 0, per_cu = 0;
        if (hipGetDevice(&dev) != hipSuccess || hipDeviceGetAttribute(&cus, hipDeviceAttributeMultiprocessorCount, dev) != hipSuccess) { grid = -1; return; }
        if (hipFuncSetAttribute((const void*)mega_fwd, hipFuncAttributeMaxDynamicSharedMemorySize, LDS_BYTES) != hipSuccess) { fprintf(stderr, "kernel_launch: hipFuncSetAttribute failed\n"); grid = -1; return; }
        if (hipOccupancyMaxActiveBlocksPerMultiprocessor(&per_cu, (const void*)mega_fwd, NTHREADS, LDS_BYTES) != hipSuccess || per_cu < 1) { fprintf(stderr, "kernel_launch: occupancy query says %d blocks per CU\n", per_cu); per_cu = 1; }
        (void)hipGetLastError();
        grid = cus;
    }
    if (grid < 0) return;
    Args a{};
    const float** ap = (const float**)&a;
    for (int i = 0; i < 18; ++i) ap[i] = (const float*)d_in[i];
    a.out = (float*)d_out; a.ws = (unsigned char*)d_ws;
    if (N_LAUNCHES == 1) {
        a.ph_lo = 0; a.ph_hi = NPHASES; a.coop = 1; a.pad = 0;
        void* args[] = {&a};
        hipError_t e = hipLaunchCooperativeKernel((const void*)mega_fwd, dim3(grid), dim3(NTHREADS), args, LDS_BYTES, stream);
        if (e != hipSuccess) fprintf(stderr, "kernel_launch: cooperative launch failed: %s (grid %d)\n", hipGetErrorString(e), grid);
    } else {
        for (int p = 0; p < NPHASES; ++p) {
            a.ph_lo = p; a.ph_hi = p + 1; a.coop = 0; a.pad = 0;
            hipLaunchKernelGGL(mega_fwd, dim3(grid), dim3(NTHREADS), LDS_BYTES, stream, a);
        }
    }
}
```

```cpp
#include <hip/hip_runtime.h>
#include <hip/hip_cooperative_groups.h>
#include <cstdio>
#include <cstdint>
namespace cg = cooperative_groups;

#define LAS __attribute__((address_space(3)))
typedef unsigned short bf16_t;
typedef short bf16x8 __attribute__((ext_vector_type(8)));
typedef short s16x4 __attribute__((ext_vector_type(4)));
typedef float f32x4 __attribute__((ext_vector_type(4)));
typedef float f32x2 __attribute__((ext_vector_type(2)));
typedef float f32x16 __attribute__((ext_vector_type(16)));
typedef unsigned u32x4 __attribute__((ext_vector_type(4)));
typedef unsigned u32x2 __attribute__((ext_vector_type(2)));
typedef __bf16 bf16x2_t __attribute__((ext_vector_type(2)));

constexpr int D_MODEL = 1024, BATCH = 16, SEQ = 2048, MTOK = BATCH * SEQ;
constexpr int M_HEADS = 4, M_HD = 128, M_WIDTH = 512, M_CHUNK = 128, NCHUNK = SEQ / M_CHUNK;
constexpr int N_HEADS = 8, N_G = 2, N_R = 4, N_HD = 64;
constexpr int N_CMP = 127, N_SLC = 32, SEL_TOPK = 16;
constexpr int D_FF = 2816, D_IN = 5408;
constexpr int N1 = 5632;
constexpr int NGU = 2 * D_FF;
constexpr float RMS_EPS = 1e-6f;
constexpr int BIAS_PAD = 64, BIAS_LEN = SEQ + BIAS_PAD;

constexpr size_t KiB = 1024, MiB = 1u << 20;
constexpr size_t WS_CTL   = 0;
constexpr size_t WS_BIAS1 = 4 * KiB;
constexpr size_t WS_PEB   = 28 * KiB;
constexpr size_t WS_WC2T  = 32 * KiB;
constexpr size_t WS_BTAB  = 64 * KiB;
constexpr size_t WS_RSX   = 256 * KiB;
constexpr size_t WS_W1T   = 1 * MiB;
constexpr size_t WS_WGUT  = 12 * MiB;
constexpr size_t WS_WDNT  = 23 * MiB;
constexpr size_t WS_WOUTT = 29 * MiB;
constexpr size_t WS_WBRT  = 31 * MiB;
constexpr size_t WS_WC1T  = 33 * MiB;
constexpr size_t WS_PART1 = 34 * MiB;
constexpr size_t WS_PART2 = 36 * MiB;
constexpr size_t WS_KC    = 38 * MiB;
constexpr size_t WS_VCT   = 38 * MiB + 512 * KiB;
constexpr size_t WS_HAB   = 39 * MiB;
constexpr size_t WS_XB    = 48 * MiB;
constexpr size_t WS_QK    = 112 * MiB;
constexpr size_t WS_VO    = 176 * MiB;
constexpr size_t WS_NQ    = 240 * MiB;
constexpr size_t WS_NKV   = 272 * MiB;
constexpr size_t WS_HID   = 112 * MiB;
constexpr size_t WS_GT    = 320 * MiB;
constexpr size_t WS_SM    = 448 * MiB;
constexpr size_t WS_VST   = 452 * MiB;
constexpr size_t WS_VWT   = 460 * MiB;
constexpr size_t WS_END   = 468 * MiB;

__device__ __forceinline__ unsigned cvtpk(float lo, float hi) { f32x2 v = {lo, hi}; bf16x2_t b = __builtin_convertvector(v, bf16x2_t); return __builtin_bit_cast(unsigned, b); }
__device__ __forceinline__ float bf2f(unsigned short u) { return __uint_as_float(((unsigned)u) << 16); }
__device__ __forceinline__ float bflo(unsigned u) { return __uint_as_float(u << 16); }
__device__ __forceinline__ float bfhi(unsigned u) { return __uint_as_float(u & 0xffff0000u); }
__device__ __forceinline__ float sigmoidf_(float x) { return __builtin_amdgcn_rcpf(1.0f + __expf(-x)); }
__device__ __forceinline__ float wave_sum(float v) {
#pragma unroll
    for (int o = 1; o < 64; o <<= 1) v += __shfl_xor(v, o);
    return v;
}

namespace pg8 {
constexpr int BM = 256, BK = 64, HALF = 128, HTB = HALF * BK * 2  , STAGE_BYTES = 8 * HTB, NXCD = 8, WGM = 8;
__host__ __device__ __forceinline__ int lds_byte(int r, int c) { const int st = (r >> 4) * 2 + (c >> 5), rr = r & 15, cc = c & 31, ob = rr * 64 + cc * 2; return st * 1024 + (ob ^ (((ob >> 9) & 1) << 5)); }
__host__ __device__ __forceinline__ void stage_rc(int b, int& R, int& C) { const int st = b / 1024, sb = b % 1024, swz = sb ^ (((sb >> 9) & 1) << 5); R = (st >> 1) * 16 + swz / 64; C = (st & 1) * 32 + (swz % 64) / 2; }

struct Unit { int pm, pn, seg; const char* A; const char* B; };
struct Dims { int lda, ldb, nt; };

__device__ __forceinline__ void tile_of(int L, int nM, int nN, int& pm, int& pn) {
    const int nwg = nM * nN; int wgid = L; { const int q = nwg / NXCD, r = nwg % NXCD, xcd = wgid % NXCD, off = wgid / NXCD; wgid = (xcd < r ? xcd * (q + 1) : r * (q + 1) + (xcd - r) * q) + off; }
    const int nig = WGM * nN, gid = wgid / nig, fm = gid * WGM, gsz = (nM - fm) < WGM ? (nM - fm) : WGM;
    pm = fm + ((wgid % nig) % gsz); pn = (wgid % nig) / gsz;
}
struct StaticOrder {
    int nM, nN, nwg, G, c; const char* A; const char* B; size_t tstepA, tstepB;
    __device__ void init(const void* A_, int lda, const void* B_, int ldb, int M, int N, int G_, int c_) { nM = M / BM; nN = N / BM; nwg = nM * nN; G = G_; c = c_; A = (const char*)A_; B = (const char*)B_; tstepA = (size_t)BM * lda * 2; tstepB = (size_t)BM * ldb * 2; }
    __device__ __forceinline__ bool next(int i, Unit& u) const {
        const long L = (long)i * G + c; if (L >= nwg) return false;
        tile_of((int)L, nM, nN, u.pm, u.pn); u.seg = 0; u.A = A + (size_t)u.pm * tstepA; u.B = B + (size_t)u.pn * tstepB; return true;
    }
    __device__ __forceinline__ bool carry(const Unit&) const { return false; }
};
struct DualOrder {
    int nM, nN, nwg, G, c; const char* A; const char* B; size_t tstepA, tstepB, segA, segB;
    __device__ void init(const void* A_, int lda, const void* B_, int ldb, int M, int N, int G_, int c_, size_t segA_, size_t segB_) { nM = M / BM; nN = N / BM; nwg = nM * nN; G = G_; c = c_; A = (const char*)A_; B = (const char*)B_; tstepA = (size_t)BM * lda * 2; tstepB = (size_t)BM * ldb * 2; segA = segA_; segB = segB_; }
    __device__ __forceinline__ bool next(int i, Unit& u) const {
        const long L = (long)(i >> 1) * G + c; if (L >= nwg) return false;
        tile_of((int)L, nM, nN, u.pm, u.pn); u.seg = i & 1; u.A = A + (size_t)u.pm * tstepA + (size_t)u.seg * segA; u.B = B + (size_t)u.pn * tstepB + (size_t)u.seg * segB; return true;
    }
    __device__ __forceinline__ bool carry(const Unit& u) const { return u.seg == 0; }
};

template <class Epi, class Sched, bool ALIGN_EPI>
__device__ __forceinline__ void gemm_phase(LAS unsigned char* lds, const Dims g, const Sched& S, const Epi& E) {
    const int tid = threadIdx.x, wid = __builtin_amdgcn_readfirstlane(tid >> 6), lane = tid & 63, wr = wid >> 2, wc = wid & 3, fr = lane & 15, fq = lane >> 4;
    const int nt = g.nt;
    unsigned voffA[2], voffB[2];
#pragma unroll
    for (int i = 0; i < 2; ++i) { int R, C; stage_rc(tid * 16 + i * 8192, R, C); voffA[i] = (unsigned)(R * g.lda + C) * 2u; voffB[i] = (unsigned)(R * g.ldb + C) * 2u; }
    const size_t kstep = (size_t)(BK * 2);
    const size_t hstepA = (size_t)HALF * g.lda * 2, hstepB = (size_t)HALF * g.ldb * 2;
    const unsigned ldsw = (unsigned)wid * 1024u;
    const int aoff = lds_byte(wr * 64 + fr, fq * 8), boff = lds_byte(wc * 32 + fr, fq * 8);
#define PG8_SA(b, h) (((b) * 2 + (h)) * HTB)
#define PG8_SB(b, h) ((4 + (b) * 2 + (h)) * HTB)
#define PG8_STAGE(bufoff, gbase, voff) do { _Pragma("unroll") for (int _i = 0; _i < 2; ++_i) \
        __builtin_amdgcn_global_load_lds((const unsigned*)((const char*)(gbase) + (voff)[_i]), (LAS unsigned*)(lds + (bufoff) + ldsw + _i * 8192), 16, 0, 0); } while (0)
#define PG8_LDA(dst, b, h) do { _Pragma("unroll") for (int m = 0; m < 4; ++m) _Pragma("unroll") for (int k = 0; k < 2; ++k) dst[m][k] = *(const LAS bf16x8*)(lds + PG8_SA(b, h) + aoff + m * 2048 + k * 1024); } while (0)
#define PG8_LDB(dst, b, h) do { _Pragma("unroll") for (int n = 0; n < 2; ++n) _Pragma("unroll") for (int k = 0; k < 2; ++k) dst[n][k] = *(const LAS bf16x8*)(lds + PG8_SB(b, h) + boff + n * 2048 + k * 1024); } while (0)
#define PG8_MMA(ai, bj, At, Bt) do { __builtin_amdgcn_s_setprio(1); _Pragma("unroll") for (int m = 0; m < 4; ++m) _Pragma("unroll") for (int n = 0; n < 2; ++n) _Pragma("unroll") for (int k = 0; k < 2; ++k) \
        acc[ai][bj][m][n] = __builtin_amdgcn_mfma_f32_16x16x32_bf16(Bt[n][k], At[m][k], acc[ai][bj][m][n], 0, 0, 0); __builtin_amdgcn_s_setprio(0); } while (0)
#define PG8_WAIT_V(n) asm volatile("s_waitcnt vmcnt(" #n ")" ::: "memory")
#define PG8_WAIT_L(n) asm volatile("s_waitcnt lgkmcnt(" #n ")" ::: "memory")
#define PG8_BAR __builtin_amdgcn_s_barrier()
#define PG8_SCHED __builtin_amdgcn_sched_barrier(0)
    Unit cur, nxt; int ui = 0;
    if (!S.next(0, cur)) return;
    f32x4 acc[2][2][4][2];
#pragma unroll
    for (int a = 0; a < 2; ++a)
#pragma unroll
        for (int b = 0; b < 2; ++b)
#pragma unroll
            for (int m = 0; m < 4; ++m)
#pragma unroll
                for (int n = 0; n < 2; ++n) acc[a][b][m][n] = (f32x4){0.f, 0.f, 0.f, 0.f};
    bf16x8 At[4][2], B0[2][2], B1[2][2];
    const char* cA = cur.A; const char* cB = cur.B;
    PG8_STAGE(PG8_SB(0, 0), cB, voffB); PG8_STAGE(PG8_SB(0, 1), cB + hstepB, voffB); PG8_STAGE(PG8_SA(0, 0), cA, voffA); PG8_STAGE(PG8_SA(0, 1), cA + hstepA, voffA);
    if (wr == 1) PG8_BAR;
    PG8_WAIT_V(2); PG8_BAR;
    PG8_STAGE(PG8_SB(1, 0), cB + kstep, voffB); PG8_STAGE(PG8_SA(1, 0), cA + kstep, voffA); PG8_STAGE(PG8_SB(1, 1), cB + hstepB + kstep, voffB);
    PG8_WAIT_V(6); PG8_BAR;
    for (;;) {
        const bool has_next = S.next(ui + 1, nxt);
        const char* nA = has_next ? nxt.A : cA; const char* nB = has_next ? nxt.B : cB;
        for (int t = 0; t < nt; t += 2) {
            const bool last = (t == nt - 2);
            const char* a1 = cA + (size_t)(t + 1) * kstep;
            const char* a2 = last ? nA : cA + (size_t)(t + 2) * kstep; const char* b2 = last ? nB : cB + (size_t)(t + 2) * kstep;
            const char* a3 = a2 + kstep; const char* b3 = b2 + kstep;
            PG8_LDB(B0, 0, 0); PG8_LDB(B1, 0, 1); PG8_SCHED; PG8_LDA(At, 0, 0); PG8_STAGE(PG8_SA(1, 1), a1 + hstepA, voffA);
            PG8_WAIT_V(8); PG8_WAIT_L(0); PG8_BAR; PG8_MMA(0, 0, At, B0); PG8_MMA(0, 1, At, B1); PG8_BAR; PG8_SCHED;
            PG8_LDA(At, 0, 1); PG8_STAGE(PG8_SB(0, 0), b2, voffB); PG8_STAGE(PG8_SB(0, 1), b2 + hstepB, voffB); PG8_STAGE(PG8_SA(0, 0), a2, voffA);
            PG8_WAIT_V(8); PG8_WAIT_L(0); PG8_BAR; PG8_MMA(1, 0, At, B0); PG8_MMA(1, 1, At, B1); PG8_BAR; PG8_SCHED;
            PG8_LDB(B0, 1, 0); PG8_LDB(B1, 1, 1); PG8_SCHED; PG8_LDA(At, 1, 0); PG8_STAGE(PG8_SA(0, 1), a2 + hstepA, voffA);
            PG8_WAIT_V(8); PG8_WAIT_L(0); PG8_BAR; PG8_MMA(0, 0, At, B0); PG8_MMA(0, 1, At, B1); PG8_BAR; PG8_SCHED;
            PG8_LDA(At, 1, 1); PG8_STAGE(PG8_SB(1, 0), b3, voffB); PG8_STAGE(PG8_SB(1, 1), b3 + hstepB, voffB); PG8_STAGE(PG8_SA(1, 0), a3, voffA);
            PG8_WAIT_V(8); PG8_WAIT_L(0); PG8_BAR; PG8_MMA(1, 0, At, B0); PG8_MMA(1, 1, At, B1); PG8_BAR; PG8_SCHED;
        }
        if constexpr (ALIGN_EPI) { if (wr == 0) PG8_BAR; }
        if constexpr (!Epi::AFTER_DRAIN) { E(acc, cur, wr, wc, fr, fq); }
        if (!has_next) break;
        if (!S.carry(cur)) {
#pragma unroll
            for (int a = 0; a < 2; ++a)
#pragma unroll
                for (int b = 0; b < 2; ++b)
#pragma unroll
                    for (int m = 0; m < 4; ++m)
#pragma unroll
                        for (int n = 0; n < 2; ++n) acc[a][b][m][n] = (f32x4){0.f, 0.f, 0.f, 0.f};
        }
        cur = nxt; cA = nA; cB = nB; ++ui;
        if constexpr (ALIGN_EPI) { if (wr == 1) PG8_BAR; }
    }
    PG8_WAIT_V(0);
    if constexpr (!ALIGN_EPI) { if (wr == 0) PG8_BAR; }
    PG8_BAR;
    if constexpr (Epi::AFTER_DRAIN) { E.fused(acc, cur, wr, wc, fr, fq, lds, wid, lane); }
#undef PG8_SA
#undef PG8_SB
#undef PG8_STAGE
#undef PG8_LDA
#undef PG8_LDB
#undef PG8_MMA
#undef PG8_WAIT_V
#undef PG8_WAIT_L
#undef PG8_BAR
#undef PG8_SCHED
}
}

typedef f32x4 acc_t[2][2][4][2];

struct EpiProj {
    static constexpr bool AFTER_DRAIN = false;
    const float* rstd; const float* bias; unsigned char* ws;
    __device__ __forceinline__ void operator()(acc_t& acc, const pg8::Unit& u, int wr, int wc, int fr, int fq) const {
        const int pn = u.pn, row0 = u.pm * 256 + wr * 64 + fr;
        f32x4 bv[2][2];
#pragma unroll
        for (int bj = 0; bj < 2; ++bj)
#pragma unroll
            for (int n = 0; n < 2; ++n) bv[bj][n] = *(const f32x4*)(bias + pn * 256 + bj * 128 + wc * 32 + n * 16 + 4 * fq);
        if (pn == 21) {
            if (wc == 0) {
                float* sm = (float*)(ws + WS_SM);
                float rsv[2][4];
#pragma unroll
                for (int ai = 0; ai < 2; ++ai)
#pragma unroll
                    for (int m = 0; m < 4; ++m) rsv[ai][m] = rstd[row0 + ai * 128 + m * 16];
#pragma unroll
                for (int ai = 0; ai < 2; ++ai)
#pragma unroll
                    for (int m = 0; m < 4; ++m) { const int row = row0 + ai * 128 + m * 16; const float rs = rsv[ai][m];
#pragma unroll
                        for (int n = 0; n < 2; ++n) *(f32x4*)(sm + (size_t)row * 32 + n * 16 + 4 * fq) = acc[ai][0][m][n] * rs + bv[0][n]; }
            }
            return;
        }
        bf16_t* cb[2]; int ld, mode = 0;
        if (pn < 8) { bf16_t* b = (bf16_t*)(ws + (pn < 4 ? WS_QK : WS_VO)) + (pn & 3) * 256 + wc * 32; cb[0] = b; cb[1] = b + 128; ld = 1024; mode = (pn >= 6) ? 1 : 0; }
        else if (pn < 10) { bf16_t* b = (bf16_t*)(ws + WS_NQ) + (pn - 8) * 256 + wc * 32; cb[0] = b; cb[1] = b + 128; ld = 512; mode = 2; }
        else if (pn < 13) { bf16_t* b = (bf16_t*)(ws + WS_NKV) + (size_t)((pn - 10) * 4 + (wc >> 1)) * MTOK * 64 + 32 * (wc & 1); cb[0] = b; cb[1] = b + (size_t)2 * MTOK * 64; ld = 64; }
        else { bf16_t* b = (bf16_t*)(ws + WS_GT) + (pn - 13) * 256 + wc * 32; cb[0] = b; cb[1] = b + 128; ld = 2048; mode = 1; }
        float rsv[2][4];
#pragma unroll
        for (int ai = 0; ai < 2; ++ai)
#pragma unroll
            for (int m = 0; m < 4; ++m) rsv[ai][m] = rstd[row0 + ai * 128 + m * 16];
#pragma unroll
        for (int ai = 0; ai < 2; ++ai)
#pragma unroll
            for (int m = 0; m < 4; ++m) { const int row = row0 + ai * 128 + m * 16; const float rs = rsv[ai][m];
#pragma unroll
                for (int bj = 0; bj < 2; ++bj)
#pragma unroll
                    for (int n = 0; n < 2; ++n) { f32x4 v = acc[ai][bj][m][n] * rs + bv[bj][n];
                        if (mode == 1) { v[0] = sigmoidf_(v[0]); v[1] = sigmoidf_(v[1]); v[2] = sigmoidf_(v[2]); v[3] = sigmoidf_(v[3]); }
                        else if (mode == 2) v = v * 0.125f;
                        u32x2 w; w.x = cvtpk(v[0], v[1]); w.y = cvtpk(v[2], v[3]);
                        *(u32x2*)(cb[bj] + (size_t)row * ld + n * 16 + 4 * fq) = w; } }
    }
};

struct EpiBranch {
    static constexpr bool AFTER_DRAIN = false;
    const bf16_t* gt; bf16_t* mixed;
    __device__ __forceinline__ void operator()(acc_t& acc, const pg8::Unit& u, int wr, int wc, int fr, int fq) const {
        const int row0 = u.pm * 256 + wr * 64 + fr, col0 = u.pn * 256 + wc * 32 + 4 * fq;
        const bool s0 = (u.seg == 0);
#pragma unroll
        for (int ai = 0; ai < 2; ++ai)
#pragma unroll
            for (int m = 0; m < 4; ++m) {
                const bf16_t* gp = gt + (size_t)(row0 + ai * 128 + m * 16) * 2048 + col0;
                u32x2 q1[2][2], q0[2][2];
#pragma unroll
                for (int bj = 0; bj < 2; ++bj)
#pragma unroll
                    for (int n = 0; n < 2; ++n) { q1[bj][n] = *(const u32x2*)(gp + 1024 + bj * 128 + n * 16); q0[bj][n] = s0 ? *(const u32x2*)(gp + bj * 128 + n * 16) : (u32x2){0x3f803f80u, 0x3f803f80u}; }
#pragma unroll
                for (int bj = 0; bj < 2; ++bj)
#pragma unroll
                    for (int n = 0; n < 2; ++n) { const u32x2 a0 = q0[bj][n], a1 = q1[bj][n];
                        const f32x4 g0 = {bflo(a0.x), bfhi(a0.x), bflo(a0.y), bfhi(a0.y)}, g1 = {bflo(a1.x), bfhi(a1.x), bflo(a1.y), bfhi(a1.y)};
                        f32x4 a = acc[ai][bj][m][n];
#pragma unroll
                        for (int e = 0; e < 4; ++e) a[e] = s0 ? a[e] * g0[e] * __builtin_amdgcn_rcpf(fmaxf(g1[e], 1e-18f)) : a[e] * g1[e];
                        acc[ai][bj][m][n] = a; }
                asm volatile("" ::: "memory");
            }
        if (!s0) {
#pragma unroll
            for (int ai = 0; ai < 2; ++ai)
#pragma unroll
                for (int m = 0; m < 4; ++m)
#pragma unroll
                    for (int bj = 0; bj < 2; ++bj)
#pragma unroll
                        for (int n = 0; n < 2; ++n) { const f32x4 v = acc[ai][bj][m][n]; u32x2 w; w.x = cvtpk(v[0], v[1]); w.y = cvtpk(v[2], v[3]);
                            *(u32x2*)(mixed + (size_t)(row0 + ai * 128 + m * 16) * 1024 + col0 + bj * 128 + n * 16) = w; }
        }
    }
};

struct EpiResid {
    static constexpr bool AFTER_DRAIN = false;
    const float* base; float* out; bf16_t* outb; float* part;
    __device__ __forceinline__ void operator()(acc_t& acc, const pg8::Unit& u, int wr, int wc, int fr, int fq) const {
        int row0 = u.pm * 256 + wr * 64 + fr; const int col0 = u.pn * 256 + wc * 32 + 4 * fq;
#pragma unroll
        for (int ai = 0; ai < 2; ++ai)
#pragma unroll
            for (int mh = 0; mh < 4; ++mh) {
                if ((mh & 1) == 0) asm volatile("" : "+v"(row0) :: "memory");
                f32x4 r[2][2];
#pragma unroll
                for (int bj = 0; bj < 2; ++bj)
#pragma unroll
                    for (int n = 0; n < 2; ++n) r[bj][n] = *(const f32x4*)(base + (size_t)(row0 + ai * 128 + mh * 16) * 1024 + col0 + bj * 128 + n * 16);
#pragma unroll
                for (int bj = 0; bj < 2; ++bj)
#pragma unroll
                    for (int n = 0; n < 2; ++n) acc[ai][bj][mh][n] += r[bj][n];
                if (mh & 1) asm volatile("" : "+v"(acc[ai][0][mh][0]), "+v"(acc[ai][1][mh][1]) :: "memory");
            }
#pragma unroll
        for (int ai = 0; ai < 2; ++ai)
#pragma unroll
            for (int m = 0; m < 4; ++m) { const int row = row0 + ai * 128 + m * 16; float ss = 0.f;
#pragma unroll
                for (int bj = 0; bj < 2; ++bj)
#pragma unroll
                    for (int n = 0; n < 2; ++n) { const size_t off = (size_t)row * 1024 + col0 + bj * 128 + n * 16;
                        const f32x4 v = acc[ai][bj][m][n];
                        ss += (v[0] * v[0] + v[1] * v[1]) + (v[2] * v[2] + v[3] * v[3]);
                        *(f32x4*)(out + off) = v;
                        if (outb) { u32x2 w; w.x = cvtpk(v[0], v[1]); w.y = cvtpk(v[2], v[3]); *(u32x2*)(outb + off) = w; } }
                ss += __shfl_xor(ss, 16); ss += __shfl_xor(ss, 32);
                if (fq == 0) part[((size_t)u.pn * MTOK + row) * 4 + wc] = ss; }
    }
};

struct EpiGateUp {
    static constexpr bool AFTER_DRAIN = false;
    const float* part; bf16_t* hid;
    __device__ __forceinline__ void operator()(acc_t& acc, const pg8::Unit& u, int wr, int wc, int fr, int fq) const {
        const int row0 = u.pm * 256 + wr * 64 + fr, col0 = u.pn * 128 + wc * 16 + 4 * fq;
        float rsv[2][4];
        { f32x4 pp[2][4];
#pragma unroll
          for (int ai = 0; ai < 2; ++ai)
#pragma unroll
            for (int m = 0; m < 4; ++m) pp[ai][m] = *(const f32x4*)(part + ((size_t)fq * MTOK + row0 + ai * 128 + m * 16) * 4);
#pragma unroll
          for (int ai = 0; ai < 2; ++ai)
#pragma unroll
            for (int m = 0; m < 4; ++m) { float s = (pp[ai][m][0] + pp[ai][m][1]) + (pp[ai][m][2] + pp[ai][m][3]); s += __shfl_xor(s, 16); s += __shfl_xor(s, 32); rsv[ai][m] = rsqrtf(s * (1.0f / 1024.0f) + RMS_EPS); } }
#pragma unroll
        for (int ai = 0; ai < 2; ++ai)
#pragma unroll
            for (int m = 0; m < 4; ++m) { const int row = row0 + ai * 128 + m * 16;
                const float rs = rsv[ai][m];
#pragma unroll
                for (int bj = 0; bj < 2; ++bj) { const f32x4 g = acc[ai][bj][m][0] * rs, up = acc[ai][bj][m][1] * rs; f32x4 y;
#pragma unroll
                    for (int e = 0; e < 4; ++e) y[e] = g[e] * sigmoidf_(g[e]) * up[e];
                    u32x2 w; w.x = cvtpk(y[0], y[1]); w.y = cvtpk(y[2], y[3]);
                    *(u32x2*)(hid + (size_t)row * D_FF + col0 + bj * 64) = w; } }
    }
};

struct Args {
    const float* x; const float* g_norm_mix; const float* w_in; const float* b_in; const float* b_fgate; const float* conv_qk; const float* g_mlstm_head; const float* pe_cmp;
    const float* w_cmp1; const float* w_cmp2; const float* rel_bias; const float* w_branch; const float* w_out; const float* g_norm_ffn; const float* w_gate; const float* w_up;
    const float* w_down; const float* g_final;
    float* out; unsigned char* ws; int ph_lo, ph_hi, coop, pad;
};
constexpr int NWAVES = 8, NTHREADS = 512;
constexpr int RING_BYTES = 131072, LDS_BYTES = 147456;

__device__ __forceinline__ int rel_bucket_dev(int n) {
    if (n < 16) return n < 0 ? 0 : n;
    int b = 16;
    b += (n >= 21); b += (n >= 27); b += (n >= 35); b += (n >= 46); b += (n >= 59); b += (n >= 77); b += (n >= 99); b += (n >= 128);
    b += (n >= 166); b += (n >= 216); b += (n >= 280); b += (n >= 363); b += (n >= 470); b += (n >= 609); b += (n >= 790);
    return b;
}

struct ColSrc { const float* p; int ld; };
template <class F>
__device__ __forceinline__ void tr_item(const F& f, const float* kscale, bf16_t* WT, int K, int nblk, int item, LAS float* scr, int lane, const float* kfallback) {
    const int kb = item / nblk, nb = item % nblk, k0 = 64 * kb, n0 = 32 * nb;
    const ColSrc cs = f(n0 + (lane & 31));
    float tv[32];
    const float* lp = cs.p ? cs.p : kfallback; const float lmask = cs.p ? 1.0f : 0.0f;
#pragma unroll
    for (int i = 0; i < 32; ++i) { const int kk = 2 * i + (lane >> 5); tv[i] = lp[(size_t)(k0 + kk) * cs.ld]; }
#pragma unroll
    for (int i = 0; i < 32; ++i) tv[i] *= lmask;
    if (kscale) {
#pragma unroll
        for (int i = 0; i < 32; ++i) tv[i] *= kscale[k0 + 2 * i + (lane >> 5)]; }
#pragma unroll
    for (int i = 0; i < 32; ++i) scr[(2 * i + (lane >> 5)) * 33 + (lane & 31)] = tv[i];
    asm volatile("s_waitcnt lgkmcnt(0)" ::: "memory");
    const int c = lane & 7;
#pragma unroll
    for (int j = 0; j < 4; ++j) { const int n = (lane >> 3) + 8 * j; const LAS float* s = scr + (8 * c) * 33 + n;
        u32x4 o; o.x = cvtpk(s[0 * 33], s[1 * 33]); o.y = cvtpk(s[2 * 33], s[3 * 33]); o.z = cvtpk(s[4 * 33], s[5 * 33]); o.w = cvtpk(s[6 * 33], s[7 * 33]);
        *(u32x4*)(WT + (size_t)(n0 + n) * K + k0 + 8 * c) = o; }
    asm volatile("s_waitcnt lgkmcnt(0)" ::: "memory");
}
__device__ __forceinline__ int proj_src_col(int n) {
    if (n < 2048) return n;
    if (n < 2560) return 2056 + (n - 2048);
    if (n < 3328) return 2568 + (n - 2560);
    if (n < 5376) return 3360 + (n - 3328);
    const int x = n - 5376;
    if (x < 8) return 2048 + x;
    if (x < 32) return 3336 + (x - 8);
    return -1;
}
struct SrcW1 { const float* w; __device__ ColSrc operator()(int n) const { const int c = proj_src_col(n); return ColSrc{c >= 0 ? w + c : nullptr, D_IN}; } };
struct SrcGU { const float* wg; const float* wu; __device__ ColSrc operator()(int n) const { const int G = n >> 4; const uintptr_t pg = (uintptr_t)wg, pu = (uintptr_t)wu; const uintptr_t sel = pg ^ ((pg ^ pu) & (uintptr_t)(0 - (long long)(G & 1)));
    return ColSrc{(const float*)sel + 16 * (G >> 1) + (n & 15), D_FF}; } };
struct SrcPlain { const float* w; int ld; __device__ ColSrc operator()(int n) const { return ColSrc{w + n, ld}; } };
struct SrcBr { const float* w; __device__ ColSrc operator()(int n) const { return ColSrc{w + (size_t)(n >> 10) * 512 * 1024 + (n & 1023), 1024}; } };
struct SrcC1 { const float* w; __device__ ColSrc operator()(int n) const { const int j = n >> 8, q = n & 255; return ColSrc{w + (size_t)j * 2048 * 128 + (q >= 128 ? 1024 * 128 : 0) + (q & 127), 128}; } };
struct SrcC2 { const float* w; __device__ ColSrc operator()(int n) const { return ColSrc{w + (size_t)(n >> 6) * 128 * 64 + (n & 63), 64}; } };

__device__ __forceinline__ void p0_prologue(const Args& a, LAS unsigned char* lds, int vcu, int G, int wave, int lane) {
    unsigned char* ws = a.ws;
    LAS float* scr = (LAS float*)(lds + wave * 16384);
    const int gw = vcu * NWAVES + wave, NGW = G * NWAVES;
    constexpr int I_W1 = (1024 / 64) * (N1 / 32), I_GU = (1024 / 64) * (NGU / 32), I_DN = (D_FF / 64) * (1024 / 32), I_OUT = 16 * 32, I_BR = (512 / 64) * (2048 / 32), I_C1 = 16 * (512 / 32), I_C2 = 2 * (128 / 32);
    constexpr int I_PEB = 256, I_BIAS = N1 / 64, I_BT = 8 * (BIAS_LEN / 64);
    constexpr int NITEMS = I_W1 + I_GU + I_DN + I_OUT + I_BR + I_C1 + I_C2 + I_PEB + I_BIAS + I_BT;
    if (blockIdx.x == 0 && threadIdx.x < 64) ((unsigned*)(ws + WS_CTL))[threadIdx.x] = 0u;
    for (int it = gw; it < NITEMS; it += NGW) {
        int r = it;
        if (r < I_W1) { tr_item(SrcW1{a.w_in}, a.g_norm_mix, (bf16_t*)(ws + WS_W1T), 1024, N1 / 32, r, scr, lane, a.w_in); continue; } r -= I_W1;
        if (r < I_GU) { tr_item(SrcGU{a.w_gate, a.w_up}, a.g_norm_ffn, (bf16_t*)(ws + WS_WGUT), 1024, NGU / 32, r, scr, lane, a.w_gate); continue; } r -= I_GU;
        if (r < I_DN) { tr_item(SrcPlain{a.w_down, 1024}, nullptr, (bf16_t*)(ws + WS_WDNT), D_FF, 1024 / 32, r, scr, lane, a.w_down); continue; } r -= I_DN;
        if (r < I_OUT) { tr_item(SrcPlain{a.w_out, 1024}, nullptr, (bf16_t*)(ws + WS_WOUTT), 1024, 1024 / 32, r, scr, lane, a.w_out); continue; } r -= I_OUT;
        if (r < I_BR) { tr_item(SrcBr{a.w_branch}, nullptr, (bf16_t*)(ws + WS_WBRT), 512, 2048 / 32, r, scr, lane, a.w_branch); continue; } r -= I_BR;
        if (r < I_C1) { tr_item(SrcC1{a.w_cmp1}, nullptr, (bf16_t*)(ws + WS_WC1T), 1024, 512 / 32, r, scr, lane, a.w_cmp1); continue; } r -= I_C1;
        if (r < I_C2) { tr_item(SrcC2{a.w_cmp2}, nullptr, (bf16_t*)(ws + WS_WC2T), 128, 128 / 32, r, scr, lane, a.w_cmp2); continue; } r -= I_C2;
        if (r < I_PEB) {
            const int j = r >> 7, n = r & 127; const float* pe = a.pe_cmp + j * 2048; const float* w = a.w_cmp1 + (size_t)j * 2048 * 128 + n; float s = 0.f;
#pragma unroll 8
            for (int i = 0; i < 32; ++i) { const int k = i * 64 + lane; s += pe[k] * w[(size_t)k * 128]; }
            s = wave_sum(s); if (lane == 0) __hip_atomic_store((float*)(ws + WS_PEB) + r, s, __ATOMIC_RELAXED, __HIP_MEMORY_SCOPE_AGENT); continue; } r -= I_PEB;
        if (r < I_BIAS) { const int n = r * 64 + lane; const int c = proj_src_col(n); ((float*)(ws + WS_BIAS1))[n] = c >= 0 ? a.b_in[c] : 0.f; continue; } r -= I_BIAS;
        { const int h = r / (BIAS_LEN / 64), idx = (r % (BIAS_LEN / 64)) * 64 + lane;
          ((float*)(ws + WS_BTAB))[h * BIAS_LEN + idx] = a.rel_bias[rel_bucket_dev(SEQ - 1 - idx) * N_HEADS + h] * 1.4426950408889634f; }
    }
    bf16_t* xb = (bf16_t*)(ws + WS_XB); float* rsx = (float*)(ws + WS_RSX);
    for (int blk = gw; blk < MTOK / 16; blk += NGW) {
        float myrs = 0.f;
#pragma unroll 1
        for (int k4 = 0; k4 < 16; k4 += 4) {
            f32x4 v[4][4]; float s[4];
#pragma unroll
            for (int r = 0; r < 4; ++r) { const f32x4* xr = (const f32x4*)(a.x + (size_t)(blk * 16 + k4 + r) * 1024) + lane;
#pragma unroll
                for (int j = 0; j < 4; ++j) v[r][j] = xr[64 * j]; }
#pragma unroll
            for (int r = 0; r < 4; ++r) { float t = 0.f;
#pragma unroll
                for (int j = 0; j < 4; ++j) t += (v[r][j][0] * v[r][j][0] + v[r][j][1] * v[r][j][1]) + (v[r][j][2] * v[r][j][2] + v[r][j][3] * v[r][j][3]);
                s[r] = wave_sum(t);
                u32x2* o = (u32x2*)(xb + (size_t)(blk * 16 + k4 + r) * 1024) + lane;
#pragma unroll
                for (int j = 0; j < 4; ++j) { u32x2 w; w.x = cvtpk(v[r][j][0], v[r][j][1]); w.y = cvtpk(v[r][j][2], v[r][j][3]); o[64 * j] = w; }
                if (lane == k4 + r) myrs = rsqrtf(s[r] * (1.0f / 1024.0f) + RMS_EPS); }
        }
        if (lane < 16) rsx[blk * 16 + lane] = myrs;
    }
}

__device__ __forceinline__ void p8_final(const Args& a, int vcu, int G, int wave, int lane) {
    const float* part = (const float*)(a.ws + WS_PART2);
    const int gw = vcu * NWAVES + wave, NGW = G * NWAVES;
    f32x4 gv[4];
#pragma unroll
    for (int j = 0; j < 4; ++j) gv[j] = ((const f32x4*)a.g_final)[lane + 64 * j];
    for (int m = gw; m < MTOK; m += NGW) {
        float p = (lane < 16) ? part[((size_t)(lane >> 2) * MTOK + m) * 4 + (lane & 3)] : 0.f;
        p += __shfl_xor(p, 1); p += __shfl_xor(p, 2); p += __shfl_xor(p, 4); p += __shfl_xor(p, 8);
        const float rs = rsqrtf(__shfl(p, 0) * (1.0f / 1024.0f) + RMS_EPS);
        f32x4* xr = (f32x4*)(a.out + (size_t)m * 1024) + lane;
#pragma unroll
        for (int j = 0; j < 4; ++j) xr[64 * j] = xr[64 * j] * rs * gv[j];
    }
}

__device__ __forceinline__ int kpos16(int key) { return (key & ~12) | ((key & 4) << 1) | ((key & 8) >> 1); }
__device__ __forceinline__ float siluf_(float x) { return x * sigmoidf_(x); }

__device__ __forceinline__ void p2_conv_item(const Args& a, int item, int tid) {
    const bf16_t* qk = (const bf16_t*)(a.ws + WS_QK); bf16_t* qc = (bf16_t*)(a.ws + WS_XB);
    const int cg8 = tid & 127, tg = tid >> 7, ch = cg8 * 8, row0 = item * 32 + tg * 8, tl0 = row0 & (SEQ - 1);
    float w[4][8];
#pragma unroll
    for (int j = 0; j < 4; ++j) { const f32x4 w0 = *(const f32x4*)(a.conv_qk + j * 1024 + ch), w1 = *(const f32x4*)(a.conv_qk + j * 1024 + ch + 4);
        w[j][0] = w0[0]; w[j][1] = w0[1]; w[j][2] = w0[2]; w[j][3] = w0[3]; w[j][4] = w1[0]; w[j][5] = w1[1]; w[j][6] = w1[2]; w[j][7] = w1[3]; }
    const float osc = (ch >= 512) ? 0.08838834764831845f : 1.0f;
    float xw[3][8];
#pragma unroll
    for (int k = 0; k < 3; ++k) { const int tl = tl0 - 3 + k; u32x4 v = (u32x4){0u, 0u, 0u, 0u}; if (tl >= 0) v = *(const u32x4*)(qk + (size_t)(row0 - 3 + k) * 1024 + ch);
        xw[k][0] = bflo(v.x); xw[k][1] = bfhi(v.x); xw[k][2] = bflo(v.y); xw[k][3] = bfhi(v.y); xw[k][4] = bflo(v.z); xw[k][5] = bfhi(v.z); xw[k][6] = bflo(v.w); xw[k][7] = bfhi(v.w); }
#pragma unroll
    for (int t = 0; t < 8; ++t) {
        const u32x4 v = *(const u32x4*)(qk + (size_t)(row0 + t) * 1024 + ch);
        float x[8] = {bflo(v.x), bfhi(v.x), bflo(v.y), bfhi(v.y), bflo(v.z), bfhi(v.z), bflo(v.w), bfhi(v.w)}; float y[8];
#pragma unroll
        for (int e = 0; e < 8; ++e) { const float s = w[0][e] * xw[0][e] + w[1][e] * xw[1][e] + w[2][e] * xw[2][e] + w[3][e] * x[e]; y[e] = siluf_(s) * osc; xw[0][e] = xw[1][e]; xw[1][e] = xw[2][e]; xw[2][e] = x[e]; }
        u32x4 o; o.x = cvtpk(y[0], y[1]); o.y = cvtpk(y[2], y[3]); o.z = cvtpk(y[4], y[5]); o.w = cvtpk(y[6], y[7]);
        *(u32x4*)(qc + (size_t)(row0 + t) * 1024 + ch) = o;
    }
}
__device__ __forceinline__ void p2_vt_item(const Args& a, int it, LAS unsigned char* scr, int lane) {
    const int which = it >> 10, rem = it & 1023, bg = rem >> 5, blk = rem & 31, b = bg >> 1, g = bg & 1;
    const bf16_t* src = (const bf16_t*)(a.ws + WS_NKV) + ((size_t)((which ? 10 : 6) + g) * MTOK + (size_t)b * SEQ + blk * 64) * 64;
    bf16_t* dst = (bf16_t*)(a.ws + (which ? WS_VWT : WS_VST)) + (size_t)(bg * 32 + blk) * 4096;
    LAS unsigned short* s = (LAS unsigned short*)scr;
#pragma unroll
    for (int i = 0; i < 8; ++i) { const int key = i * 8 + (lane >> 3), c = lane & 7; const u32x4 v = *(const u32x4*)(src + key * 64 + c * 8); const int p = (key & ~15) | kpos16(key & 15);
        s[(c * 8 + 0) * 72 + p] = (unsigned short)(v.x & 0xffff); s[(c * 8 + 1) * 72 + p] = (unsigned short)(v.x >> 16); s[(c * 8 + 2) * 72 + p] = (unsigned short)(v.y & 0xffff); s[(c * 8 + 3) * 72 + p] = (unsigned short)(v.y >> 16);
        s[(c * 8 + 4) * 72 + p] = (unsigned short)(v.z & 0xffff); s[(c * 8 + 5) * 72 + p] = (unsigned short)(v.z >> 16); s[(c * 8 + 6) * 72 + p] = (unsigned short)(v.w & 0xffff); s[(c * 8 + 7) * 72 + p] = (unsigned short)(v.w >> 16); }
    asm volatile("s_waitcnt lgkmcnt(0)" ::: "memory");
#pragma unroll
    for (int i = 0; i < 8; ++i) { const int d = i * 8 + (lane >> 3), c = lane & 7; *(u32x4*)(dst + d * 64 + c * 8) = *(const LAS u32x4*)(scr + d * 144 + c * 16); }
    asm volatile("s_waitcnt lgkmcnt(0)" ::: "memory");
}
struct CmpOrder {
    int c; const char* A; const char* B;
    __device__ __forceinline__ bool next(int i, pg8::Unit& u) const { if (i != 0 || c >= 32) return false; u.pm = c & 7; u.pn = c >> 3; u.seg = 0; u.A = A + (size_t)(c >> 3) * MTOK * 64 * 2 + (size_t)(c & 7) * 256 * 1024 * 2; u.B = B + (size_t)(c >> 4) * 256 * 1024 * 2; return true; }
    __device__ __forceinline__ bool carry(const pg8::Unit&) const { return false; }
};
struct EpiCmp {
    static constexpr bool AFTER_DRAIN = true;
    const float* peb; const bf16_t* wc2t; bf16_t* kc; bf16_t* vct;
    __device__ __forceinline__ void operator()(acc_t&, const pg8::Unit&, int, int, int, int) const {}
    __device__ __forceinline__ void fused(acc_t& acc, const pg8::Unit& u, int wr, int wc, int fr, int fq, LAS unsigned char* lds, int wid, int lane) const {
        const int p = u.pn, jj = p >> 1, g = p & 1;
        LAS float* hb = (LAS float*)lds;
#pragma unroll
        for (int ai = 0; ai < 2; ++ai)
#pragma unroll
            for (int m = 0; m < 4; ++m) { const int r = ai * 128 + wr * 64 + m * 16 + fr;
#pragma unroll
                for (int n = 0; n < 2; ++n) { const int cu = (32 * wc + 16 * n + 4 * fq) >> 2; *(LAS f32x4*)(hb + r * 128 + ((cu ^ (r & 15)) << 2)) = acc[ai][1][m][n]; } }
        asm volatile("s_waitcnt lgkmcnt(0)" ::: "memory"); __builtin_amdgcn_s_barrier(); asm volatile("" ::: "memory");
#pragma unroll
        for (int ai = 0; ai < 2; ++ai)
#pragma unroll
            for (int m = 0; m < 4; ++m) { const int r = ai * 128 + wr * 64 + m * 16 + fr, r1 = (r + 1) & 255;
#pragma unroll
                for (int n = 0; n < 2; ++n) { const int col = 32 * wc + 16 * n + 4 * fq, cu = col >> 2;
                    const f32x4 bt = *(const LAS f32x4*)(hb + r1 * 128 + ((cu ^ (r1 & 15)) << 2)); const f32x4 pb = *(const f32x4*)(peb + jj * 128 + col);
                    f32x4 v = acc[ai][0][m][n] + bt + pb; v[0] = siluf_(v[0]); v[1] = siluf_(v[1]); v[2] = siluf_(v[2]); v[3] = siluf_(v[3]); acc[ai][0][m][n] = v; } }
        asm volatile("s_waitcnt lgkmcnt(0)" ::: "memory"); __builtin_amdgcn_s_barrier(); asm volatile("" ::: "memory");
#pragma unroll
        for (int ai = 0; ai < 2; ++ai)
#pragma unroll
            for (int m = 0; m < 4; ++m) { const int r = ai * 128 + wr * 64 + m * 16 + fr;
#pragma unroll
                for (int n = 0; n < 2; ++n) { const int col = 32 * wc + 16 * n + 4 * fq; const f32x4 v = acc[ai][0][m][n]; u32x2 w; w.x = cvtpk(v[0], v[1]); w.y = cvtpk(v[2], v[3]); *(LAS u32x2*)(lds + r * 272 + col * 2) = w; } }
        asm volatile("s_waitcnt lgkmcnt(0)" ::: "memory"); __builtin_amdgcn_s_barrier(); asm volatile("" ::: "memory");
        const bf16_t* w2 = wc2t + jj * 64 * 128;
        bf16x8 wf[4][4];
#pragma unroll
        for (int dt = 0; dt < 4; ++dt)
#pragma unroll
            for (int s = 0; s < 4; ++s) wf[dt][s] = *(const bf16x8*)(w2 + (dt * 16 + fr) * 128 + 32 * s + 8 * fq);
#pragma unroll
        for (int rt = 0; rt < 2; ++rt) {
            const int r = wid * 32 + rt * 16 + fr; bf16x8 hf[4];
#pragma unroll
            for (int s = 0; s < 4; ++s) hf[s] = *(const LAS bf16x8*)(lds + r * 272 + (32 * s + 8 * fq) * 2);
            const int crow = u.pm * 256 + r, b = crow >> 7, c = crow & 127; const bool zero = (c == 127);
#pragma unroll
            for (int dt = 0; dt < 4; ++dt) { f32x4 o = {0.f, 0.f, 0.f, 0.f};
#pragma unroll
                for (int s = 0; s < 4; ++s) o = __builtin_amdgcn_mfma_f32_16x16x32_bf16(wf[dt][s], hf[s], o, 0, 0, 0);
                if (zero) o = (f32x4){0.f, 0.f, 0.f, 0.f};
                const int dd = dt * 16 + 4 * fq;
                if (jj == 0) { u32x2 w; w.x = cvtpk(o[0], o[1]); w.y = cvtpk(o[2], o[3]); *(u32x2*)(kc + ((size_t)(b * 2 + g) * 128 + c) * 64 + dd) = w; }
                else { bf16_t* vb = vct + ((size_t)(b * 2 + g) * 2 + (c >> 6)) * 4096 + ((c & 48) | kpos16(c & 15));
#pragma unroll
                    for (int e = 0; e < 4; ++e) vb[(dd + e) * 64] = (bf16_t)(cvtpk(o[e], 0.f) & 0xffff); } }
        }
    }
};
__device__ __forceinline__ void p2_prep(const Args& a, LAS unsigned char* lds, int bx, int G, int wave, int lane) {
    unsigned char* ws = a.ws;
    {
        CmpOrder S{bx, (const char*)(ws + WS_NKV), (const char*)(ws + WS_WC1T)};
        EpiCmp E{(const float*)(ws + WS_PEB), (const bf16_t*)(ws + WS_WC2T), (bf16_t*)(ws + WS_KC), (bf16_t*)(ws + WS_VCT)};
        pg8::gemm_phase<EpiCmp, CmpOrder, false>(lds, pg8::Dims{1024, 1024, 16}, S, E);
        __syncthreads();
    }
    for (int it = bx; it < MTOK / 32; it += G) p2_conv_item(a, it, threadIdx.x);
    for (int it = bx * NWAVES + wave; it < 2048; it += G * NWAVES) p2_vt_item(a, it, lds + wave * 16384, lane);
}

__device__ __forceinline__ int jpos32(int jj) { return ((jj & 12) << 1) | ((jj & 16) >> 2) | (jj & 3); }
__device__ __forceinline__ float logsigf_(float x) { return fminf(x, 0.f) - log1pf(__expf(-fabsf(x))); }
constexpr int ML_KS = 0, ML_VTS = 34816, ML_CS = 69632, ML_GV = 108800, ML_PM = ML_GV + 8192, ML_BC = ML_PM + 8192, ML_GH = ML_BC + 8192, ML_SCB = ML_GH + 512, ML_END = ML_SCB + 128;
static_assert(ML_END <= 140 * 1024, "mLSTM LDS map");
__device__ __forceinline__ void mlstm_item(const Args& a, LAS unsigned char* lds, int b, int h, int tid, int wave, int lane) {
    const bf16_t* qc = (const bf16_t*)(a.ws + WS_XB); const bf16_t* vo = (const bf16_t*)(a.ws + WS_VO); const float* sm = (const float*)(a.ws + WS_SM); bf16_t* ys = (bf16_t*)(a.ws + WS_QK);
    asm volatile("" : "+v"(tid), "+v"(lane));
    const int w = wave, fr = lane & 15, g = lane >> 4;
    LAS float* GV = (LAS float*)(lds + ML_GV); LAS float* PM = (LAS float*)(lds + ML_PM); LAS float* BC = (LAS float*)(lds + ML_BC); LAS float* GH = (LAS float*)(lds + ML_GH); LAS float* SCB = (LAS float*)(lds + ML_SCB);
    {
        const float bfg = a.b_fgate[h];
#pragma unroll 1
        for (int cc = 0; cc < 2; ++cc) {
            const int c = 2 * w + cc, r0 = b * SEQ + c * M_CHUNK, j0 = 2 * lane, j1 = j0 + 1;
            const float ip0 = sm[(size_t)(r0 + j0) * 32 + h], ip1 = sm[(size_t)(r0 + j1) * 32 + h];
            const float lf0 = logsigf_(sm[(size_t)(r0 + j0) * 32 + 4 + h] + bfg), lf1 = logsigf_(sm[(size_t)(r0 + j1) * 32 + 4 + h] + bfg);
            float s = lf0 + lf1;
#pragma unroll
            for (int o = 1; o < 64; o <<= 1) { const float t = __shfl_up(s, o); if (lane >= o) s += t; }
            const float bc1 = s, bc0 = s - lf1, gv0 = ip0 - bc0, gv1 = ip1 - bc1;
            float pm = fmaxf(gv0, gv1);
#pragma unroll
            for (int o = 1; o < 64; o <<= 1) { const float t = __shfl_up(pm, o); if (lane >= o) pm = fmaxf(pm, t); }
            float ex = __shfl_up(pm, 1); if (lane == 0) ex = -INFINITY;
            GV[c * 128 + j0] = gv0; GV[c * 128 + j1] = gv1; PM[c * 128 + j0] = fmaxf(ex, gv0); PM[c * 128 + j1] = pm; BC[c * 128 + j0] = bc0; BC[c * 128 + j1] = bc1;
            if (lane == 63) { SCB[2 * c] = bc1; SCB[2 * c + 1] = pm; }
        }
        if (tid < 128) GH[tid] = a.g_mlstm_head[h * 128 + tid];
    }
    float m_prev = 0.f;
    f32x4 ct[9];
#pragma unroll
    for (int vt = 0; vt < 9; ++vt) ct[vt] = (f32x4){0.f, 0.f, 0.f, 0.f};
    bf16x8 ones; { const short o = (fr == 0) ? (short)0x3F80 : (short)0; ones = (bf16x8){o, o, o, o, o, o, o, o}; }
    u32x4 kreg[4], vreg[4]; bf16x8 qf[4];
    const int pj = tid >> 4, pch = tid & 15;
#define ML_PREFETCH(c_) do { const int r0_ = b * SEQ + (c_) * M_CHUNK; \
        _Pragma("unroll") for (int i = 0; i < 4; ++i) { kreg[i] = *(const u32x4*)(qc + (size_t)(r0_ + pj + 32 * i) * 1024 + 512 + h * 128 + pch * 8); vreg[i] = *(const u32x4*)(vo + (size_t)(r0_ + pj + 32 * i) * 1024 + h * 128 + pch * 8); } } while (0)
#define ML_PREFETCH_Q(c_) do { const int r0_ = b * SEQ + (c_) * M_CHUNK; \
        _Pragma("unroll") for (int s = 0; s < 4; ++s) qf[s] = *(const bf16x8*)(qc + (size_t)(r0_ + 16 * w + fr) * 1024 + h * 128 + 32 * s + 8 * g); } while (0)
    ML_PREFETCH(0); ML_PREFETCH_Q(0);
    for (int c = 0; c < NCHUNK; ++c) {
        const int r0 = b * SEQ + c * M_CHUNK, irow = r0 + 16 * w + fr;
#pragma unroll
        for (int i = 0; i < 4; ++i) { const int j = pj + 32 * i;
            *(LAS u32x4*)(lds + ML_KS + j * 272 + pch * 16) = kreg[i];
            const u32x4 v = vreg[i]; const int p = (j & ~31) | jpos32(j & 31);
            LAS unsigned short* d = (LAS unsigned short*)(lds + ML_VTS + (pch * 8) * 272 + p * 2);
            d[0 * 136] = (unsigned short)(v.x & 0xffff); d[1 * 136] = (unsigned short)(v.x >> 16); d[2 * 136] = (unsigned short)(v.y & 0xffff); d[3 * 136] = (unsigned short)(v.y >> 16);
            d[4 * 136] = (unsigned short)(v.z & 0xffff); d[5 * 136] = (unsigned short)(v.z >> 16); d[6 * 136] = (unsigned short)(v.w & 0xffff); d[7 * 136] = (unsigned short)(v.w >> 16); }
#pragma unroll
        for (int vt = 0; vt < 9; ++vt)
#pragma unroll
            for (int r = 0; r < 4; ++r) *(LAS unsigned short*)(lds + ML_CS + (16 * vt + 4 * g + r) * 272 + (16 * w + fr) * 2) = (unsigned short)(cvtpk(ct[vt][r], 0.f) & 0xffff);
        __syncthreads();
        if (c + 1 < NCHUNK) ML_PREFETCH(c + 1);
        const float Ml = fmaxf(SCB[2 * c + 1], m_prev), m_new = SCB[2 * c] + Ml, decay = __expf(m_prev - Ml);
        const float Mi = fmaxf(PM[c * 128 + 16 * w + fr], m_prev), bci = BC[c * 128 + 16 * w + fr];
        const float sint = __expf(m_prev - Mi);
        unsigned pk[8][2];
#pragma unroll
        for (int jt = 0; jt < 8; ++jt) {
            pk[jt][0] = 0u; pk[jt][1] = 0u;
            if (jt <= w) {
                f32x4 st = {0.f, 0.f, 0.f, 0.f};
#pragma unroll
                for (int s = 0; s < 4; ++s) st = __builtin_amdgcn_mfma_f32_16x16x32_bf16(*(const LAS bf16x8*)(lds + ML_KS + (16 * jt + fr) * 272 + (32 * s + 8 * g) * 2), qf[s], st, 0, 0, 0);
                const f32x4 gvv = *(const LAS f32x4*)(lds + ML_GV + (c * 128 + 16 * jt + 4 * g) * 4); float p[4];
#pragma unroll
                for (int r = 0; r < 4; ++r) { const bool ok = (jt < w) || (4 * g + r <= fr); p[r] = ok ? st[r] * __expf(gvv[r] - Mi) : 0.f; }
                pk[jt][0] = cvtpk(p[0], p[1]); pk[jt][1] = cvtpk(p[2], p[3]);
            }
        }
        u32x2 so[8];
#pragma unroll
        for (int vt = 0; vt < 8; ++vt) so[vt] = *(const u32x2*)(vo + (size_t)irow * 1024 + 512 + h * 128 + 16 * vt + 4 * g);
        f32x4 hacc[9];
#pragma unroll
        for (int vt = 0; vt < 9; ++vt) {
            f32x4 hh = {0.f, 0.f, 0.f, 0.f};
#pragma unroll
            for (int s = 0; s < 4; ++s) hh = __builtin_amdgcn_mfma_f32_16x16x32_bf16(*(const LAS bf16x8*)(lds + ML_CS + (16 * vt + fr) * 272 + (32 * s + 8 * g) * 2), qf[s], hh, 0, 0, 0);
            hh = hh * sint;
#pragma unroll
            for (int s = 0; s < 4; ++s) if (2 * s <= w) {
                const bf16x8 av = (vt < 8) ? *(const LAS bf16x8*)(lds + ML_VTS + (16 * vt + fr) * 272 + (32 * s + 8 * g) * 2) : ones;
                const u32x4 pb = {pk[2 * s][0], pk[2 * s][1], pk[2 * s + 1][0], pk[2 * s + 1][1]};
                hh = __builtin_amdgcn_mfma_f32_16x16x32_bf16(av, __builtin_bit_cast(bf16x8, pb), hh, 0, 0, 0); }
            hacc[vt] = hh;
            if (vt & 1) asm volatile("" ::: "memory");
        }
        if (c + 1 < NCHUNK) ML_PREFETCH_Q(c + 1);
        {
            const float den = __shfl(hacc[8][0], fr);
            const float inv = 1.0f / fmaxf(fabsf(den), __expf(-(bci + Mi)));
            float ss = 0.f;
#pragma unroll
            for (int vt = 0; vt < 8; ++vt) { hacc[vt] = hacc[vt] * inv; ss += (hacc[vt][0] * hacc[vt][0] + hacc[vt][1] * hacc[vt][1]) + (hacc[vt][2] * hacc[vt][2] + hacc[vt][3] * hacc[vt][3]); }
            ss += __shfl_xor(ss, 16); ss += __shfl_xor(ss, 32);
            const float rs = rsqrtf(ss * (1.0f / 128.0f) + RMS_EPS);
#pragma unroll
            for (int vt = 0; vt < 8; ++vt) { const int v0 = 16 * vt + 4 * g;
                const f32x4 gh = *(const LAS f32x4*)(lds + ML_GH + v0 * 4);
                const f32x4 y = {hacc[vt][0] * rs * gh[0] * bflo(so[vt].x), hacc[vt][1] * rs * gh[1] * bfhi(so[vt].x), hacc[vt][2] * rs * gh[2] * bflo(so[vt].y), hacc[vt][3] * rs * gh[3] * bfhi(so[vt].y)};
                u32x2 o; o.x = cvtpk(y[0], y[1]); o.y = cvtpk(y[2], y[3]); *(u32x2*)(ys + (size_t)irow * 1024 + h * 128 + v0) = o; }
        }
        {
            bf16x8 kb[4];
#pragma unroll
            for (int s = 0; s < 4; ++s) {
                const f32x4 g0 = *(const LAS f32x4*)(lds + ML_GV + (c * 128 + 32 * s + 4 * g) * 4), g1 = *(const LAS f32x4*)(lds + ML_GV + (c * 128 + 32 * s + 16 + 4 * g) * 4); float kv[8];
#pragma unroll
                for (int e = 0; e < 4; ++e) { kv[e] = bf2f(*(const LAS unsigned short*)(lds + ML_KS + (32 * s + 4 * g + e) * 272 + (16 * w + fr) * 2)) * __expf(g0[e] - Ml);
                    kv[4 + e] = bf2f(*(const LAS unsigned short*)(lds + ML_KS + (32 * s + 16 + 4 * g + e) * 272 + (16 * w + fr) * 2)) * __expf(g1[e] - Ml); }
                const u32x4 kk = {cvtpk(kv[0], kv[1]), cvtpk(kv[2], kv[3]), cvtpk(kv[4], kv[5]), cvtpk(kv[6], kv[7])}; kb[s] = __builtin_bit_cast(bf16x8, kk);
            }
#pragma unroll
            for (int vt = 0; vt < 9; ++vt) { f32x4 cc = ct[vt] * decay;
#pragma unroll
                for (int s = 0; s < 4; ++s) { const bf16x8 av = (vt < 8) ? *(const LAS bf16x8*)(lds + ML_VTS + (16 * vt + fr) * 272 + (32 * s + 8 * g) * 2) : ones;
                    cc = __builtin_amdgcn_mfma_f32_16x16x32_bf16(av, kb[s], cc, 0, 0, 0); }
                ct[vt] = cc;
                if (vt & 1) asm volatile("" ::: "memory"); }
            m_prev = m_new;
        }
        __syncthreads();
    }
#undef ML_PREFETCH
#undef ML_PREFETCH_Q
}

constexpr int NS_KB = 0, NS_VB = 18432, NS_BT = 36864, NS_IMP = NS_BT + 8 * BIAS_LEN * 4, NS_SEL = NS_IMP + 4 * 64 * 33 * 4, NS_END = NS_SEL + 256;
static_assert(NS_END <= 143 * 1024, "NSA LDS map");
constexpr float LOG2E = 1.4426950408889634f;
__device__ __forceinline__ int crow32(int r, int hi) { return (r & 3) + 8 * (r >> 2) + 4 * hi; }
__device__ __forceinline__ float ex2(float x) { return __builtin_amdgcn_exp2f(x); }

struct NsaState { float m, l; f32x16 o[2]; };
__device__ __forceinline__ void ns_reset(NsaState& s) { s.m = -1e30f; s.l = 0.f;
#pragma unroll
    for (int r = 0; r < 16; ++r) { s.o[0][r] = 0.f; s.o[1][r] = 0.f; } }

__device__ __forceinline__ void ns_qk(f32x16& s0, f32x16& s1, const LAS unsigned char* kb, const bf16x8* qf, int q, int hi) {
#pragma unroll
    for (int r = 0; r < 16; ++r) { s0[r] = 0.f; s1[r] = 0.f; }
#pragma unroll
    for (int ks = 0; ks < 4; ++ks) {
        const bf16x8 a0 = *(const LAS bf16x8*)(kb + q * 144 + ks * 32 + hi * 16), a1 = *(const LAS bf16x8*)(kb + (32 + q) * 144 + ks * 32 + hi * 16);
        s0 = __builtin_amdgcn_mfma_f32_32x32x16_bf16(a0, qf[ks], s0, 0, 0, 0); s1 = __builtin_amdgcn_mfma_f32_32x32x16_bf16(a1, qf[ks], s1, 0, 0, 0);
    }
}
__device__ __forceinline__ void ns_pv(f32x16* o, const f32x16& p0, const f32x16& p1, const LAS unsigned char* vb, int q, int hi, bool keep = true) {
    bf16x8 pf[4]; const unsigned km = keep ? 0xffffffffu : 0u;
#pragma unroll
    for (int h2 = 0; h2 < 2; ++h2) { const u32x4 a = {cvtpk(p0[8 * h2 + 0], p0[8 * h2 + 1]) & km, cvtpk(p0[8 * h2 + 2], p0[8 * h2 + 3]) & km, cvtpk(p0[8 * h2 + 4], p0[8 * h2 + 5]) & km, cvtpk(p0[8 * h2 + 6], p0[8 * h2 + 7]) & km};
        const u32x4 b = {cvtpk(p1[8 * h2 + 0], p1[8 * h2 + 1]) & km, cvtpk(p1[8 * h2 + 2], p1[8 * h2 + 3]) & km, cvtpk(p1[8 * h2 + 4], p1[8 * h2 + 5]) & km, cvtpk(p1[8 * h2 + 6], p1[8 * h2 + 7]) & km};
        pf[h2] = __builtin_bit_cast(bf16x8, a); pf[2 + h2] = __builtin_bit_cast(bf16x8, b); }
#pragma unroll
    for (int dt = 0; dt < 2; ++dt)
#pragma unroll
        for (int ks = 0; ks < 4; ++ks) o[dt] = __builtin_amdgcn_mfma_f32_32x32x16_bf16(*(const LAS bf16x8*)(vb + (32 * dt + q) * 144 + ks * 32 + hi * 16), pf[ks], o[dt], 0, 0, 0);
}
template <bool CAUSAL, bool WINLO, bool FAR, bool SEL>
__device__ __forceinline__ void ns_block(NsaState& st, const LAS unsigned char* kb, const LAS unsigned char* vb, const bf16x8* qf, const LAS float* bt, int dq, bool selbit, float cfar, int q, int hi) {
    f32x16 s0, s1; ns_qk(s0, s1, kb, qf, q, hi);
    const LAS float* bp = bt + (SEQ - 1 - dq + 4 * hi);
    const int dl = dq - 4 * hi;
    float mx = -INFINITY;
#pragma unroll
    for (int r = 0; r < 16; ++r) {
        const int kc = (r & 3) + 8 * (r >> 2);
        float x0 = FAR ? s0[r] * LOG2E + cfar : s0[r] * LOG2E + bp[kc], x1 = FAR ? s1[r] * LOG2E + cfar : s1[r] * LOG2E + bp[kc + 32];
        if (CAUSAL) { x0 = (dl >= kc) ? x0 : -INFINITY; x1 = (dl >= kc + 32) ? x1 : -INFINITY; }
        if (WINLO) { x0 = (dl < 512 + kc) ? x0 : -INFINITY; x1 = (dl < 512 + kc + 32) ? x1 : -INFINITY; }
        s0[r] = x0; s1[r] = x1; mx = fmaxf(mx, fmaxf(x0, x1));
    }
    if (SEL) mx = selbit ? mx : -INFINITY;
    mx = fmaxf(mx, __shfl_xor(mx, 32));
    const float mn = fmaxf(st.m, mx), sc = ex2(st.m - mn); st.m = mn;
    float ls = 0.f;
#pragma unroll
    for (int r = 0; r < 16; ++r) { s0[r] = ex2(s0[r] - mn); s1[r] = ex2(s1[r] - mn); ls += s0[r] + s1[r]; }
    if (SEL) ls = selbit ? ls : 0.f;
    st.l = st.l * sc + ls;
#pragma unroll
    for (int r = 0; r < 16; ++r) { st.o[0][r] *= sc; st.o[1][r] *= sc; }
    ns_pv(st.o, s0, s1, vb, q, hi, SEL ? selbit : true);
}
__device__ __forceinline__ void ns_finish(f32x16* out, NsaState& st, float gate) {
    const float lt = st.l + __shfl_xor(st.l, 32); const float f = gate / fmaxf(lt, 1e-30f);
#pragma unroll
    for (int r = 0; r < 16; ++r) { out[0][r] += st.o[0][r] * f; out[1][r] += st.o[1][r] * f; }
}
__device__ __forceinline__ void ns_load(u32x4& kr, u32x4& vr, const bf16_t* kblk, const bf16_t* vblk, int tid) { kr = *(const u32x4*)(kblk + tid * 8); vr = *(const u32x4*)(vblk + tid * 8); }
__device__ __forceinline__ void ns_store(LAS unsigned char* lds, int buf, const u32x4& kr, const u32x4& vr, int tid) {
    const int row = tid >> 3, c = tid & 7; *(LAS u32x4*)(lds + NS_KB + buf * 9216 + row * 144 + c * 16) = kr; *(LAS u32x4*)(lds + NS_VB + buf * 9216 + row * 144 + c * 16) = vr; }

__device__ __forceinline__ void nsa_unit(const Args& a, LAS unsigned char* lds, int b, int g, int qi, int& tab_ok, int tid, int wave, int lane) {
    unsigned char* ws = a.ws;
    asm volatile("" : "+v"(tid), "+v"(lane));
    const int q = lane & 31, hi = lane >> 5, r = wave >> 1, th = wave & 1, head = g * 4 + r;
    const int tl = 64 * qi + 32 * th + q, row = b * SEQ + tl;
    const bf16_t* nkv = (const bf16_t*)(ws + WS_NKV);
    if (!tab_ok) { __syncthreads(); const float* bt = (const float*)(ws + WS_BTAB);
#pragma unroll 1
        for (int i = tid; i < 8 * BIAS_LEN; i += NTHREADS) ((LAS float*)(lds + NS_BT))[i] = bt[i];
        tab_ok = 1; }
    const LAS float* btab = (const LAS float*)(lds + NS_BT) + head * BIAS_LEN;
    bf16x8 qf[4];
#pragma unroll
    for (int ks = 0; ks < 4; ++ks) qf[ks] = *(const bf16x8*)((const bf16_t*)(ws + WS_NQ) + (size_t)row * 512 + head * 64 + ks * 16 + hi * 8);
    const float* smr = (const float*)(ws + WS_SM) + (size_t)row * 32 + 8 + head * 3;
    const float gc = sigmoidf_(smr[0]), gs = sigmoidf_(smr[1]), gw = sigmoidf_(smr[2]);
    f32x16 out[2];
#pragma unroll
    for (int rr = 0; rr < 16; ++rr) { out[0][rr] = 0.f; out[1][rr] = 0.f; }
    NsaState st;
    u32x4 kr, vr;
    const int ncb = (qi >= 16) ? 2 : 1;
    {
        const bf16_t* kcb = (const bf16_t*)(ws + WS_KC) + (size_t)(b * 2 + g) * 128 * 64; const bf16_t* vcb = (const bf16_t*)(ws + WS_VCT) + (size_t)(b * 2 + g) * 2 * 4096;
        __syncthreads();
        ns_load(kr, vr, kcb, vcb, tid); ns_store(lds, 0, kr, vr, tid);
        if (ncb == 2) { ns_load(kr, vr, kcb + 4096, vcb + 4096, tid); ns_store(lds, 1, kr, vr, tid); }
        __syncthreads();
        f32x16 s[2][2];
        float mx = -INFINITY;
#pragma unroll
        for (int cb = 0; cb < 2; ++cb) {
            if (cb < ncb) {
                ns_qk(s[cb][0], s[cb][1], lds + NS_KB + cb * 9216, qf, q, hi);
#pragma unroll
                for (int T = 0; T < 2; ++T)
#pragma unroll
                    for (int rr = 0; rr < 16; ++rr) { const int c = 64 * cb + 32 * T + crow32(rr, hi), d = tl - 16 * c - 31;
                        const float x = s[cb][T][rr] * LOG2E + btab[min(SEQ - 1 - d, BIAS_LEN - 1)]; s[cb][T][rr] = (d >= 0) ? x : -INFINITY; mx = fmaxf(mx, s[cb][T][rr]); }
            } else {
#pragma unroll
                for (int rr = 0; rr < 16; ++rr) { s[cb][0][rr] = -INFINITY; s[cb][1][rr] = -INFINITY; }
            }
        }
        mx = fmaxf(fmaxf(mx, __shfl_xor(mx, 32)), -1e30f);
        float ls = 0.f;
#pragma unroll
        for (int cb = 0; cb < 2; ++cb)
#pragma unroll
            for (int T = 0; T < 2; ++T)
#pragma unroll
                for (int rr = 0; rr < 16; ++rr) { const float e = ex2(s[cb][T][rr] - mx); s[cb][T][rr] = e; ls += e; }
        ns_pv(out, s[0][0], s[0][1], lds + NS_VB, q, hi);
        if (ncb == 2) ns_pv(out, s[1][0], s[1][1], lds + NS_VB + 9216, q, hi);
        const float lt = ls + __shfl_xor(ls, 32), rinv = 1.0f / fmaxf(lt, 1e-30f);
        { const float f = gc * rinv;
#pragma unroll
          for (int rr = 0; rr < 16; ++rr) { out[0][rr] *= f; out[1][rr] *= f; } }
        if (qi >= 16) {
            LAS float* imp = (LAS float*)(lds + NS_IMP) + (r * 64 + 32 * th + q) * 33;
            float prevB = 0.f;
#pragma unroll
            for (int cb = 0; cb < 2; ++cb)
#pragma unroll
                for (int T = 0; T < 2; ++T)
#pragma unroll
                    for (int q4 = 0; q4 < 4; ++q4) { const int n = cb * 8 + T * 4 + q4; const float p0 = s[cb][T][4 * q4] * rinv, p1 = s[cb][T][4 * q4 + 1] * rinv, p2 = s[cb][T][4 * q4 + 2] * rinv, p3 = s[cb][T][4 * q4 + 3] * rinv;
                        const float An = 2.0f * (p0 + p1 + p2) + p3, pb = __shfl_xor(p3, 32);
                        imp[2 * n + hi] = hi ? (An + pb) : (An + prevB); prevB = pb; }
        }
        __syncthreads();
        if (qi >= 16) {
            const int tq = tid >> 3, sub = tid & 7; const LAS float* ip = (const LAS float*)(lds + NS_IMP) + tq * 33;
            float sc[32];
#pragma unroll
            for (int j = 0; j < 32; ++j) sc[j] = ((ip[j] + ip[64 * 33 + j]) + ip[2 * 64 * 33 + j]) + ip[3 * 64 * 33 + j];
            unsigned bits = 0u;
#pragma unroll
            for (int jj = 0; jj < 4; ++jj) { const int j = sub * 4 + jj; int rank = 0;
                const float mine = ((ip[j] + ip[64 * 33 + j]) + ip[2 * 64 * 33 + j]) + ip[3 * 64 * 33 + j];
#pragma unroll
                for (int j2 = 0; j2 < 32; ++j2) { const bool cand = (j2 >= 1 && j2 <= qi - 2); rank += (cand && (sc[j2] > mine || (sc[j2] == mine && j2 < j))) ? 1 : 0; }
                const bool forced = (j == 0) || (j == qi) || (j == qi - 1);
                if (forced || (j >= 1 && j <= qi - 2 && rank < SEL_TOPK - 3)) bits |= 1u << j; }
            bits |= __shfl_xor(bits, 1); bits |= __shfl_xor(bits, 2); bits |= __shfl_xor(bits, 4);
            if (sub == 0) ((LAS unsigned*)(lds + NS_SEL))[tq] = bits;
        } else if (tid < 64) ((LAS unsigned*)(lds + NS_SEL))[tid] = (qi >= 31) ? 0xffffffffu : ((2u << qi) - 1u);
        __syncthreads();
    }
    const unsigned selm = ((const LAS unsigned*)(lds + NS_SEL))[32 * th + q];
    const float cfar = btab[SEQ - 1 - 800];
    {
        const bf16_t* kb = nkv + ((size_t)(4 + g) * MTOK + (size_t)b * SEQ) * 64; const bf16_t* vb = (const bf16_t*)(ws + WS_VST) + (size_t)(b * 2 + g) * 32 * 4096;
        ns_reset(st);
        ns_load(kr, vr, kb, vb, tid);
        for (int j = 0; j <= qi; ++j) {
            ns_store(lds, j & 1, kr, vr, tid);
            __syncthreads();
            if (j < qi) ns_load(kr, vr, kb + (size_t)(j + 1) * 4096, vb + (size_t)(j + 1) * 4096, tid);
            const LAS unsigned char* kl = lds + NS_KB + (j & 1) * 9216; const LAS unsigned char* vl = lds + NS_VB + (j & 1) * 9216; const int dq = tl - 64 * j; const bool sb = (selm >> j) & 1u;
            if (j == qi) ns_block<true, false, false, false>(st, kl, vl, qf, btab, dq, true, cfar, q, hi);
            else if (qi - j >= 14) { if (j == 0) ns_block<false, false, true, false>(st, kl, vl, qf, btab, dq, true, cfar, q, hi); else ns_block<false, false, true, true>(st, kl, vl, qf, btab, dq, sb, cfar, q, hi); }
            else { if (j == 0 || j == qi - 1) ns_block<false, false, false, false>(st, kl, vl, qf, btab, dq, true, cfar, q, hi); else ns_block<false, false, false, true>(st, kl, vl, qf, btab, dq, sb, cfar, q, hi); }
        }
        ns_finish(out, st, gs);
    }
    {
        const bf16_t* kb = nkv + ((size_t)(8 + g) * MTOK + (size_t)b * SEQ) * 64; const bf16_t* vb = (const bf16_t*)(ws + WS_VWT) + (size_t)(b * 2 + g) * 32 * 4096;
        const int j0 = qi >= 8 ? qi - 8 : 0;
        ns_reset(st);
        __syncthreads();
        ns_load(kr, vr, kb + (size_t)j0 * 4096, vb + (size_t)j0 * 4096, tid);
        for (int j = j0; j <= qi; ++j) {
            ns_store(lds, j & 1, kr, vr, tid);
            __syncthreads();
            if (j < qi) ns_load(kr, vr, kb + (size_t)(j + 1) * 4096, vb + (size_t)(j + 1) * 4096, tid);
            const LAS unsigned char* kl = lds + NS_KB + (j & 1) * 9216; const LAS unsigned char* vl = lds + NS_VB + (j & 1) * 9216; const int dq = tl - 64 * j;
            if (j == qi) ns_block<true, false, false, false>(st, kl, vl, qf, btab, dq, true, cfar, q, hi);
            else if (qi - j == 8) ns_block<false, true, false, false>(st, kl, vl, qf, btab, dq, true, cfar, q, hi);
            else ns_block<false, false, false, false>(st, kl, vl, qf, btab, dq, true, cfar, q, hi);
        }
        ns_finish(out, st, gw);
    }
    bf16_t* yn = (bf16_t*)(ws + WS_QK) + (size_t)row * 1024 + 512 + head * 64;
#pragma unroll
    for (int dt = 0; dt < 2; ++dt)
#pragma unroll
        for (int q4 = 0; q4 < 4; ++q4) { u32x2 w; w.x = cvtpk(out[dt][4 * q4], out[dt][4 * q4 + 1]); w.y = cvtpk(out[dt][4 * q4 + 2], out[dt][4 * q4 + 3]); *(u32x2*)(yn + 32 * dt + 8 * q4 + 4 * hi) = w; }
}

__device__ __forceinline__ void p3_mixers(const Args& a, LAS unsigned char* lds, int tid, int wave, int lane, int cword = 0) {
    unsigned* ctr = (unsigned*)(a.ws + WS_CTL) + cword;
    LAS unsigned* slot = (LAS unsigned*)(lds + 143 * 1024);
    int cur_g = 0;
    for (int it_ = 0;; ++it_) {
        __syncthreads();
#ifdef DBG_STATIC_Q
        if (tid == 0) *slot = (unsigned)(blockIdx.x + it_ * gridDim.x);
#else
        if (tid == 0) *slot = atomicAdd(ctr, 1u);
#endif
        __syncthreads();
        const int idx = (int)*slot;
        if (idx >= 64 + 1024) break;
        if (idx < 64) {
#ifdef DBG_NO_ML
            { const int b = idx >> 2, h = idx & 3; bf16_t* ym = (bf16_t*)(a.ws + WS_QK) + (size_t)b * SEQ * 1024 + h * 128;
              for (int i = tid; i < SEQ * 16; i += NTHREADS) *(u32x4*)(ym + (size_t)(i >> 4) * 1024 + (i & 15) * 8) = (u32x4){0u, 0u, 0u, 0u}; }
#else
            mlstm_item(a, lds, idx >> 2, idx & 3, tid, wave, lane);
#endif
            cur_g = 0; }
        else { const int u = idx - 64;
#ifdef DBG_NO_NSA
            { const int b = (u & 31) >> 1, g = u & 1, qi = 31 - (u >> 5); bf16_t* yn = (bf16_t*)(a.ws + WS_QK) + ((size_t)b * SEQ + qi * 64) * 1024 + 512 + g * 256;
              for (int i = tid; i < 64 * 32; i += NTHREADS) *(u32x4*)(yn + (size_t)(i >> 5) * 1024 + (i & 31) * 8) = (u32x4){0u, 0u, 0u, 0u}; }
#else
            nsa_unit(a, lds, (u & 31) >> 1, u & 1, 31 - (u >> 5), cur_g, tid, wave, lane);
#endif
        }
    }
}

__global__ void __launch_bounds__(NTHREADS, 2) mega_fwd(Args a) {
    extern __shared__ __attribute__((aligned(16))) unsigned char lds_raw[];
    LAS unsigned char* lds = (LAS unsigned char*)lds_raw;
    const int tid = threadIdx.x, lane = tid & 63, wave = __builtin_amdgcn_readfirstlane(tid >> 6);
    const int G = gridDim.x; const int bx = blockIdx.x; const int vcu = (G % 8 == 0) ? (bx % 8) * (G / 8) + bx / 8 : bx;
    cg::grid_group grid = cg::this_grid();
    unsigned char* ws = a.ws;
    const int lo = a.ph_lo, hi = a.ph_hi;
#define IN(k) (lo <= (k) && (k) < hi)
#define FULLSYNC() do { asm volatile("s_waitcnt vmcnt(0) lgkmcnt(0)" ::: "memory"); grid.sync(); \
    if (tid < 64) { __builtin_amdgcn_fence(__ATOMIC_ACQUIRE, "agent"); asm volatile("s_waitcnt vmcnt(0)" ::: "memory"); } __syncthreads(); } while (0)
#define SEAM(k) do { if (IN(k) && IN((k) + 1)) FULLSYNC(); } while (0)

#define PH0() p0_prologue(a, lds, vcu, G, wave, lane)
#define PH1() do { pg8::StaticOrder S; S.init(ws + WS_XB, 1024, ws + WS_W1T, 1024, MTOK, N1, G, bx); \
        EpiProj E{(const float*)(ws + WS_RSX), (const float*)(ws + WS_BIAS1), ws}; \
        pg8::gemm_phase<EpiProj, pg8::StaticOrder, true>(lds, pg8::Dims{1024, 1024, 16}, S, E); } while (0)
#define PH2() p2_prep(a, lds, bx, G, wave, lane)
#define PH3() p3_mixers(a, lds, tid, wave, lane, 0)
#define PH4() do { pg8::DualOrder S; S.init(ws + WS_QK, 1024, ws + WS_WBRT, 512, MTOK, 1024, G, bx, (size_t)512 * 2, (size_t)1024 * 512 * 2); \
        EpiBranch E{(const bf16_t*)(ws + WS_GT), (bf16_t*)(ws + WS_VO)}; \
        pg8::gemm_phase<EpiBranch, pg8::DualOrder, true>(lds, pg8::Dims{1024, 512, 8}, S, E); } while (0)
#define PH5() do { pg8::StaticOrder S; S.init(ws + WS_VO, 1024, ws + WS_WOUTT, 1024, MTOK, 1024, G, bx); \
        EpiResid E{a.x, a.out, (bf16_t*)(ws + WS_XB), (float*)(ws + WS_PART1)}; \
        pg8::gemm_phase<EpiResid, pg8::StaticOrder, true>(lds, pg8::Dims{1024, 1024, 16}, S, E); } while (0)
#define PH6() do { pg8::StaticOrder S; S.init(ws + WS_XB, 1024, ws + WS_WGUT, 1024, MTOK, NGU, G, bx); \
        EpiGateUp E{(const float*)(ws + WS_PART1), (bf16_t*)(ws + WS_HID)}; \
        pg8::gemm_phase<EpiGateUp, pg8::StaticOrder, true>(lds, pg8::Dims{1024, 1024, 16}, S, E); } while (0)
#define PH7() do { pg8::StaticOrder S; S.init(ws + WS_HID, D_FF, ws + WS_WDNT, D_FF, MTOK, 1024, G, bx); \
        EpiResid E{a.out, a.out, nullptr, (float*)(ws + WS_PART2)}; \
        pg8::gemm_phase<EpiResid, pg8::StaticOrder, true>(lds, pg8::Dims{D_FF, D_FF, D_FF / 64}, S, E); } while (0)
#define PH8() p8_final(a, vcu, G, wave, lane)
#ifndef DUP_PHASE
#define DUP_PHASE -1
#endif
#define RUN(k, PH) do { if (IN(k)) { PH(); if (DUP_PHASE == (k)) { FULLSYNC(); if ((k) == 3) p3_mixers(a, lds, tid, wave, lane, 1); else PH(); } } } while (0)
    RUN(0, PH0); SEAM(0);
    RUN(1, PH1); SEAM(1);
    RUN(2, PH2); SEAM(2);
    RUN(3, PH3); SEAM(3);
    RUN(4, PH4); SEAM(4);
    RUN(5, PH5); SEAM(5);
    RUN(6, PH6); SEAM(6);
    RUN(7, PH7); SEAM(7);
    RUN(8, PH8);
#undef IN
#undef SEAM
}

constexpr int NPHASES = 9;
#ifndef N_LAUNCHES
#define N_LAUNCHES 1
#endif
extern "C" void kernel_launch(void* const* d_in, const int* in_sizes, int n_in, void* d_out, int out_size, void* d_ws, size_t ws_size, hipStream_t stream) {
    static int grid = 0;
    if (grid == 0) {
        if (n_in != 18 || out_size != MTOK * D_MODEL || ws_size < WS_END) { fprintf(stderr, "kernel_launch: unexpected shapes (n_in %d out %d ws %zu)\n", n_in, out_size, ws_size); grid = -1; return; }
        int dev = 0, cus = 0, per_cu = 0;
        if (hipGetDevice(&dev) != hipSuccess || hipDeviceGetAttribute(&cus, hipDeviceAttributeMultiprocessorCount, dev) != hipSuccess) { grid = -1; return; }
        if (hipFuncSetAttribute((const void*)mega_fwd, hipFuncAttributeMaxDynamicSharedMemorySize, LDS_BYTES) != hipSuccess) { fprintf(stderr, "kernel_launch: hipFuncSetAttribute failed\n"); grid = -1; return; }
        if (hipOccupancyMaxActiveBlocksPerMultiprocessor(&per_cu, (const void*)mega_fwd, NTHREADS, LDS_BYTES) != hipSuccess || per_cu < 1) { fprintf(stderr, "kernel_launch: occupancy query says %d blocks per CU\n", per_cu); per_cu = 1; }
        (void)hipGetLastError();
        grid = cus;
    }
    if (grid < 0) return;
    Args a{};
    const float** ap = (const float**)&a;
    for (int i = 0; i < 18; ++i) ap[i] = (const float*)d_in[i];
    a.out = (float*)d_out; a.ws = (unsigned char*)d_ws;
    if (N_LAUNCHES == 1) {
        a.ph_lo = 0; a.ph_hi = NPHASES; a.coop = 1; a.pad = 0;
        void* args[] = {&a};
        hipError_t e = hipLaunchCooperativeKernel((const void*)mega_fwd, dim3(grid), dim3(NTHREADS), args, LDS_BYTES, stream);
        if (e != hipSuccess) fprintf(stderr, "kernel_launch: cooperative launch failed: %s (grid %d)\n", hipGetErrorString(e), grid);
    } else {
        for (int p = 0; p < NPHASES; ++p) {
            a.ph_lo = p; a.ph_hi = p + 1; a.coop = 0; a.pad = 0;
            hipLaunchKernelGGL(mega_fwd, dim3(grid), dim3(NTHREADS), LDS_BYTES, stream, a);
        }
    }
}
```

```cpp
#include <hip/hip_runtime.h>
#include <hip/hip_cooperative_groups.h>
#include <cstdio>
#include <cstdint>
namespace cg = cooperative_groups;

#define LAS __attribute__((address_space(3)))
typedef unsigned short bf16_t;
typedef short bf16x8 __attribute__((ext_vector_type(8)));
typedef short s16x4 __attribute__((ext_vector_type(4)));
typedef float f32x4 __attribute__((ext_vector_type(4)));
typedef float f32x2 __attribute__((ext_vector_type(2)));
typedef float f32x16 __attribute__((ext_vector_type(16)));
typedef unsigned u32x4 __attribute__((ext_vector_type(4)));
typedef unsigned u32x2 __attribute__((ext_vector_type(2)));
typedef __bf16 bf16x2_t __attribute__((ext_vector_type(2)));

constexpr int D_MODEL = 1024, BATCH = 16, SEQ = 2048, MTOK = BATCH * SEQ;
constexpr int M_HEADS = 4, M_HD = 128, M_WIDTH = 512, M_CHUNK = 128, NCHUNK = SEQ / M_CHUNK;
constexpr int N_HEADS = 8, N_G = 2, N_R = 4, N_HD = 64;
constexpr int N_CMP = 127, N_SLC = 32, SEL_TOPK = 16;
constexpr int D_FF = 2816, D_IN = 5408;
constexpr int N1 = 5632;
constexpr int NGU = 2 * D_FF;
constexpr float RMS_EPS = 1e-6f;
constexpr int BIAS_PAD = 64, BIAS_LEN = SEQ + BIAS_PAD;

constexpr size_t KiB = 1024, MiB = 1u << 20;
constexpr size_t WS_CTL   = 0;
constexpr size_t WS_BIAS1 = 4 * KiB;
constexpr size_t WS_PEB   = 28 * KiB;
constexpr size_t WS_WC2T  = 32 * KiB;
constexpr size_t WS_BTAB  = 64 * KiB;
constexpr size_t WS_RSX   = 256 * KiB;
constexpr size_t WS_BAR   = 384 * KiB;
constexpr size_t WS_W1T   = 1 * MiB;
constexpr size_t WS_WGUT  = 12 * MiB;
constexpr size_t WS_WDNT  = 23 * MiB;
constexpr size_t WS_WOUTT = 29 * MiB;
constexpr size_t WS_WBRT  = 31 * MiB;
constexpr size_t WS_WC1T  = 33 * MiB;
constexpr size_t WS_PART1 = 34 * MiB;
constexpr size_t WS_PART2 = 36 * MiB;
constexpr size_t WS_KC    = 38 * MiB;
constexpr size_t WS_VCT   = 38 * MiB + 512 * KiB;
constexpr size_t WS_HAB   = 39 * MiB;
constexpr size_t WS_XB    = 48 * MiB;
constexpr size_t WS_QK    = 112 * MiB;
constexpr size_t WS_VO    = 176 * MiB;
constexpr size_t WS_NQ    = 240 * MiB;
constexpr size_t WS_NKV   = 272 * MiB;
constexpr size_t WS_HID   = 112 * MiB;
constexpr size_t WS_GT    = 320 * MiB;
constexpr size_t WS_SM    = 448 * MiB;
constexpr size_t WS_VST   = 452 * MiB;
constexpr size_t WS_VWT   = 460 * MiB;
constexpr size_t WS_END   = 468 * MiB;

__device__ __forceinline__ unsigned cvtpk(float lo, float hi) { f32x2 v = {lo, hi}; bf16x2_t b = __builtin_convertvector(v, bf16x2_t); return __builtin_bit_cast(unsigned, b); }
__device__ __forceinline__ float bf2f(unsigned short u) { return __uint_as_float(((unsigned)u) << 16); }
__device__ __forceinline__ float bflo(unsigned u) { return __uint_as_float(u << 16); }
__device__ __forceinline__ float bfhi(unsigned u) { return __uint_as_float(u & 0xffff0000u); }
__device__ __forceinline__ float sigmoidf_(float x) { return __builtin_amdgcn_rcpf(1.0f + __expf(-x)); }
__device__ __forceinline__ float wave_sum(float v) {
#pragma unroll
    for (int o = 1; o < 64; o <<= 1) v += __shfl_xor(v, o);
    return v;
}

namespace pg8 {
constexpr int BM = 256, BK = 64, HALF = 128, HTB = HALF * BK * 2  , STAGE_BYTES = 8 * HTB, NXCD = 8, WGM = 8;
__host__ __device__ __forceinline__ int lds_byte(int r, int c) { const int st = (r >> 4) * 2 + (c >> 5), rr = r & 15, cc = c & 31, ob = rr * 64 + cc * 2; return st * 1024 + (ob ^ (((ob >> 9) & 1) << 5)); }
__host__ __device__ __forceinline__ void stage_rc(int b, int& R, int& C) { const int st = b / 1024, sb = b % 1024, swz = sb ^ (((sb >> 9) & 1) << 5); R = (st >> 1) * 16 + swz / 64; C = (st & 1) * 32 + (swz % 64) / 2; }

struct Unit { int pm, pn, seg; const char* A; const char* B; };
struct Dims { int lda, ldb, nt; };

__device__ __forceinline__ void tile_of(int L, int nM, int nN, int& pm, int& pn) {
    const int nwg = nM * nN; int wgid = L; { const int q = nwg / NXCD, r = nwg % NXCD, xcd = wgid % NXCD, off = wgid / NXCD; wgid = (xcd < r ? xcd * (q + 1) : r * (q + 1) + (xcd - r) * q) + off; }
    const int nig = WGM * nN, gid = wgid / nig, fm = gid * WGM, gsz = (nM - fm) < WGM ? (nM - fm) : WGM;
    pm = fm + ((wgid % nig) % gsz); pn = (wgid % nig) / gsz;
}
struct StaticOrder {
    int nM, nN, nwg, G, c; const char* A; const char* B; size_t tstepA, tstepB;
    __device__ void init(const void* A_, int lda, const void* B_, int ldb, int M, int N, int G_, int c_) { nM = M / BM; nN = N / BM; nwg = nM * nN; G = G_; c = c_; A = (const char*)A_; B = (const char*)B_; tstepA = (size_t)BM * lda * 2; tstepB = (size_t)BM * ldb * 2; }
    __device__ __forceinline__ bool next(int i, Unit& u) const {
        const long L = (long)i * G + c; if (L >= nwg) return false;
        tile_of((int)L, nM, nN, u.pm, u.pn); u.seg = 0; u.A = A + (size_t)u.pm * tstepA; u.B = B + (size_t)u.pn * tstepB; return true;
    }
    __device__ __forceinline__ bool carry(const Unit&) const { return false; }
};
struct DualOrder {
    int nM, nN, nwg, G, c; const char* A; const char* B; size_t tstepA, tstepB, segA, segB;
    __device__ void init(const void* A_, int lda, const void* B_, int ldb, int M, int N, int G_, int c_, size_t segA_, size_t segB_) { nM = M / BM; nN = N / BM; nwg = nM * nN; G = G_; c = c_; A = (const char*)A_; B = (const char*)B_; tstepA = (size_t)BM * lda * 2; tstepB = (size_t)BM * ldb * 2; segA = segA_; segB = segB_; }
    __device__ __forceinline__ bool next(int i, Unit& u) const {
        const long L = (long)(i >> 1) * G + c; if (L >= nwg) return false;
        tile_of((int)L, nM, nN, u.pm, u.pn); u.seg = i & 1; u.A = A + (size_t)u.pm * tstepA + (size_t)u.seg * segA; u.B = B + (size_t)u.pn * tstepB + (size_t)u.seg * segB; return true;
    }
    __device__ __forceinline__ bool carry(const Unit& u) const { return u.seg == 0; }
};

template <class Epi, class Sched, bool ALIGN_EPI>
__device__ __forceinline__ void gemm_phase(LAS unsigned char* lds, const Dims g, const Sched& S, const Epi& E) {
    const int tid = threadIdx.x, wid = __builtin_amdgcn_readfirstlane(tid >> 6), lane = tid & 63, wr = wid >> 2, wc = wid & 3, fr = lane & 15, fq = lane >> 4;
    const int nt = g.nt;
    unsigned voffA[2], voffB[2];
#pragma unroll
    for (int i = 0; i < 2; ++i) { int R, C; stage_rc(tid * 16 + i * 8192, R, C); voffA[i] = (unsigned)(R * g.lda + C) * 2u; voffB[i] = (unsigned)(R * g.ldb + C) * 2u; }
    const size_t kstep = (size_t)(BK * 2);
    const size_t hstepA = (size_t)HALF * g.lda * 2, hstepB = (size_t)HALF * g.ldb * 2;
    const unsigned ldsw = (unsigned)wid * 1024u;
    const int aoff = lds_byte(wr * 64 + fr, fq * 8), boff = lds_byte(wc * 32 + fr, fq * 8);
#define PG8_SA(b, h) (((b) * 2 + (h)) * HTB)
#define PG8_SB(b, h) ((4 + (b) * 2 + (h)) * HTB)
#define PG8_STAGE(bufoff, gbase, voff) do { _Pragma("unroll") for (int _i = 0; _i < 2; ++_i) \
        __builtin_amdgcn_global_load_lds((const unsigned*)((const char*)(gbase) + (voff)[_i]), (LAS unsigned*)(lds + (bufoff) + ldsw + _i * 8192), 16, 0, 0); } while (0)
#define PG8_LDA(dst, b, h) do { _Pragma("unroll") for (int m = 0; m < 4; ++m) _Pragma("unroll") for (int k = 0; k < 2; ++k) dst[m][k] = *(const LAS bf16x8*)(lds + PG8_SA(b, h) + aoff + m * 2048 + k * 1024); } while (0)
#define PG8_LDB(dst, b, h) do { _Pragma("unroll") for (int n = 0; n < 2; ++n) _Pragma("unroll") for (int k = 0; k < 2; ++k) dst[n][k] = *(const LAS bf16x8*)(lds + PG8_SB(b, h) + boff + n * 2048 + k * 1024); } while (0)
#define PG8_MMA(ai, bj, At, Bt) do { __builtin_amdgcn_s_setprio(1); _Pragma("unroll") for (int m = 0; m < 4; ++m) _Pragma("unroll") for (int n = 0; n < 2; ++n) _Pragma("unroll") for (int k = 0; k < 2; ++k) \
        acc[ai][bj][m][n] = __builtin_amdgcn_mfma_f32_16x16x32_bf16(Bt[n][k], At[m][k], acc[ai][bj][m][n], 0, 0, 0); __builtin_amdgcn_s_setprio(0); } while (0)
#define PG8_WAIT_V(n) asm volatile("s_waitcnt vmcnt(" #n ")" ::: "memory")
#define PG8_WAIT_L(n) asm volatile("s_waitcnt lgkmcnt(" #n ")" ::: "memory")
#define PG8_BAR __builtin_amdgcn_s_barrier()
#define PG8_SCHED __builtin_amdgcn_sched_barrier(0)
    Unit cur, nxt; int ui = 0;
    if (!S.next(0, cur)) return;
    f32x4 acc[2][2][4][2];
#pragma unroll
    for (int a = 0; a < 2; ++a)
#pragma unroll
        for (int b = 0; b < 2; ++b)
#pragma unroll
            for (int m = 0; m < 4; ++m)
#pragma unroll
                for (int n = 0; n < 2; ++n) acc[a][b][m][n] = (f32x4){0.f, 0.f, 0.f, 0.f};
    bf16x8 At[4][2], B0[2][2], B1[2][2];
    const char* cA = cur.A; const char* cB = cur.B;
    PG8_STAGE(PG8_SB(0, 0), cB, voffB); PG8_STAGE(PG8_SB(0, 1), cB + hstepB, voffB); PG8_STAGE(PG8_SA(0, 0), cA, voffA); PG8_STAGE(PG8_SA(0, 1), cA + hstepA, voffA);
    if (wr == 1) PG8_BAR;
    PG8_WAIT_V(2); PG8_BAR;
    PG8_STAGE(PG8_SB(1, 0), cB + kstep, voffB); PG8_STAGE(PG8_SA(1, 0), cA + kstep, voffA); PG8_STAGE(PG8_SB(1, 1), cB + hstepB + kstep, voffB);
    PG8_WAIT_V(6); PG8_BAR;
    for (;;) {
        const bool has_next = S.next(ui + 1, nxt);
        const char* nA = has_next ? nxt.A : cA; const char* nB = has_next ? nxt.B : cB;
        for (int t = 0; t < nt; t += 2) {
            const bool last = (t == nt - 2);
            const char* a1 = cA + (size_t)(t + 1) * kstep;
            const char* a2 = last ? nA : cA + (size_t)(t + 2) * kstep; const char* b2 = last ? nB : cB + (size_t)(t + 2) * kstep;
            const char* a3 = a2 + kstep; const char* b3 = b2 + kstep;
            PG8_LDB(B0, 0, 0); PG8_LDB(B1, 0, 1); PG8_SCHED; PG8_LDA(At, 0, 0); PG8_STAGE(PG8_SA(1, 1), a1 + hstepA, voffA);
            PG8_WAIT_V(8); PG8_WAIT_L(0); PG8_BAR; PG8_MMA(0, 0, At, B0); PG8_MMA(0, 1, At, B1); PG8_BAR; PG8_SCHED;
            PG8_LDA(At, 0, 1); PG8_STAGE(PG8_SB(0, 0), b2, voffB); PG8_STAGE(PG8_SB(0, 1), b2 + hstepB, voffB); PG8_STAGE(PG8_SA(0, 0), a2, voffA);
            PG8_WAIT_V(8); PG8_WAIT_L(0); PG8_BAR; PG8_MMA(1, 0, At, B0); PG8_MMA(1, 1, At, B1); PG8_BAR; PG8_SCHED;
            PG8_LDB(B0, 1, 0); PG8_LDB(B1, 1, 1); PG8_SCHED; PG8_LDA(At, 1, 0); PG8_STAGE(PG8_SA(0, 1), a2 + hstepA, voffA);
            PG8_WAIT_V(8); PG8_WAIT_L(0); PG8_BAR; PG8_MMA(0, 0, At, B0); PG8_MMA(0, 1, At, B1); PG8_BAR; PG8_SCHED;
            PG8_LDA(At, 1, 1); PG8_STAGE(PG8_SB(1, 0), b3, voffB); PG8_STAGE(PG8_SB(1, 1), b3 + hstepB, voffB); PG8_STAGE(PG8_SA(1, 0), a3, voffA);
            PG8_WAIT_V(8); PG8_WAIT_L(0); PG8_BAR; PG8_MMA(1, 0, At, B0); PG8_MMA(1, 1, At, B1); PG8_BAR; PG8_SCHED;
        }
        if constexpr (ALIGN_EPI) { if (wr == 0) PG8_BAR; }
        if constexpr (!Epi::AFTER_DRAIN) { E(acc, cur, wr, wc, fr, fq); }
        if (!has_next) break;
        if (!S.carry(cur)) {
#pragma unroll
            for (int a = 0; a < 2; ++a)
#pragma unroll
                for (int b = 0; b < 2; ++b)
#pragma unroll
                    for (int m = 0; m < 4; ++m)
#pragma unroll
                        for (int n = 0; n < 2; ++n) acc[a][b][m][n] = (f32x4){0.f, 0.f, 0.f, 0.f};
        }
        cur = nxt; cA = nA; cB = nB; ++ui;
        if constexpr (ALIGN_EPI) { if (wr == 1) PG8_BAR; }
    }
    PG8_WAIT_V(0);
    if constexpr (!ALIGN_EPI) { if (wr == 0) PG8_BAR; }
    PG8_BAR;
    if constexpr (Epi::AFTER_DRAIN) { E.fused(acc, cur, wr, wc, fr, fq, lds, wid, lane); }
#undef PG8_SA
#undef PG8_SB
#undef PG8_STAGE
#undef PG8_LDA
#undef PG8_LDB
#undef PG8_MMA
#undef PG8_WAIT_V
#undef PG8_WAIT_L
#undef PG8_BAR
#undef PG8_SCHED
}
}

typedef f32x4 acc_t[2][2][4][2];

struct EpiProj {
    static constexpr bool AFTER_DRAIN = false;
    const float* rstd; const float* bias; unsigned char* ws;
    __device__ __forceinline__ void operator()(acc_t& acc, const pg8::Unit& u, int wr, int wc, int fr, int fq) const {
        const int pn = u.pn, row0 = u.pm * 256 + wr * 64 + fr;
        f32x4 bv[2][2];
#pragma unroll
        for (int bj = 0; bj < 2; ++bj)
#pragma unroll
            for (int n = 0; n < 2; ++n) bv[bj][n] = *(const f32x4*)(bias + pn * 256 + bj * 128 + wc * 32 + n * 16 + 4 * fq);
        if (pn == 21) {
            if (wc == 0) {
                float* sm = (float*)(ws + WS_SM);
                float rsv[2][4];
#pragma unroll
                for (int ai = 0; ai < 2; ++ai)
#pragma unroll
                    for (int m = 0; m < 4; ++m) rsv[ai][m] = rstd[row0 + ai * 128 + m * 16];
#pragma unroll
                for (int ai = 0; ai < 2; ++ai)
#pragma unroll
                    for (int m = 0; m < 4; ++m) { const int row = row0 + ai * 128 + m * 16; const float rs = rsv[ai][m];
#pragma unroll
                        for (int n = 0; n < 2; ++n) *(f32x4*)(sm + (size_t)row * 32 + n * 16 + 4 * fq) = acc[ai][0][m][n] * rs + bv[0][n]; }
            }
            return;
        }
        bf16_t* cb[2]; int ld, mode = 0;
        if (pn < 8) { bf16_t* b = (bf16_t*)(ws + (pn < 4 ? WS_QK : WS_VO)) + (pn & 3) * 256 + wc * 32; cb[0] = b; cb[1] = b + 128; ld = 1024; mode = (pn >= 6) ? 1 : 0; }
        else if (pn < 10) { bf16_t* b = (bf16_t*)(ws + WS_NQ) + (pn - 8) * 256 + wc * 32; cb[0] = b; cb[1] = b + 128; ld = 512; mode = 2; }
        else if (pn < 13) { bf16_t* b = (bf16_t*)(ws + WS_NKV) + (size_t)((pn - 10) * 4 + (wc >> 1)) * MTOK * 64 + 32 * (wc & 1); cb[0] = b; cb[1] = b + (size_t)2 * MTOK * 64; ld = 64; }
        else { bf16_t* b = (bf16_t*)(ws + WS_GT) + (pn - 13) * 256 + wc * 32; cb[0] = b; cb[1] = b + 128; ld = 2048; mode = 1; }
        float rsv[2][4];
#pragma unroll
        for (int ai = 0; ai < 2; ++ai)
#pragma unroll
            for (int m = 0; m < 4; ++m) rsv[ai][m] = rstd[row0 + ai * 128 + m * 16];
#pragma unroll
        for (int ai = 0; ai < 2; ++ai)
#pragma unroll
            for (int m = 0; m < 4; ++m) { const int row = row0 + ai * 128 + m * 16; const float rs = rsv[ai][m];
#pragma unroll
                for (int bj = 0; bj < 2; ++bj)
#pragma unroll
                    for (int n = 0; n < 2; ++n) { f32x4 v = acc[ai][bj][m][n] * rs + bv[bj][n];
                        if (mode == 1) { v[0] = sigmoidf_(v[0]); v[1] = sigmoidf_(v[1]); v[2] = sigmoidf_(v[2]); v[3] = sigmoidf_(v[3]); }
                        else if (mode == 2) v = v * 0.125f;
                        u32x2 w; w.x = cvtpk(v[0], v[1]); w.y = cvtpk(v[2], v[3]);
                        *(u32x2*)(cb[bj] + (size_t)row * ld + n * 16 + 4 * fq) = w; } }
    }
};

struct EpiBranch {
    static constexpr bool AFTER_DRAIN = false;
    const bf16_t* gt; bf16_t* mixed;
    __device__ __forceinline__ void operator()(acc_t& acc, const pg8::Unit& u, int wr, int wc, int fr, int fq) const {
        const int row0 = u.pm * 256 + wr * 64 + fr, col0 = u.pn * 256 + wc * 32 + 4 * fq;
        const bool s0 = (u.seg == 0);
#pragma unroll
        for (int ai = 0; ai < 2; ++ai)
#pragma unroll
            for (int m = 0; m < 4; ++m) {
                const bf16_t* gp = gt + (size_t)(row0 + ai * 128 + m * 16) * 2048 + col0;
                u32x2 q1[2][2], q0[2][2];
#pragma unroll
                for (int bj = 0; bj < 2; ++bj)
#pragma unroll
                    for (int n = 0; n < 2; ++n) { q1[bj][n] = *(const u32x2*)(gp + 1024 + bj * 128 + n * 16); q0[bj][n] = s0 ? *(const u32x2*)(gp + bj * 128 + n * 16) : (u32x2){0x3f803f80u, 0x3f803f80u}; }
#pragma unroll
                for (int bj = 0; bj < 2; ++bj)
#pragma unroll
                    for (int n = 0; n < 2; ++n) { const u32x2 a0 = q0[bj][n], a1 = q1[bj][n];
                        const f32x4 g0 = {bflo(a0.x), bfhi(a0.x), bflo(a0.y), bfhi(a0.y)}, g1 = {bflo(a1.x), bfhi(a1.x), bflo(a1.y), bfhi(a1.y)};
                        f32x4 a = acc[ai][bj][m][n];
#pragma unroll
                        for (int e = 0; e < 4; ++e) a[e] = s0 ? a[e] * g0[e] * __builtin_amdgcn_rcpf(fmaxf(g1[e], 1e-18f)) : a[e] * g1[e];
                        acc[ai][bj][m][n] = a; }
                asm volatile("" ::: "memory");
            }
        if (!s0) {
#pragma unroll
            for (int ai = 0; ai < 2; ++ai)
#pragma unroll
                for (int m = 0; m < 4; ++m)
#pragma unroll
                    for (int bj = 0; bj < 2; ++bj)
#pragma unroll
                        for (int n = 0; n < 2; ++n) { const f32x4 v = acc[ai][bj][m][n]; u32x2 w; w.x = cvtpk(v[0], v[1]); w.y = cvtpk(v[2], v[3]);
                            *(u32x2*)(mixed + (size_t)(row0 + ai * 128 + m * 16) * 1024 + col0 + bj * 128 + n * 16) = w; }
        }
    }
};

struct EpiResid {
    static constexpr bool AFTER_DRAIN = false;
    const float* base; float* out; bf16_t* outb; float* part;
    __device__ __forceinline__ void operator()(acc_t& acc, const pg8::Unit& u, int wr, int wc, int fr, int fq) const {
        int row0 = u.pm * 256 + wr * 64 + fr; const int col0 = u.pn * 256 + wc * 32 + 4 * fq;
#pragma unroll
        for (int ai = 0; ai < 2; ++ai)
#pragma unroll
            for (int mh = 0; mh < 4; ++mh) {
                if ((mh & 1) == 0) asm volatile("" : "+v"(row0) :: "memory");
                f32x4 r[2][2];
#pragma unroll
                for (int bj = 0; bj < 2; ++bj)
#pragma unroll
                    for (int n = 0; n < 2; ++n) r[bj][n] = *(const f32x4*)(base + (size_t)(row0 + ai * 128 + mh * 16) * 1024 + col0 + bj * 128 + n * 16);
#pragma unroll
                for (int bj = 0; bj < 2; ++bj)
#pragma unroll
                    for (int n = 0; n < 2; ++n) acc[ai][bj][mh][n] += r[bj][n];
                if (mh & 1) asm volatile("" : "+v"(acc[ai][0][mh][0]), "+v"(acc[ai][1][mh][1]) :: "memory");
            }
#pragma unroll
        for (int ai = 0; ai < 2; ++ai)
#pragma unroll
            for (int m = 0; m < 4; ++m) { const int row = row0 + ai * 128 + m * 16; float ss = 0.f;
#pragma unroll
                for (int bj = 0; bj < 2; ++bj)
#pragma unroll
                    for (int n = 0; n < 2; ++n) { const size_t off = (size_t)row * 1024 + col0 + bj * 128 + n * 16;
                        const f32x4 v = acc[ai][bj][m][n];
                        ss += (v[0] * v[0] + v[1] * v[1]) + (v[2] * v[2] + v[3] * v[3]);
                        *(f32x4*)(out + off) = v;
                        if (outb) { u32x2 w; w.x = cvtpk(v[0], v[1]); w.y = cvtpk(v[2], v[3]); *(u32x2*)(outb + off) = w; } }
                ss += __shfl_xor(ss, 16); ss += __shfl_xor(ss, 32);
                if (fq == 0) part[((size_t)u.pn * MTOK + row) * 4 + wc] = ss; }
    }
};

struct EpiGateUp {
    static constexpr bool AFTER_DRAIN = false;
    const float* part; bf16_t* hid;
    __device__ __forceinline__ void operator()(acc_t& acc, const pg8::Unit& u, int wr, int wc, int fr, int fq) const {
        const int row0 = u.pm * 256 + wr * 64 + fr, col0 = u.pn * 128 + wc * 16 + 4 * fq;
        float rsv[2][4];
        { f32x4 pp[2][4];
#pragma unroll
          for (int ai = 0; ai < 2; ++ai)
#pragma unroll
            for (int m = 0; m < 4; ++m) pp[ai][m] = *(const f32x4*)(part + ((size_t)fq * MTOK + row0 + ai * 128 + m * 16) * 4);
#pragma unroll
          for (int ai = 0; ai < 2; ++ai)
#pragma unroll
            for (int m = 0; m < 4; ++m) { float s = (pp[ai][m][0] + pp[ai][m][1]) + (pp[ai][m][2] + pp[ai][m][3]); s += __shfl_xor(s, 16); s += __shfl_xor(s, 32); rsv[ai][m] = rsqrtf(s * (1.0f / 1024.0f) + RMS_EPS); } }
#pragma unroll
        for (int ai = 0; ai < 2; ++ai)
#pragma unroll
            for (int m = 0; m < 4; ++m) { const int row = row0 + ai * 128 + m * 16;
                const float rs = rsv[ai][m];
#pragma unroll
                for (int bj = 0; bj < 2; ++bj) { const f32x4 g = acc[ai][bj][m][0] * rs, up = acc[ai][bj][m][1] * rs; f32x4 y;
#pragma unroll
                    for (int e = 0; e < 4; ++e) y[e] = g[e] * sigmoidf_(g[e]) * up[e];
                    u32x2 w; w.x = cvtpk(y[0], y[1]); w.y = cvtpk(y[2], y[3]);
                    *(u32x2*)(hid + (size_t)row * D_FF + col0 + bj * 64) = w; } }
    }
};

struct Args {
    const float* x; const float* g_norm_mix; const float* w_in; const float* b_in; const float* b_fgate; const float* conv_qk; const float* g_mlstm_head; const float* pe_cmp;
    const float* w_cmp1; const float* w_cmp2; const float* rel_bias; const float* w_branch; const float* w_out; const float* g_norm_ffn; const float* w_gate; const float* w_up;
    const float* w_down; const float* g_final;
    float* out; unsigned char* ws; int ph_lo, ph_hi, coop, pad;
};
constexpr int NWAVES = 8, NTHREADS = 512;
constexpr int RING_BYTES = 131072, LDS_BYTES = 147456;

__device__ __forceinline__ int rel_bucket_dev(int n) {
    if (n < 16) return n < 0 ? 0 : n;
    int b = 16;
    b += (n >= 21); b += (n >= 27); b += (n >= 35); b += (n >= 46); b += (n >= 59); b += (n >= 77); b += (n >= 99); b += (n >= 128);
    b += (n >= 166); b += (n >= 216); b += (n >= 280); b += (n >= 363); b += (n >= 470); b += (n >= 609); b += (n >= 790);
    return b;
}

struct ColSrc { const float* p; int ld; };
template <class F>
__device__ __forceinline__ void tr_item(const F& f, const float* kscale, bf16_t* WT, int K, int nblk, int item, LAS float* scr, int lane, const float* kfallback) {
    const int kb = item / nblk, nb = item % nblk, k0 = 64 * kb, n0 = 32 * nb;
    const ColSrc cs = f(n0 + (lane & 31));
    float tv[32];
    const float* lp = cs.p ? cs.p : kfallback; const float lmask = cs.p ? 1.0f : 0.0f;
#pragma unroll
    for (int i = 0; i < 32; ++i) { const int kk = 2 * i + (lane >> 5); tv[i] = lp[(size_t)(k0 + kk) * cs.ld]; }
#pragma unroll
    for (int i = 0; i < 32; ++i) tv[i] *= lmask;
    if (kscale) {
#pragma unroll
        for (int i = 0; i < 32; ++i) tv[i] *= kscale[k0 + 2 * i + (lane >> 5)]; }
#pragma unroll
    for (int i = 0; i < 32; ++i) scr[(2 * i + (lane >> 5)) * 33 + (lane & 31)] = tv[i];
    asm volatile("s_waitcnt lgkmcnt(0)" ::: "memory");
    const int c = lane & 7;
#pragma unroll
    for (int j = 0; j < 4; ++j) { const int n = (lane >> 3) + 8 * j; const LAS float* s = scr + (8 * c) * 33 + n;
        u32x4 o; o.x = cvtpk(s[0 * 33], s[1 * 33]); o.y = cvtpk(s[2 * 33], s[3 * 33]); o.z = cvtpk(s[4 * 33], s[5 * 33]); o.w = cvtpk(s[6 * 33], s[7 * 33]);
        *(u32x4*)(WT + (size_t)(n0 + n) * K + k0 + 8 * c) = o; }
    asm volatile("s_waitcnt lgkmcnt(0)" ::: "memory");
}
__device__ __forceinline__ int proj_src_col(int n) {
    if (n < 2048) return n;
    if (n < 2560) return 2056 + (n - 2048);
    if (n < 3328) return 2568 + (n - 2560);
    if (n < 5376) return 3360 + (n - 3328);
    const int x = n - 5376;
    if (x < 8) return 2048 + x;
    if (x < 32) return 3336 + (x - 8);
    return -1;
}
struct SrcW1 { const float* w; __device__ ColSrc operator()(int n) const { const int c = proj_src_col(n); return ColSrc{c >= 0 ? w + c : nullptr, D_IN}; } };
struct SrcGU { const float* wg; const float* wu; __device__ ColSrc operator()(int n) const { const int G = n >> 4; const uintptr_t pg = (uintptr_t)wg, pu = (uintptr_t)wu; const uintptr_t sel = pg ^ ((pg ^ pu) & (uintptr_t)(0 - (long long)(G & 1)));
    return ColSrc{(const float*)sel + 16 * (G >> 1) + (n & 15), D_FF}; } };
struct SrcPlain { const float* w; int ld; __device__ ColSrc operator()(int n) const { return ColSrc{w + n, ld}; } };
struct SrcBr { const float* w; __device__ ColSrc operator()(int n) const { return ColSrc{w + (size_t)(n >> 10) * 512 * 1024 + (n & 1023), 1024}; } };
struct SrcC1 { const float* w; __device__ ColSrc operator()(int n) const { const int j = n >> 8, q = n & 255; return ColSrc{w + (size_t)j * 2048 * 128 + (q >= 128 ? 1024 * 128 : 0) + (q & 127), 128}; } };
struct SrcC2 { const float* w; __device__ ColSrc operator()(int n) const { return ColSrc{w + (size_t)(n >> 6) * 128 * 64 + (n & 63), 64}; } };

__device__ __forceinline__ void p0_prologue(const Args& a, LAS unsigned char* lds, int vcu, int G, int wave, int lane) {
    unsigned char* ws = a.ws;
    LAS float* scr = (LAS float*)(lds + wave * 16384);
    const int gw = vcu * NWAVES + wave, NGW = G * NWAVES;
    constexpr int I_W1 = (1024 / 64) * (N1 / 32), I_GU = (1024 / 64) * (NGU / 32), I_DN = (D_FF / 64) * (1024 / 32), I_OUT = 16 * 32, I_BR = (512 / 64) * (2048 / 32), I_C1 = 16 * (512 / 32), I_C2 = 2 * (128 / 32);
    constexpr int I_PEB = 256, I_BIAS = N1 / 64, I_BT = 8 * (BIAS_LEN / 64);
    constexpr int NITEMS = I_W1 + I_GU + I_DN + I_OUT + I_BR + I_C1 + I_C2 + I_PEB + I_BIAS + I_BT;
    if (blockIdx.x == 0) { if (threadIdx.x < 64) ((unsigned*)(ws + WS_CTL))[threadIdx.x] = 0u; for (int i = threadIdx.x; i < 3456; i += NTHREADS) ((unsigned*)(ws + WS_BAR))[i] = 0u; }
    for (int it = gw; it < NITEMS; it += NGW) {
        int r = it;
        if (r < I_W1) { tr_item(SrcW1{a.w_in}, a.g_norm_mix, (bf16_t*)(ws + WS_W1T), 1024, N1 / 32, r, scr, lane, a.w_in); continue; } r -= I_W1;
        if (r < I_GU) { tr_item(SrcGU{a.w_gate, a.w_up}, a.g_norm_ffn, (bf16_t*)(ws + WS_WGUT), 1024, NGU / 32, r, scr, lane, a.w_gate); continue; } r -= I_GU;
        if (r < I_DN) { tr_item(SrcPlain{a.w_down, 1024}, nullptr, (bf16_t*)(ws + WS_WDNT), D_FF, 1024 / 32, r, scr, lane, a.w_down); continue; } r -= I_DN;
        if (r < I_OUT) { tr_item(SrcPlain{a.w_out, 1024}, nullptr, (bf16_t*)(ws + WS_WOUTT), 1024, 1024 / 32, r, scr, lane, a.w_out); continue; } r -= I_OUT;
        if (r < I_BR) { tr_item(SrcBr{a.w_branch}, nullptr, (bf16_t*)(ws + WS_WBRT), 512, 2048 / 32, r, scr, lane, a.w_branch); continue; } r -= I_BR;
        if (r < I_C1) { tr_item(SrcC1{a.w_cmp1}, nullptr, (bf16_t*)(ws + WS_WC1T), 1024, 512 / 32, r, scr, lane, a.w_cmp1); continue; } r -= I_C1;
        if (r < I_C2) { tr_item(SrcC2{a.w_cmp2}, nullptr, (bf16_t*)(ws + WS_WC2T), 128, 128 / 32, r, scr, lane, a.w_cmp2); continue; } r -= I_C2;
        if (r < I_PEB) {
            const int j = r >> 7, n = r & 127; const float* pe = a.pe_cmp + j * 2048; const float* w = a.w_cmp1 + (size_t)j * 2048 * 128 + n; float s = 0.f;
#pragma unroll 8
            for (int i = 0; i < 32; ++i) { const int k = i * 64 + lane; s += pe[k] * w[(size_t)k * 128]; }
            s = wave_sum(s); if (lane == 0) __hip_atomic_store((float*)(ws + WS_PEB) + r, s, __ATOMIC_RELAXED, __HIP_MEMORY_SCOPE_AGENT); continue; } r -= I_PEB;
        if (r < I_BIAS) { const int n = r * 64 + lane; const int c = proj_src_col(n); ((float*)(ws + WS_BIAS1))[n] = c >= 0 ? a.b_in[c] : 0.f; continue; } r -= I_BIAS;
        { const int h = r / (BIAS_LEN / 64), idx = (r % (BIAS_LEN / 64)) * 64 + lane;
          ((float*)(ws + WS_BTAB))[h * BIAS_LEN + idx] = a.rel_bias[rel_bucket_dev(SEQ - 1 - idx) * N_HEADS + h] * 1.4426950408889634f; }
    }
    bf16_t* xb = (bf16_t*)(ws + WS_XB); float* rsx = (float*)(ws + WS_RSX);
    for (int blk = gw; blk < MTOK / 16; blk += NGW) {
        float myrs = 0.f;
#pragma unroll 1
        for (int k4 = 0; k4 < 16; k4 += 4) {
            f32x4 v[4][4]; float s[4];
#pragma unroll
            for (int r = 0; r < 4; ++r) { const f32x4* xr = (const f32x4*)(a.x + (size_t)(blk * 16 + k4 + r) * 1024) + lane;
#pragma unroll
                for (int j = 0; j < 4; ++j) v[r][j] = xr[64 * j]; }
#pragma unroll
            for (int r = 0; r < 4; ++r) { float t = 0.f;
#pragma unroll
                for (int j = 0; j < 4; ++j) t += (v[r][j][0] * v[r][j][0] + v[r][j][1] * v[r][j][1]) + (v[r][j][2] * v[r][j][2] + v[r][j][3] * v[r][j][3]);
                s[r] = wave_sum(t);
                u32x2* o = (u32x2*)(xb + (size_t)(blk * 16 + k4 + r) * 1024) + lane;
#pragma unroll
                for (int j = 0; j < 4; ++j) { u32x2 w; w.x = cvtpk(v[r][j][0], v[r][j][1]); w.y = cvtpk(v[r][j][2], v[r][j][3]); o[64 * j] = w; }
                if (lane == k4 + r) myrs = rsqrtf(s[r] * (1.0f / 1024.0f) + RMS_EPS); }
        }
        if (lane < 16) rsx[blk * 16 + lane] = myrs;
    }
}

__device__ __forceinline__ void p8_final(const Args& a, int vcu, int G, int wave, int lane) {
    const float* part = (const float*)(a.ws + WS_PART2);
    const int gw = vcu * NWAVES + wave, NGW = G * NWAVES;
    f32x4 gv[4];
#pragma unroll
    for (int j = 0; j < 4; ++j) gv[j] = ((const f32x4*)a.g_final)[lane + 64 * j];
    for (int m = gw; m < MTOK; m += NGW) {
        float p = (lane < 16) ? part[((size_t)(lane >> 2) * MTOK + m) * 4 + (lane & 3)] : 0.f;
        p += __shfl_xor(p, 1); p += __shfl_xor(p, 2); p += __shfl_xor(p, 4); p += __shfl_xor(p, 8);
        const float rs = rsqrtf(__shfl(p, 0) * (1.0f / 1024.0f) + RMS_EPS);
        f32x4* xr = (f32x4*)(a.out + (size_t)m * 1024) + lane;
#pragma unroll
        for (int j = 0; j < 4; ++j) xr[64 * j] = xr[64 * j] * rs * gv[j];
    }
}

__device__ __forceinline__ int kpos16(int key) { return (key & ~12) | ((key & 4) << 1) | ((key & 8) >> 1); }
__device__ __forceinline__ float siluf_(float x) { return x * sigmoidf_(x); }

__device__ __forceinline__ void p2_conv_item(const Args& a, int item, int tid) {
    const bf16_t* qk = (const bf16_t*)(a.ws + WS_QK); bf16_t* qc = (bf16_t*)(a.ws + WS_XB);
    const int cg8 = tid & 127, tg = tid >> 7, ch = cg8 * 8, row0 = item * 32 + tg * 8, tl0 = row0 & (SEQ - 1);
    float w[4][8];
#pragma unroll
    for (int j = 0; j < 4; ++j) { const f32x4 w0 = *(const f32x4*)(a.conv_qk + j * 1024 + ch), w1 = *(const f32x4*)(a.conv_qk + j * 1024 + ch + 4);
        w[j][0] = w0[0]; w[j][1] = w0[1]; w[j][2] = w0[2]; w[j][3] = w0[3]; w[j][4] = w1[0]; w[j][5] = w1[1]; w[j][6] = w1[2]; w[j][7] = w1[3]; }
    const float osc = (ch >= 512) ? 0.08838834764831845f : 1.0f;
    float xw[3][8];
#pragma unroll
    for (int k = 0; k < 3; ++k) { const int tl = tl0 - 3 + k; u32x4 v = (u32x4){0u, 0u, 0u, 0u}; if (tl >= 0) v = *(const u32x4*)(qk + (size_t)(row0 - 3 + k) * 1024 + ch);
        xw[k][0] = bflo(v.x); xw[k][1] = bfhi(v.x); xw[k][2] = bflo(v.y); xw[k][3] = bfhi(v.y); xw[k][4] = bflo(v.z); xw[k][5] = bfhi(v.z); xw[k][6] = bflo(v.w); xw[k][7] = bfhi(v.w); }
#pragma unroll
    for (int t = 0; t < 8; ++t) {
        const u32x4 v = *(const u32x4*)(qk + (size_t)(row0 + t) * 1024 + ch);
        float x[8] = {bflo(v.x), bfhi(v.x), bflo(v.y), bfhi(v.y), bflo(v.z), bfhi(v.z), bflo(v.w), bfhi(v.w)}; float y[8];
#pragma unroll
        for (int e = 0; e < 8; ++e) { const float s = w[0][e] * xw[0][e] + w[1][e] * xw[1][e] + w[2][e] * xw[2][e] + w[3][e] * x[e]; y[e] = siluf_(s) * osc; xw[0][e] = xw[1][e]; xw[1][e] = xw[2][e]; xw[2][e] = x[e]; }
        u32x4 o; o.x = cvtpk(y[0], y[1]); o.y = cvtpk(y[2], y[3]); o.z = cvtpk(y[4], y[5]); o.w = cvtpk(y[6], y[7]);
        *(u32x4*)(qc + (size_t)(row0 + t) * 1024 + ch) = o;
    }
}
__device__ __forceinline__ void p2_vt_item(const Args& a, int it, LAS unsigned char* scr, int lane) {
    const int which = it >> 10, rem = it & 1023, bg = rem >> 5, blk = rem & 31, b = bg >> 1, g = bg & 1;
    const bf16_t* src = (const bf16_t*)(a.ws + WS_NKV) + ((size_t)((which ? 10 : 6) + g) * MTOK + (size_t)b * SEQ + blk * 64) * 64;
    bf16_t* dst = (bf16_t*)(a.ws + (which ? WS_VWT : WS_VST)) + (size_t)(bg * 32 + blk) * 4096;
    LAS unsigned short* s = (LAS unsigned short*)scr;
#pragma unroll
    for (int i = 0; i < 8; ++i) { const int key = i * 8 + (lane >> 3), c = lane & 7; const u32x4 v = *(const u32x4*)(src + key * 64 + c * 8); const int p = (key & ~15) | kpos16(key & 15);
        s[(c * 8 + 0) * 72 + p] = (unsigned short)(v.x & 0xffff); s[(c * 8 + 1) * 72 + p] = (unsigned short)(v.x >> 16); s[(c * 8 + 2) * 72 + p] = (unsigned short)(v.y & 0xffff); s[(c * 8 + 3) * 72 + p] = (unsigned short)(v.y >> 16);
        s[(c * 8 + 4) * 72 + p] = (unsigned short)(v.z & 0xffff); s[(c * 8 + 5) * 72 + p] = (unsigned short)(v.z >> 16); s[(c * 8 + 6) * 72 + p] = (unsigned short)(v.w & 0xffff); s[(c * 8 + 7) * 72 + p] = (unsigned short)(v.w >> 16); }
    asm volatile("s_waitcnt lgkmcnt(0)" ::: "memory");
#pragma unroll
    for (int i = 0; i < 8; ++i) { const int d = i * 8 + (lane >> 3), c = lane & 7; *(u32x4*)(dst + d * 64 + c * 8) = *(const LAS u32x4*)(scr + d * 144 + c * 16); }
    asm volatile("s_waitcnt lgkmcnt(0)" ::: "memory");
}
struct CmpOrder {
    int c; const char* A; const char* B;
    __device__ __forceinline__ bool next(int i, pg8::Unit& u) const { if (i != 0 || c >= 32) return false; u.pm = c & 7; u.pn = c >> 3; u.seg = 0; u.A = A + (size_t)(c >> 3) * MTOK * 64 * 2 + (size_t)(c & 7) * 256 * 1024 * 2; u.B = B + (size_t)(c >> 4) * 256 * 1024 * 2; return true; }
    __device__ __forceinline__ bool carry(const pg8::Unit&) const { return false; }
};
struct EpiCmp {
    static constexpr bool AFTER_DRAIN = true;
    const float* peb; const bf16_t* wc2t; bf16_t* kc; bf16_t* vct;
    __device__ __forceinline__ void operator()(acc_t&, const pg8::Unit&, int, int, int, int) const {}
    __device__ __forceinline__ void fused(acc_t& acc, const pg8::Unit& u, int wr, int wc, int fr, int fq, LAS unsigned char* lds, int wid, int lane) const {
        const int p = u.pn, jj = p >> 1, g = p & 1;
        LAS float* hb = (LAS float*)lds;
#pragma unroll
        for (int ai = 0; ai < 2; ++ai)
#pragma unroll
            for (int m = 0; m < 4; ++m) { const int r = ai * 128 + wr * 64 + m * 16 + fr;
#pragma unroll
                for (int n = 0; n < 2; ++n) { const int cu = (32 * wc + 16 * n + 4 * fq) >> 2; *(LAS f32x4*)(hb + r * 128 + ((cu ^ (r & 15)) << 2)) = acc[ai][1][m][n]; } }
        asm volatile("s_waitcnt lgkmcnt(0)" ::: "memory"); __builtin_amdgcn_s_barrier(); asm volatile("" ::: "memory");
#pragma unroll
        for (int ai = 0; ai < 2; ++ai)
#pragma unroll
            for (int m = 0; m < 4; ++m) { const int r = ai * 128 + wr * 64 + m * 16 + fr, r1 = (r + 1) & 255;
#pragma unroll
                for (int n = 0; n < 2; ++n) { const int col = 32 * wc + 16 * n + 4 * fq, cu = col >> 2;
                    const f32x4 bt = *(const LAS f32x4*)(hb + r1 * 128 + ((cu ^ (r1 & 15)) << 2)); const f32x4 pb = *(const f32x4*)(peb + jj * 128 + col);
                    f32x4 v = acc[ai][0][m][n] + bt + pb; v[0] = siluf_(v[0]); v[1] = siluf_(v[1]); v[2] = siluf_(v[2]); v[3] = siluf_(v[3]); acc[ai][0][m][n] = v; } }
        asm volatile("s_waitcnt lgkmcnt(0)" ::: "memory"); __builtin_amdgcn_s_barrier(); asm volatile("" ::: "memory");
#pragma unroll
        for (int ai = 0; ai < 2; ++ai)
#pragma unroll
            for (int m = 0; m < 4; ++m) { const int r = ai * 128 + wr * 64 + m * 16 + fr;
#pragma unroll
                for (int n = 0; n < 2; ++n) { const int col = 32 * wc + 16 * n + 4 * fq; const f32x4 v = acc[ai][0][m][n]; u32x2 w; w.x = cvtpk(v[0], v[1]); w.y = cvtpk(v[2], v[3]); *(LAS u32x2*)(lds + r * 272 + col * 2) = w; } }
        asm volatile("s_waitcnt lgkmcnt(0)" ::: "memory"); __builtin_amdgcn_s_barrier(); asm volatile("" ::: "memory");
        const bf16_t* w2 = wc2t + jj * 64 * 128;
        bf16x8 wf[4][4];
#pragma unroll
        for (int dt = 0; dt < 4; ++dt)
#pragma unroll
            for (int s = 0; s < 4; ++s) wf[dt][s] = *(const bf16x8*)(w2 + (dt * 16 + fr) * 128 + 32 * s + 8 * fq);
#pragma unroll
        for (int rt = 0; rt < 2; ++rt) {
            const int r = wid * 32 + rt * 16 + fr; bf16x8 hf[4];
#pragma unroll
            for (int s = 0; s < 4; ++s) hf[s] = *(const LAS bf16x8*)(lds + r * 272 + (32 * s + 8 * fq) * 2);
            const int crow = u.pm * 256 + r, b = crow >> 7, c = crow & 127; const bool zero = (c == 127);
#pragma unroll
            for (int dt = 0; dt < 4; ++dt) { f32x4 o = {0.f, 0.f, 0.f, 0.f};
#pragma unroll
                for (int s = 0; s < 4; ++s) o = __builtin_amdgcn_mfma_f32_16x16x32_bf16(wf[dt][s], hf[s], o, 0, 0, 0);
                if (zero) o = (f32x4){0.f, 0.f, 0.f, 0.f};
                const int dd = dt * 16 + 4 * fq;
                if (jj == 0) { u32x2 w; w.x = cvtpk(o[0], o[1]); w.y = cvtpk(o[2], o[3]); *(u32x2*)(kc + ((size_t)(b * 2 + g) * 128 + c) * 64 + dd) = w; }
                else { bf16_t* vb = vct + ((size_t)(b * 2 + g) * 2 + (c >> 6)) * 4096 + ((c & 48) | kpos16(c & 15));
#pragma unroll
                    for (int e = 0; e < 4; ++e) vb[(dd + e) * 64] = (bf16_t)(cvtpk(o[e], 0.f) & 0xffff); } }
        }
    }
};
__device__ __forceinline__ void p2_prep(const Args& a, LAS unsigned char* lds, int bx, int G, int wave, int lane) {
    unsigned char* ws = a.ws;
    {
        CmpOrder S{bx, (const char*)(ws + WS_NKV), (const char*)(ws + WS_WC1T)};
        EpiCmp E{(const float*)(ws + WS_PEB), (const bf16_t*)(ws + WS_WC2T), (bf16_t*)(ws + WS_KC), (bf16_t*)(ws + WS_VCT)};
        pg8::gemm_phase<EpiCmp, CmpOrder, false>(lds, pg8::Dims{1024, 1024, 16}, S, E);
        __syncthreads();
    }
    for (int it = bx; it < MTOK / 32; it += G) p2_conv_item(a, it, threadIdx.x);
    for (int it = bx * NWAVES + wave; it < 2048; it += G * NWAVES) p2_vt_item(a, it, lds + wave * 16384, lane);
}

__device__ __forceinline__ int jpos32(int jj) { return ((jj & 12) << 1) | ((jj & 16) >> 2) | (jj & 3); }
__device__ __forceinline__ float logsigf_(float x) { return fminf(x, 0.f) - log1pf(__expf(-fabsf(x))); }
constexpr int ML_KS = 0, ML_VTS = 34816, ML_CS = 69632, ML_GV = 108800, ML_PM = ML_GV + 8192, ML_BC = ML_PM + 8192, ML_GH = ML_BC + 8192, ML_SCB = ML_GH + 512, ML_END = ML_SCB + 128;
static_assert(ML_END <= 140 * 1024, "mLSTM LDS map");
__device__ __forceinline__ void mlstm_item(const Args& a, LAS unsigned char* lds, int b, int h, int tid, int wave, int lane) {
    const bf16_t* qc = (const bf16_t*)(a.ws + WS_XB); const bf16_t* vo = (const bf16_t*)(a.ws + WS_VO); const float* sm = (const float*)(a.ws + WS_SM); bf16_t* ys = (bf16_t*)(a.ws + WS_QK);
    asm volatile("" : "+v"(tid), "+v"(lane));
    const int w = wave, fr = lane & 15, g = lane >> 4;
    LAS float* GV = (LAS float*)(lds + ML_GV); LAS float* PM = (LAS float*)(lds + ML_PM); LAS float* BC = (LAS float*)(lds + ML_BC); LAS float* GH = (LAS float*)(lds + ML_GH); LAS float* SCB = (LAS float*)(lds + ML_SCB);
    {
        const float bfg = a.b_fgate[h];
#pragma unroll 1
        for (int cc = 0; cc < 2; ++cc) {
            const int c = 2 * w + cc, r0 = b * SEQ + c * M_CHUNK, j0 = 2 * lane, j1 = j0 + 1;
            const float ip0 = sm[(size_t)(r0 + j0) * 32 + h], ip1 = sm[(size_t)(r0 + j1) * 32 + h];
            const float lf0 = logsigf_(sm[(size_t)(r0 + j0) * 32 + 4 + h] + bfg), lf1 = logsigf_(sm[(size_t)(r0 + j1) * 32 + 4 + h] + bfg);
            float s = lf0 + lf1;
#pragma unroll
            for (int o = 1; o < 64; o <<= 1) { const float t = __shfl_up(s, o); if (lane >= o) s += t; }
            const float bc1 = s, bc0 = s - lf1, gv0 = ip0 - bc0, gv1 = ip1 - bc1;
            float pm = fmaxf(gv0, gv1);
#pragma unroll
            for (int o = 1; o < 64; o <<= 1) { const float t = __shfl_up(pm, o); if (lane >= o) pm = fmaxf(pm, t); }
            float ex = __shfl_up(pm, 1); if (lane == 0) ex = -INFINITY;
            GV[c * 128 + j0] = gv0; GV[c * 128 + j1] = gv1; PM[c * 128 + j0] = fmaxf(ex, gv0); PM[c * 128 + j1] = pm; BC[c * 128 + j0] = bc0; BC[c * 128 + j1] = bc1;
            if (lane == 63) { SCB[2 * c] = bc1; SCB[2 * c + 1] = pm; }
        }
        if (tid < 128) GH[tid] = a.g_mlstm_head[h * 128 + tid];
    }
    float m_prev = 0.f;
    f32x4 ct[9];
#pragma unroll
    for (int vt = 0; vt < 9; ++vt) ct[vt] = (f32x4){0.f, 0.f, 0.f, 0.f};
    bf16x8 ones; { const short o = (fr == 0) ? (short)0x3F80 : (short)0; ones = (bf16x8){o, o, o, o, o, o, o, o}; }
    u32x4 kreg[4], vreg[4]; bf16x8 qf[4];
    const int pj = tid >> 4, pch = tid & 15;
#define ML_PREFETCH(c_) do { const int r0_ = b * SEQ + (c_) * M_CHUNK; \
        _Pragma("unroll") for (int i = 0; i < 4; ++i) { kreg[i] = *(const u32x4*)(qc + (size_t)(r0_ + pj + 32 * i) * 1024 + 512 + h * 128 + pch * 8); vreg[i] = *(const u32x4*)(vo + (size_t)(r0_ + pj + 32 * i) * 1024 + h * 128 + pch * 8); } } while (0)
#define ML_PREFETCH_Q(c_) do { const int r0_ = b * SEQ + (c_) * M_CHUNK; \
        _Pragma("unroll") for (int s = 0; s < 4; ++s) qf[s] = *(const bf16x8*)(qc + (size_t)(r0_ + 16 * w + fr) * 1024 + h * 128 + 32 * s + 8 * g); } while (0)
    ML_PREFETCH(0); ML_PREFETCH_Q(0);
    for (int c = 0; c < NCHUNK; ++c) {
        const int r0 = b * SEQ + c * M_CHUNK, irow = r0 + 16 * w + fr;
#pragma unroll
        for (int i = 0; i < 4; ++i) { const int j = pj + 32 * i;
            *(LAS u32x4*)(lds + ML_KS + j * 272 + pch * 16) = kreg[i];
            const u32x4 v = vreg[i]; const int p = (j & ~31) | jpos32(j & 31);
            LAS unsigned short* d = (LAS unsigned short*)(lds + ML_VTS + (pch * 8) * 272 + p * 2);
            d[0 * 136] = (unsigned short)(v.x & 0xffff); d[1 * 136] = (unsigned short)(v.x >> 16); d[2 * 136] = (unsigned short)(v.y & 0xffff); d[3 * 136] = (unsigned short)(v.y >> 16);
            d[4 * 136] = (unsigned short)(v.z & 0xffff); d[5 * 136] = (unsigned short)(v.z >> 16); d[6 * 136] = (unsigned short)(v.w & 0xffff); d[7 * 136] = (unsigned short)(v.w >> 16); }
#pragma unroll
        for (int vt = 0; vt < 9; ++vt)
#pragma unroll
            for (int r = 0; r < 4; ++r) *(LAS unsigned short*)(lds + ML_CS + (16 * vt + 4 * g + r) * 272 + (16 * w + fr) * 2) = (unsigned short)(cvtpk(ct[vt][r], 0.f) & 0xffff);
        __syncthreads();
        if (c + 1 < NCHUNK) ML_PREFETCH(c + 1);
        const float Ml = fmaxf(SCB[2 * c + 1], m_prev), m_new = SCB[2 * c] + Ml, decay = __expf(m_prev - Ml);
        const float Mi = fmaxf(PM[c * 128 + 16 * w + fr], m_prev), bci = BC[c * 128 + 16 * w + fr];
        const float sint = __expf(m_prev - Mi);
        unsigned pk[8][2];
#pragma unroll
        for (int jt = 0; jt < 8; ++jt) {
            pk[jt][0] = 0u; pk[jt][1] = 0u;
            if (jt <= w) {
                f32x4 st = {0.f, 0.f, 0.f, 0.f};
#pragma unroll
                for (int s = 0; s < 4; ++s) st = __builtin_amdgcn_mfma_f32_16x16x32_bf16(*(const LAS bf16x8*)(lds + ML_KS + (16 * jt + fr) * 272 + (32 * s + 8 * g) * 2), qf[s], st, 0, 0, 0);
                const f32x4 gvv = *(const LAS f32x4*)(lds + ML_GV + (c * 128 + 16 * jt + 4 * g) * 4); float p[4];
#pragma unroll
                for (int r = 0; r < 4; ++r) { const bool ok = (jt < w) || (4 * g + r <= fr); p[r] = ok ? st[r] * __expf(gvv[r] - Mi) : 0.f; }
                pk[jt][0] = cvtpk(p[0], p[1]); pk[jt][1] = cvtpk(p[2], p[3]);
            }
        }
        u32x2 so[8];
#pragma unroll
        for (int vt = 0; vt < 8; ++vt) so[vt] = *(const u32x2*)(vo + (size_t)irow * 1024 + 512 + h * 128 + 16 * vt + 4 * g);
        f32x4 hacc[9];
#pragma unroll
        for (int vt = 0; vt < 9; ++vt) {
            f32x4 hh = {0.f, 0.f, 0.f, 0.f};
#pragma unroll
            for (int s = 0; s < 4; ++s) hh = __builtin_amdgcn_mfma_f32_16x16x32_bf16(*(const LAS bf16x8*)(lds + ML_CS + (16 * vt + fr) * 272 + (32 * s + 8 * g) * 2), qf[s], hh, 0, 0, 0);
            hh = hh * sint;
#pragma unroll
            for (int s = 0; s < 4; ++s) if (2 * s <= w) {
                const bf16x8 av = (vt < 8) ? *(const LAS bf16x8*)(lds + ML_VTS + (16 * vt + fr) * 272 + (32 * s + 8 * g) * 2) : ones;
                const u32x4 pb = {pk[2 * s][0], pk[2 * s][1], pk[2 * s + 1][0], pk[2 * s + 1][1]};
                hh = __builtin_amdgcn_mfma_f32_16x16x32_bf16(av, __builtin_bit_cast(bf16x8, pb), hh, 0, 0, 0); }
            hacc[vt] = hh;
            if (vt & 1) asm volatile("" ::: "memory");
        }
        if (c + 1 < NCHUNK) ML_PREFETCH_Q(c + 1);
        {
            const float den = __shfl(hacc[8][0], fr);
            const float inv = 1.0f / fmaxf(fabsf(den), __expf(-(bci + Mi)));
            float ss = 0.f;
#pragma unroll
            for (int vt = 0; vt < 8; ++vt) { hacc[vt] = hacc[vt] * inv; ss += (hacc[vt][0] * hacc[vt][0] + hacc[vt][1] * hacc[vt][1]) + (hacc[vt][2] * hacc[vt][2] + hacc[vt][3] * hacc[vt][3]); }
            ss += __shfl_xor(ss, 16); ss += __shfl_xor(ss, 32);
            const float rs = rsqrtf(ss * (1.0f / 128.0f) + RMS_EPS);
#pragma unroll
            for (int vt = 0; vt < 8; ++vt) { const int v0 = 16 * vt + 4 * g;
                const f32x4 gh = *(const LAS f32x4*)(lds + ML_GH + v0 * 4);
                const f32x4 y = {hacc[vt][0] * rs * gh[0] * bflo(so[vt].x), hacc[vt][1] * rs * gh[1] * bfhi(so[vt].x), hacc[vt][2] * rs * gh[2] * bflo(so[vt].y), hacc[vt][3] * rs * gh[3] * bfhi(so[vt].y)};
                u32x2 o; o.x = cvtpk(y[0], y[1]); o.y = cvtpk(y[2], y[3]); *(u32x2*)(ys + (size_t)irow * 1024 + h * 128 + v0) = o; }
        }
        {
            bf16x8 kb[4];
#pragma unroll
            for (int s = 0; s < 4; ++s) {
                const f32x4 g0 = *(const LAS f32x4*)(lds + ML_GV + (c * 128 + 32 * s + 4 * g) * 4), g1 = *(const LAS f32x4*)(lds + ML_GV + (c * 128 + 32 * s + 16 + 4 * g) * 4); float kv[8];
#pragma unroll
                for (int e = 0; e < 4; ++e) { kv[e] = bf2f(*(const LAS unsigned short*)(lds + ML_KS + (32 * s + 4 * g + e) * 272 + (16 * w + fr) * 2)) * __expf(g0[e] - Ml);
                    kv[4 + e] = bf2f(*(const LAS unsigned short*)(lds + ML_KS + (32 * s + 16 + 4 * g + e) * 272 + (16 * w + fr) * 2)) * __expf(g1[e] - Ml); }
                const u32x4 kk = {cvtpk(kv[0], kv[1]), cvtpk(kv[2], kv[3]), cvtpk(kv[4], kv[5]), cvtpk(kv[6], kv[7])}; kb[s] = __builtin_bit_cast(bf16x8, kk);
            }
#pragma unroll
            for (int vt = 0; vt < 9; ++vt) { f32x4 cc = ct[vt] * decay;
#pragma unroll
                for (int s = 0; s < 4; ++s) { const bf16x8 av = (vt < 8) ? *(const LAS bf16x8*)(lds + ML_VTS + (16 * vt + fr) * 272 + (32 * s + 8 * g) * 2) : ones;
                    cc = __builtin_amdgcn_mfma_f32_16x16x32_bf16(av, kb[s], cc, 0, 0, 0); }
                ct[vt] = cc;
                if (vt & 1) asm volatile("" ::: "memory"); }
            m_prev = m_new;
        }
        __syncthreads();
    }
#undef ML_PREFETCH
#undef ML_PREFETCH_Q
}

constexpr int NS_KB = 0, NS_VB = 18432, NS_BT = 36864, NS_IMP = NS_BT + 8 * BIAS_LEN * 4, NS_SEL = NS_IMP + 4 * 64 * 33 * 4, NS_END = NS_SEL + 256;
static_assert(NS_END <= 143 * 1024, "NSA LDS map");
constexpr float LOG2E = 1.4426950408889634f;
__device__ __forceinline__ int crow32(int r, int hi) { return (r & 3) + 8 * (r >> 2) + 4 * hi; }
__device__ __forceinline__ float ex2(float x) { return __builtin_amdgcn_exp2f(x); }

struct NsaState { float m, l; f32x16 o[2]; };
__device__ __forceinline__ void ns_reset(NsaState& s) { s.m = -1e30f; s.l = 0.f;
#pragma unroll
    for (int r = 0; r < 16; ++r) { s.o[0][r] = 0.f; s.o[1][r] = 0.f; } }

__device__ __forceinline__ void ns_qk(f32x16& s0, f32x16& s1, const LAS unsigned char* kb, const bf16x8* qf, int q, int hi) {
#pragma unroll
    for (int r = 0; r < 16; ++r) { s0[r] = 0.f; s1[r] = 0.f; }
#pragma unroll
    for (int ks = 0; ks < 4; ++ks) {
        const bf16x8 a0 = *(const LAS bf16x8*)(kb + q * 144 + ks * 32 + hi * 16), a1 = *(const LAS bf16x8*)(kb + (32 + q) * 144 + ks * 32 + hi * 16);
        s0 = __builtin_amdgcn_mfma_f32_32x32x16_bf16(a0, qf[ks], s0, 0, 0, 0); s1 = __builtin_amdgcn_mfma_f32_32x32x16_bf16(a1, qf[ks], s1, 0, 0, 0);
    }
}
__device__ __forceinline__ void ns_pv(f32x16* o, const f32x16& p0, const f32x16& p1, const LAS unsigned char* vb, int q, int hi, bool keep = true) {
    bf16x8 pf[4]; const unsigned km = keep ? 0xffffffffu : 0u;
#pragma unroll
    for (int h2 = 0; h2 < 2; ++h2) { const u32x4 a = {cvtpk(p0[8 * h2 + 0], p0[8 * h2 + 1]) & km, cvtpk(p0[8 * h2 + 2], p0[8 * h2 + 3]) & km, cvtpk(p0[8 * h2 + 4], p0[8 * h2 + 5]) & km, cvtpk(p0[8 * h2 + 6], p0[8 * h2 + 7]) & km};
        const u32x4 b = {cvtpk(p1[8 * h2 + 0], p1[8 * h2 + 1]) & km, cvtpk(p1[8 * h2 + 2], p1[8 * h2 + 3]) & km, cvtpk(p1[8 * h2 + 4], p1[8 * h2 + 5]) & km, cvtpk(p1[8 * h2 + 6], p1[8 * h2 + 7]) & km};
        pf[h2] = __builtin_bit_cast(bf16x8, a); pf[2 + h2] = __builtin_bit_cast(bf16x8, b); }
#pragma unroll
    for (int dt = 0; dt < 2; ++dt)
#pragma unroll
        for (int ks = 0; ks < 4; ++ks) o[dt] = __builtin_amdgcn_mfma_f32_32x32x16_bf16(*(const LAS bf16x8*)(vb + (32 * dt + q) * 144 + ks * 32 + hi * 16), pf[ks], o[dt], 0, 0, 0);
}
template <bool CAUSAL, bool WINLO, bool FAR, bool SEL>
__device__ __forceinline__ void ns_block(NsaState& st, const LAS unsigned char* kb, const LAS unsigned char* vb, const bf16x8* qf, const LAS float* bt, int dq, bool selbit, float cfar, int q, int hi) {
    f32x16 s0, s1; ns_qk(s0, s1, kb, qf, q, hi);
    const LAS float* bp = bt + (SEQ - 1 - dq + 4 * hi);
    const int dl = dq - 4 * hi;
    float mx = -INFINITY;
#pragma unroll
    for (int r = 0; r < 16; ++r) {
        const int kc = (r & 3) + 8 * (r >> 2);
        float x0 = FAR ? s0[r] * LOG2E + cfar : s0[r] * LOG2E + bp[kc], x1 = FAR ? s1[r] * LOG2E + cfar : s1[r] * LOG2E + bp[kc + 32];
        if (CAUSAL) { x0 = (dl >= kc) ? x0 : -INFINITY; x1 = (dl >= kc + 32) ? x1 : -INFINITY; }
        if (WINLO) { x0 = (dl < 512 + kc) ? x0 : -INFINITY; x1 = (dl < 512 + kc + 32) ? x1 : -INFINITY; }
        s0[r] = x0; s1[r] = x1; mx = fmaxf(mx, fmaxf(x0, x1));
    }
    if (SEL) mx = selbit ? mx : -INFINITY;
    mx = fmaxf(mx, __shfl_xor(mx, 32));
    const float mn = fmaxf(st.m, mx), sc = ex2(st.m - mn); st.m = mn;
    float ls = 0.f;
#pragma unroll
    for (int r = 0; r < 16; ++r) { s0[r] = ex2(s0[r] - mn); s1[r] = ex2(s1[r] - mn); ls += s0[r] + s1[r]; }
    if (SEL) ls = selbit ? ls : 0.f;
    st.l = st.l * sc + ls;
#pragma unroll
    for (int r = 0; r < 16; ++r) { st.o[0][r] *= sc; st.o[1][r] *= sc; }
    ns_pv(st.o, s0, s1, vb, q, hi, SEL ? selbit : true);
}
__device__ __forceinline__ void ns_finish(f32x16* out, NsaState& st, float gate) {
    const float lt = st.l + __shfl_xor(st.l, 32); const float f = gate / fmaxf(lt, 1e-30f);
#pragma unroll
    for (int r = 0; r < 16; ++r) { out[0][r] += st.o[0][r] * f; out[1][r] += st.o[1][r] * f; }
}
__device__ __forceinline__ void ns_load(u32x4& kr, u32x4& vr, const bf16_t* kblk, const bf16_t* vblk, int tid) { kr = *(const u32x4*)(kblk + tid * 8); vr = *(const u32x4*)(vblk + tid * 8); }
__device__ __forceinline__ void ns_store(LAS unsigned char* lds, int buf, const u32x4& kr, const u32x4& vr, int tid) {
    const int row = tid >> 3, c = tid & 7; *(LAS u32x4*)(lds + NS_KB + buf * 9216 + row * 144 + c * 16) = kr; *(LAS u32x4*)(lds + NS_VB + buf * 9216 + row * 144 + c * 16) = vr; }

__device__ __forceinline__ void nsa_unit(const Args& a, LAS unsigned char* lds, int b, int g, int qi, int& tab_ok, int tid, int wave, int lane) {
    unsigned char* ws = a.ws;
    asm volatile("" : "+v"(tid), "+v"(lane));
    const int q = lane & 31, hi = lane >> 5, r = wave >> 1, th = wave & 1, head = g * 4 + r;
    const int tl = 64 * qi + 32 * th + q, row = b * SEQ + tl;
    const bf16_t* nkv = (const bf16_t*)(ws + WS_NKV);
    if (!tab_ok) { __syncthreads(); const float* bt = (const float*)(ws + WS_BTAB);
#pragma unroll 1
        for (int i = tid; i < 8 * BIAS_LEN; i += NTHREADS) ((LAS float*)(lds + NS_BT))[i] = bt[i];
        tab_ok = 1; }
    const LAS float* btab = (const LAS float*)(lds + NS_BT) + head * BIAS_LEN;
    bf16x8 qf[4];
#pragma unroll
    for (int ks = 0; ks < 4; ++ks) qf[ks] = *(const bf16x8*)((const bf16_t*)(ws + WS_NQ) + (size_t)row * 512 + head * 64 + ks * 16 + hi * 8);
    const float* smr = (const float*)(ws + WS_SM) + (size_t)row * 32 + 8 + head * 3;
    const float gc = sigmoidf_(smr[0]), gs = sigmoidf_(smr[1]), gw = sigmoidf_(smr[2]);
    f32x16 out[2];
#pragma unroll
    for (int rr = 0; rr < 16; ++rr) { out[0][rr] = 0.f; out[1][rr] = 0.f; }
    NsaState st;
    u32x4 kr, vr;
    const int ncb = (qi >= 16) ? 2 : 1;
    {
        const bf16_t* kcb = (const bf16_t*)(ws + WS_KC) + (size_t)(b * 2 + g) * 128 * 64; const bf16_t* vcb = (const bf16_t*)(ws + WS_VCT) + (size_t)(b * 2 + g) * 2 * 4096;
        __syncthreads();
        ns_load(kr, vr, kcb, vcb, tid); ns_store(lds, 0, kr, vr, tid);
        if (ncb == 2) { ns_load(kr, vr, kcb + 4096, vcb + 4096, tid); ns_store(lds, 1, kr, vr, tid); }
        __syncthreads();
        f32x16 s[2][2];
        float mx = -INFINITY;
#pragma unroll
        for (int cb = 0; cb < 2; ++cb) {
            if (cb < ncb) {
                ns_qk(s[cb][0], s[cb][1], lds + NS_KB + cb * 9216, qf, q, hi);
#pragma unroll
                for (int T = 0; T < 2; ++T)
#pragma unroll
                    for (int rr = 0; rr < 16; ++rr) { const int c = 64 * cb + 32 * T + crow32(rr, hi), d = tl - 16 * c - 31;
                        const float x = s[cb][T][rr] * LOG2E + btab[min(SEQ - 1 - d, BIAS_LEN - 1)]; s[cb][T][rr] = (d >= 0) ? x : -INFINITY; mx = fmaxf(mx, s[cb][T][rr]); }
            } else {
#pragma unroll
                for (int rr = 0; rr < 16; ++rr) { s[cb][0][rr] = -INFINITY; s[cb][1][rr] = -INFINITY; }
            }
        }
        mx = fmaxf(fmaxf(mx, __shfl_xor(mx, 32)), -1e30f);
        float ls = 0.f;
#pragma unroll
        for (int cb = 0; cb < 2; ++cb)
#pragma unroll
            for (int T = 0; T < 2; ++T)
#pragma unroll
                for (int rr = 0; rr < 16; ++rr) { const float e = ex2(s[cb][T][rr] - mx); s[cb][T][rr] = e; ls += e; }
        ns_pv(out, s[0][0], s[0][1], lds + NS_VB, q, hi);
        if (ncb == 2) ns_pv(out, s[1][0], s[1][1], lds + NS_VB + 9216, q, hi);
        const float lt = ls + __shfl_xor(ls, 32), rinv = 1.0f / fmaxf(lt, 1e-30f);
        { const float f = gc * rinv;
#pragma unroll
          for (int rr = 0; rr < 16; ++rr) { out[0][rr] *= f; out[1][rr] *= f; } }
        if (qi >= 16) {
            LAS float* imp = (LAS float*)(lds + NS_IMP) + (r * 64 + 32 * th + q) * 33;
            float prevB = 0.f;
#pragma unroll
            for (int cb = 0; cb < 2; ++cb)
#pragma unroll
                for (int T = 0; T < 2; ++T)
#pragma unroll
                    for (int q4 = 0; q4 < 4; ++q4) { const int n = cb * 8 + T * 4 + q4; const float p0 = s[cb][T][4 * q4] * rinv, p1 = s[cb][T][4 * q4 + 1] * rinv, p2 = s[cb][T][4 * q4 + 2] * rinv, p3 = s[cb][T][4 * q4 + 3] * rinv;
                        const float An = 2.0f * (p0 + p1 + p2) + p3, pb = __shfl_xor(p3, 32);
                        imp[2 * n + hi] = hi ? (An + pb) : (An + prevB); prevB = pb; }
        }
        __syncthreads();
        if (qi >= 16) {
            const int tq = tid >> 3, sub = tid & 7; const LAS float* ip = (const LAS float*)(lds + NS_IMP) + tq * 33;
            float sc[32];
#pragma unroll
            for (int j = 0; j < 32; ++j) sc[j] = ((ip[j] + ip[64 * 33 + j]) + ip[2 * 64 * 33 + j]) + ip[3 * 64 * 33 + j];
            unsigned bits = 0u;
#pragma unroll
            for (int jj = 0; jj < 4; ++jj) { const int j = sub * 4 + jj; int rank = 0;
                const float mine = ((ip[j] + ip[64 * 33 + j]) + ip[2 * 64 * 33 + j]) + ip[3 * 64 * 33 + j];
#pragma unroll
                for (int j2 = 0; j2 < 32; ++j2) { const bool cand = (j2 >= 1 && j2 <= qi - 2); rank += (cand && (sc[j2] > mine || (sc[j2] == mine && j2 < j))) ? 1 : 0; }
                const bool forced = (j == 0) || (j == qi) || (j == qi - 1);
                if (forced || (j >= 1 && j <= qi - 2 && rank < SEL_TOPK - 3)) bits |= 1u << j; }
            bits |= __shfl_xor(bits, 1); bits |= __shfl_xor(bits, 2); bits |= __shfl_xor(bits, 4);
            if (sub == 0) ((LAS unsigned*)(lds + NS_SEL))[tq] = bits;
        } else if (tid < 64) ((LAS unsigned*)(lds + NS_SEL))[tid] = (qi >= 31) ? 0xffffffffu : ((2u << qi) - 1u);
        __syncthreads();
    }
    const unsigned selm = ((const LAS unsigned*)(lds + NS_SEL))[32 * th + q];
    const float cfar = btab[SEQ - 1 - 800];
    {
        const bf16_t* kb = nkv + ((size_t)(4 + g) * MTOK + (size_t)b * SEQ) * 64; const bf16_t* vb = (const bf16_t*)(ws + WS_VST) + (size_t)(b * 2 + g) * 32 * 4096;
        ns_reset(st);
        ns_load(kr, vr, kb, vb, tid);
        for (int j = 0; j <= qi; ++j) {
            ns_store(lds, j & 1, kr, vr, tid);
            __syncthreads();
            if (j < qi) ns_load(kr, vr, kb + (size_t)(j + 1) * 4096, vb + (size_t)(j + 1) * 4096, tid);
            const LAS unsigned char* kl = lds + NS_KB + (j & 1) * 9216; const LAS unsigned char* vl = lds + NS_VB + (j & 1) * 9216; const int dq = tl - 64 * j; const bool sb = (selm >> j) & 1u;
            if (j == qi) ns_block<true, false, false, false>(st, kl, vl, qf, btab, dq, true, cfar, q, hi);
            else if (qi - j >= 14) { if (j == 0) ns_block<false, false, true, false>(st, kl, vl, qf, btab, dq, true, cfar, q, hi); else ns_block<false, false, true, true>(st, kl, vl, qf, btab, dq, sb, cfar, q, hi); }
            else { if (j == 0 || j == qi - 1) ns_block<false, false, false, false>(st, kl, vl, qf, btab, dq, true, cfar, q, hi); else ns_block<false, false, false, true>(st, kl, vl, qf, btab, dq, sb, cfar, q, hi); }
        }
        ns_finish(out, st, gs);
    }
    {
        const bf16_t* kb = nkv + ((size_t)(8 + g) * MTOK + (size_t)b * SEQ) * 64; const bf16_t* vb = (const bf16_t*)(ws + WS_VWT) + (size_t)(b * 2 + g) * 32 * 4096;
        const int j0 = qi >= 8 ? qi - 8 : 0;
        ns_reset(st);
        __syncthreads();
        ns_load(kr, vr, kb + (size_t)j0 * 4096, vb + (size_t)j0 * 4096, tid);
        for (int j = j0; j <= qi; ++j) {
            ns_store(lds, j & 1, kr, vr, tid);
            __syncthreads();
            if (j < qi) ns_load(kr, vr, kb + (size_t)(j + 1) * 4096, vb + (size_t)(j + 1) * 4096, tid);
            const LAS unsigned char* kl = lds + NS_KB + (j & 1) * 9216; const LAS unsigned char* vl = lds + NS_VB + (j & 1) * 9216; const int dq = tl - 64 * j;
            if (j == qi) ns_block<true, false, false, false>(st, kl, vl, qf, btab, dq, true, cfar, q, hi);
            else if (qi - j == 8) ns_block<false, true, false, false>(st, kl, vl, qf, btab, dq, true, cfar, q, hi);
            else ns_block<false, false, false, false>(st, kl, vl, qf, btab, dq, true, cfar, q, hi);
        }
        ns_finish(out, st, gw);
    }
    bf16_t* yn = (bf16_t*)(ws + WS_QK) + (size_t)row * 1024 + 512 + head * 64;
#pragma unroll
    for (int dt = 0; dt < 2; ++dt)
#pragma unroll
        for (int q4 = 0; q4 < 4; ++q4) { u32x2 w; w.x = cvtpk(out[dt][4 * q4], out[dt][4 * q4 + 1]); w.y = cvtpk(out[dt][4 * q4 + 2], out[dt][4 * q4 + 3]); *(u32x2*)(yn + 32 * dt + 8 * q4 + 4 * hi) = w; }
}

__device__ __forceinline__ void p3_mixers(const Args& a, LAS unsigned char* lds, int tid, int wave, int lane, int cword = 0) {
    unsigned* ctr = (unsigned*)(a.ws + WS_CTL) + cword;
    LAS unsigned* slot = (LAS unsigned*)(lds + 143 * 1024);
    int cur_g = 0;
    for (int it_ = 0;; ++it_) {
        __syncthreads();
#ifdef DBG_STATIC_Q
        if (tid == 0) *slot = (unsigned)(blockIdx.x + it_ * gridDim.x);
#else
        if (tid == 0) *slot = atomicAdd(ctr, 1u);
#endif
        __syncthreads();
        const int idx = (int)*slot;
        if (idx >= 64 + 1024) break;
        if (idx < 64) {
#ifdef DBG_NO_ML
            { const int b = idx >> 2, h = idx & 3; bf16_t* ym = (bf16_t*)(a.ws + WS_QK) + (size_t)b * SEQ * 1024 + h * 128;
              for (int i = tid; i < SEQ * 16; i += NTHREADS) *(u32x4*)(ym + (size_t)(i >> 4) * 1024 + (i & 15) * 8) = (u32x4){0u, 0u, 0u, 0u}; }
#else
            mlstm_item(a, lds, idx >> 2, idx & 3, tid, wave, lane);
#endif
            cur_g = 0; }
        else { const int u = idx - 64;
#ifdef DBG_NO_NSA
            { const int b = (u & 31) >> 1, g = u & 1, qi = 31 - (u >> 5); bf16_t* yn = (bf16_t*)(a.ws + WS_QK) + ((size_t)b * SEQ + qi * 64) * 1024 + 512 + g * 256;
              for (int i = tid; i < 64 * 32; i += NTHREADS) *(u32x4*)(yn + (size_t)(i >> 5) * 1024 + (i & 31) * 8) = (u32x4){0u, 0u, 0u, 0u}; }
#else
            nsa_unit(a, lds, (u & 31) >> 1, u & 1, 31 - (u >> 5), cur_g, tid, wave, lane);
#endif
        }
    }
}

#define XB_TMO      128
#define XB_XCNT(j)  (256  + 64 * (j))
#define XB_XSUB(j)  (1280 + 64 * (j))
#define XB_XGEN(j)  (2304 + 64 * (j))
#define XB_TOP      3328
#define XB_TOPGEN   3392
#define XCD_BAR_WORDS 3456
#define XB_SPIN_CAP (1u << 18)
__device__ __forceinline__ unsigned xb_ld(unsigned* p)              { return __hip_atomic_load(p, __ATOMIC_RELAXED, __HIP_MEMORY_SCOPE_AGENT); }
__device__ __forceinline__ unsigned xb_add(unsigned* p, unsigned v) { return __hip_atomic_fetch_add(p, v, __ATOMIC_RELAXED, __HIP_MEMORY_SCOPE_AGENT); }
__device__ __forceinline__ unsigned xb_xcc_id() { return (unsigned)__builtin_amdgcn_s_getreg((3 << 11) | 20) & 0xFu; }
#define XB_SPIN(cond, bar) do { unsigned _sp = 0; while (cond) { __builtin_amdgcn_s_sleep(1); \
    if ((++_sp & 255u) == 0u) { if (xb_ld(&(bar)[XB_TMO])) break; if (_sp > XB_SPIN_CAP) { atomicAdd(&(bar)[XB_TMO], 1u); break; } } } } while (0)
struct XcdBarrier { unsigned* bar; unsigned x; volatile LAS unsigned* st; };
__device__ __forceinline__ void xcd_barrier_complete(unsigned* bar, unsigned x, unsigned& nloc, unsigned& nx) {
    const unsigned G = gridDim.x * gridDim.y * gridDim.z;
    unsigned sum, cnt, mine, sp = 0u;
    for (;;) {
        sum = 0u; cnt = 0u; mine = 0u;
#pragma unroll
        for (unsigned j = 0; j < 16; ++j) { const unsigned c = xb_ld(&bar[XB_XCNT(j)]); sum += c; cnt += (c > 0u) ? 1u : 0u; mine = (j == x) ? c : mine; }
        if (sum == G) break;
        __builtin_amdgcn_s_sleep(1);
        if ((++sp & 255u) == 0u) { if (xb_ld(&bar[XB_TMO])) break; if (sp > XB_SPIN_CAP) { atomicAdd(&bar[XB_TMO], 1u); break; } }
    }
    nloc = mine > 0u ? mine : 1u; nx = cnt > 0u ? cnt : 1u;
}
__device__ __forceinline__ void xcd_barrier(const XcdBarrier& b) {
    asm volatile("s_waitcnt vmcnt(0)" ::: "memory");
    __syncthreads();
    if (threadIdx.x == 0) {
        unsigned* bar = b.bar;
        __builtin_amdgcn_s_waitcnt(0);
        unsigned nloc = b.st[0], nx = b.st[1];
        if (nloc == 0u) { xcd_barrier_complete(bar, b.x, nloc, nx); b.st[0] = nloc; b.st[1] = nx; }
        const unsigned old = xb_add(&bar[XB_XSUB(b.x)], 1u);
        const unsigned gen = old / nloc;
        if (old + 1u == (gen + 1u) * nloc) {
            __builtin_amdgcn_fence(__ATOMIC_RELEASE, "agent");
            asm volatile("s_waitcnt vmcnt(0)" ::: "memory");
            const unsigned og = xb_add(&bar[XB_TOP], 1u);
            const unsigned tg = og / nx;
            if (og + 1u == (tg + 1u) * nx) xb_add(&bar[XB_TOPGEN], 1u);
            else XB_SPIN(xb_ld(&bar[XB_TOPGEN]) == tg, bar);
            __builtin_amdgcn_fence(__ATOMIC_ACQUIRE, "agent");
            xb_add(&bar[XB_XGEN(b.x)], 1u);
            asm volatile("s_waitcnt vmcnt(0)" ::: "memory");
        } else {
            XB_SPIN(xb_ld(&bar[XB_XGEN(b.x)]) == gen, bar);
            __builtin_amdgcn_fence(__ATOMIC_ACQUIRE, "agent");
            asm volatile("s_waitcnt vmcnt(0)" ::: "memory");
        }
    }
    __syncthreads();
}

__global__ void __launch_bounds__(NTHREADS, 2) mega_fwd(Args a) {
    extern __shared__ __attribute__((aligned(16))) unsigned char lds_raw[];
    LAS unsigned char* lds = (LAS unsigned char*)lds_raw;
    const int tid = threadIdx.x, lane = tid & 63, wave = __builtin_amdgcn_readfirstlane(tid >> 6);
    const int G = gridDim.x; const int bx = blockIdx.x; const int vcu = (G % 8 == 0) ? (bx % 8) * (G / 8) + bx / 8 : bx;
    cg::grid_group grid = cg::this_grid();
    XcdBarrier xbar; xbar.bar = (unsigned*)(a.ws + WS_BAR); xbar.x = 0; xbar.st = (volatile LAS unsigned*)(lds + 143 * 1024 + 64);
    if (tid < 2) xbar.st[tid] = 0u;
    __syncthreads();
    unsigned char* ws = a.ws;
    const int lo = a.ph_lo, hi = a.ph_hi;
#define IN(k) (lo <= (k) && (k) < hi)
#define FULLSYNC() do { asm volatile("s_waitcnt vmcnt(0) lgkmcnt(0)" ::: "memory"); grid.sync(); \
    if (tid < 64) { __builtin_amdgcn_fence(__ATOMIC_ACQUIRE, "agent"); asm volatile("s_waitcnt vmcnt(0)" ::: "memory"); } __syncthreads(); } while (0)
#define SEAM(k) do { if (IN(k) && IN((k) + 1)) { if ((k) == 0) { FULLSYNC(); xbar.x = xb_xcc_id(); if (tid == 0) (void)xb_add(&xbar.bar[XB_XCNT(xbar.x)], 1u); } else xcd_barrier(xbar); } } while (0)

#define PH0() p0_prologue(a, lds, vcu, G, wave, lane)
#define PH1() do { pg8::StaticOrder S; S.init(ws + WS_XB, 1024, ws + WS_W1T, 1024, MTOK, N1, G, bx); \
        EpiProj E{(const float*)(ws + WS_RSX), (const float*)(ws + WS_BIAS1), ws}; \
        pg8::gemm_phase<EpiProj, pg8::StaticOrder, true>(lds, pg8::Dims{1024, 1024, 16}, S, E); } while (0)
#define PH2() p2_prep(a, lds, bx, G, wave, lane)
#define PH3() p3_mixers(a, lds, tid, wave, lane, 0)
#define PH4() do { pg8::DualOrder S; S.init(ws + WS_QK, 1024, ws + WS_WBRT, 512, MTOK, 1024, G, bx, (size_t)512 * 2, (size_t)1024 * 512 * 2); \
        EpiBranch E{(const bf16_t*)(ws + WS_GT), (bf16_t*)(ws + WS_VO)}; \
        pg8::gemm_phase<EpiBranch, pg8::DualOrder, true>(lds, pg8::Dims{1024, 512, 8}, S, E); } while (0)
#define PH5() do { pg8::StaticOrder S; S.init(ws + WS_VO, 1024, ws + WS_WOUTT, 1024, MTOK, 1024, G, bx); \
        EpiResid E{a.x, a.out, (bf16_t*)(ws + WS_XB), (float*)(ws + WS_PART1)}; \
        pg8::gemm_phase<EpiResid, pg8::StaticOrder, true>(lds, pg8::Dims{1024, 1024, 16}, S, E); } while (0)
#define PH6() do { pg8::StaticOrder S; S.init(ws + WS_XB, 1024, ws + WS_WGUT, 1024, MTOK, NGU, G, bx); \
        EpiGateUp E{(const float*)(ws + WS_PART1), (bf16_t*)(ws + WS_HID)}; \
        pg8::gemm_phase<EpiGateUp, pg8::StaticOrder, true>(lds, pg8::Dims{1024, 1024, 16}, S, E); } while (0)
#define PH7() do { pg8::StaticOrder S; S.init(ws + WS_HID, D_FF, ws + WS_WDNT, D_FF, MTOK, 1024, G, bx); \
        EpiResid E{a.out, a.out, nullptr, (float*)(ws + WS_PART2)}; \
        pg8::gemm_phase<EpiResid, pg8::StaticOrder, true>(lds, pg8::Dims{D_FF, D_FF, D_FF / 64}, S, E); } while (0)
#define PH8() p8_final(a, vcu, G, wave, lane)
#ifndef DUP_PHASE
#define DUP_PHASE -1
#endif
#define RUN(k, PH) do { if (IN(k)) { PH(); if (DUP_PHASE == (k)) { FULLSYNC(); if ((k) == 3) p3_mixers(a, lds, tid, wave, lane, 1); else PH(); } } } while (0)
    RUN(0, PH0); SEAM(0);
    RUN(1, PH1); SEAM(1);
    RUN(2, PH2); SEAM(2);
    RUN(3, PH3); SEAM(3);
    RUN(4, PH4); SEAM(4);
    RUN(5, PH5); SEAM(5);
    RUN(6, PH6); SEAM(6);
    RUN(7, PH7); SEAM(7);
    RUN(8, PH8);
#undef IN
#undef SEAM
}

constexpr int NPHASES = 9;
#ifndef N_LAUNCHES
#define N_LAUNCHES 1
#endif
extern "C" void kernel_launch(void* const* d_in, const int* in_sizes, int n_in, void* d_out, int out_size, void* d_ws, size_t ws_size, hipStream_t stream) {
    static int grid = 0;
    if (grid == 0) {
        if (n_in != 18 || out_size != MTOK * D_MODEL || ws_size < WS_END) { fprintf(stderr, "kernel_launch: unexpected shapes (n_in %d out %d ws %zu)\n", n_in, out_size, ws_size); grid = -1; return; }
        int dev = 0, cus = 0, per_cu = 0;
        if (hipGetDevice(&dev) != hipSuccess || hipDeviceGetAttribute(&cus, hipDeviceAttributeMultiprocessorCount, dev) != hipSuccess) { grid = -1; return; }
        if (hipFuncSetAttribute((const void*)mega_fwd, hipFuncAttributeMaxDynamicSharedMemorySize, LDS_BYTES) != hipSuccess) { fprintf(stderr, "kernel_launch: hipFuncSetAttribute failed\n"); grid = -1; return; }
        if (hipOccupancyMaxActiveBlocksPerMultiprocessor(&per_cu, (const void*)mega_fwd, NTHREADS, LDS_BYTES) != hipSuccess || per_cu < 1) { fprintf(stderr, "kernel_launch: occupancy query says %d blocks per CU\n", per_cu); per_cu = 1; }
        (void)hipGetLastError();
        grid = cus;
    }
    if (grid < 0) return;
    Args a{};
    const float** ap = (const float**)&a;
    for (int i = 0; i < 18; ++i) ap[i] = (const float*)d_in[i];
    a.out = (float*)d_out; a.ws = (unsigned char*)d_ws;
    if (N_LAUNCHES == 1) {
        a.ph_lo = 0; a.ph_hi = NPHASES; a.coop = 1; a.pad = 0;
        void* args[] = {&a};
        hipError_t e = hipLaunchCooperativeKernel((const void*)mega_fwd, dim3(grid), dim3(NTHREADS), args, LDS_BYTES, stream);
        if (e != hipSuccess) fprintf(stderr, "kernel_launch: cooperative launch failed: %s (grid %d)\n", hipGetErrorString(e), grid);
    } else {
        for (int p = 0; p < NPHASES; ++p) {
            a.ph_lo = p; a.ph_hi = p + 1; a.coop = 0; a.pad = 0;
            hipLaunchKernelGGL(mega_fwd, dim3(grid), dim3(NTHREADS), LDS_BYTES, stream, a);
        }
    }
}
```
